# Optimizing an MI355X kernel written in HIP

```python
import jax, jax.numpy as jnp
from jax import lax
import numpy as np

D_MODEL = 1024
BATCH = 32
SEQ = 2048
DEPTH = 4

HEAD_DIM = 64
N_MIXERS = 4
GROUP_WIDTH = D_MODEL // N_MIXERS
GROUP_HEADS = GROUP_WIDTH // HEAD_DIM
MIX_WIDTH = N_MIXERS * GROUP_WIDTH
BLOCK = 128
GMLP_CHUNK = 128
MLA_Q_RANK = 192
MLA_KV_RANK = 128
MLA_NOPE_DIM = 64
MLA_ROPE_DIM = 32
MLA_V_DIM = 64
DILATED_BRANCHES = ((128, 1), (512, 4), (2048, 16))
MLSTM_CHUNK = 128
CONV_WIDTH = 4
D_FF = ((8 * D_MODEL + 3 * 256 - 1) // (3 * 256)) * 256
ROPE_THETA = 10000.0
LN_EPS = 1e-5
RMS_EPS = 1e-6
DEEPNORM_ALPHA = (2 * DEPTH) ** 0.25
DEEPNORM_BETA = (8 * DEPTH) ** -0.25
A_COLS = 2 * GROUP_WIDTH
B_COLS = MLA_Q_RANK + MLA_KV_RANK + MLA_ROPE_DIM
C_COLS = 3 * GROUP_WIDTH
D_COLS = 4 * GROUP_WIDTH + 2 * GROUP_HEADS
IN_COLS = A_COLS + B_COLS + C_COLS + D_COLS

kernel_name = 'hymba_style_gmlp_mla_dilated_mlstm_deepnorm'


def _layer_norm(x, g, b):
    xf = x.astype(jnp.float32)
    mu = xf.mean(-1, keepdims=True)
    var = jnp.square(xf - mu).mean(-1, keepdims=True)
    return ((xf - mu) * lax.rsqrt(var + LN_EPS) * g + b).astype(x.dtype)


def _rms_norm(x, g):
    xf = x.astype(jnp.float32)
    return (xf * lax.rsqrt(jnp.square(xf).mean(-1, keepdims=True) + RMS_EPS) * g).astype(x.dtype)


def _rope(x, pos):
    half = x.shape[-1] // 2
    inv = jnp.power(ROPE_THETA, -jnp.arange(half, dtype=jnp.float32) / half)
    ang = pos.astype(jnp.float32)[..., None] * inv
    cos = jnp.cos(ang)[:, :, None, :]
    sin = jnp.sin(ang)[:, :, None, :]
    x1 = x[..., :half].astype(jnp.float32)
    x2 = x[..., half:].astype(jnp.float32)
    return jnp.concatenate([x1 * cos - x2 * sin, x1 * sin + x2 * cos], -1).astype(x.dtype)


def _causal_block_attention(q, k, v, scale):
    bsz, seq, heads, dq = q.shape
    nb = seq // BLOCK
    qb = q.reshape(bsz, nb, BLOCK, heads, dq).swapaxes(0, 1)
    key_pos = jnp.arange(seq)

    def one_block(args):
        q_blk, start = args
        s = jnp.einsum('bqhd,bkhd->bhqk', q_blk, k).astype(jnp.float32) * scale
        q_pos = start + jnp.arange(BLOCK)
        s = jnp.where(key_pos[None, :] <= q_pos[:, None], s, -jnp.inf)
        p = jax.nn.softmax(s, axis=-1).astype(v.dtype)
        return jnp.einsum('bhqk,bkhd->bqhd', p, v)

    out = lax.map(one_block, (qb, jnp.arange(nb, dtype=jnp.int32) * BLOCK))
    return out.swapaxes(0, 1).reshape(bsz, seq, heads, v.shape[-1])


def _gmlp_mixer(z, ln_g, ln_b, w_s, b_s):
    bsz, seq, _ = z.shape
    u, v = jnp.split(jax.nn.gelu(z, approximate=False), 2, axis=-1)
    v = _layer_norm(v, ln_g, ln_b)
    n_chunks = seq // GMLP_CHUNK
    v = v.reshape(bsz, n_chunks, GMLP_CHUNK, GROUP_HEADS, HEAD_DIM)
    causal = jnp.tril(jnp.ones((GMLP_CHUNK, GMLP_CHUNK), dtype=bool))
    w_causal = jnp.where(causal[None], w_s, 0.0)
    mixed = jnp.einsum('hts,bcshd->bcthd', w_causal, v) + b_s.T[None, None, :, :, None]
    return u * mixed.reshape(bsz, seq, GROUP_WIDTH)


def _mla_mixer(z, pos, q_norm_g, kv_norm_g, w_uq, w_ukv):
    bsz, seq, _ = z.shape
    c_q, c_kv, k_r = jnp.split(z, [MLA_Q_RANK, MLA_Q_RANK + MLA_KV_RANK], axis=-1)
    q = (_rms_norm(c_q, q_norm_g) @ w_uq).reshape(bsz, seq, GROUP_HEADS, MLA_NOPE_DIM + MLA_ROPE_DIM)
    q = jnp.concatenate([q[..., :MLA_NOPE_DIM], _rope(q[..., MLA_NOPE_DIM:], pos)], -1)
    kv = (_rms_norm(c_kv, kv_norm_g) @ w_ukv).reshape(bsz, seq, GROUP_HEADS, MLA_NOPE_DIM + MLA_V_DIM)
    k_nope, v = kv[..., :MLA_NOPE_DIM], kv[..., MLA_NOPE_DIM:]
    k_rope = jnp.broadcast_to(_rope(k_r[:, :, None, :], pos), (bsz, seq, GROUP_HEADS, MLA_ROPE_DIM))
    k = jnp.concatenate([k_nope, k_rope], -1)
    o = _causal_block_attention(q, k, v, (MLA_NOPE_DIM + MLA_ROPE_DIM) ** -0.5)
    return o.reshape(bsz, seq, GROUP_HEADS * MLA_V_DIM)


def _dilated_branch(q, k, v, window, dilation):
    bsz, seq, heads, dh = q.shape
    n_back = window // dilation
    span = dilation * BLOCK
    padded = -(-seq // span) * span
    sub_len = padded // dilation
    nb = sub_len // BLOCK

    def to_residue_blocks(x):
        x = jnp.pad(x, ((0, 0), (0, padded - seq), (0, 0), (0, 0)))
        x = x.reshape(bsz, sub_len, dilation, heads, dh).transpose(0, 2, 1, 3, 4)
        return x.reshape(bsz * dilation, nb, BLOCK, heads, dh)

    qb, kb, vb = to_residue_blocks(q), to_residue_blocks(k), to_residue_blocks(v)
    k_prev = jnp.pad(kb, ((0, 0), (1, 0), (0, 0), (0, 0), (0, 0)))[:, :-1]
    v_prev = jnp.pad(vb, ((0, 0), (1, 0), (0, 0), (0, 0), (0, 0)))[:, :-1]
    kk = jnp.concatenate([k_prev, kb], axis=2)
    vv = jnp.concatenate([v_prev, vb], axis=2)
    s = jnp.einsum('gnqhd,gnkhd->gnhqk', qb, kk).astype(jnp.float32) * (dh ** -0.5)
    rel = (BLOCK + jnp.arange(BLOCK))[:, None] - jnp.arange(2 * BLOCK)[None, :]
    band = (rel >= 0) & (rel <= n_back)
    not_pad = (jnp.arange(nb)[:, None, None] > 0) | (jnp.arange(2 * BLOCK)[None, None, :] >= BLOCK)
    mask = band[None] & not_pad
    s = jnp.where(mask[None, :, None], s, -jnp.inf)
    lse = jax.nn.logsumexp(s, axis=-1)
    p = jnp.exp(s - lse[..., None]).astype(v.dtype)
    o = jnp.einsum('gnhqk,gnkhd->gnqhd', p, vv)
    o = o.reshape(bsz, dilation, sub_len, heads, dh).transpose(0, 2, 1, 3, 4)
    o = o.reshape(bsz, padded, heads, dh)[:, :seq]
    lse = lse.transpose(0, 1, 3, 2).reshape(bsz, dilation, sub_len, heads).transpose(0, 2, 1, 3)
    lse = lse.reshape(bsz, padded, heads)[:, :seq]
    return o, lse


def _dilated_mixer(z, pos):
    bsz, seq, _ = z.shape
    q, k, v = [t.reshape(bsz, seq, GROUP_HEADS, HEAD_DIM) for t in jnp.split(z, 3, axis=-1)]
    q, k = _rope(q, pos), _rope(k, pos)
    outs, lses = [], []
    for window, dilation in DILATED_BRANCHES:
        o, lse = _dilated_branch(q, k, v, window, dilation)
        outs.append(o)
        lses.append(lse)
    w = jax.nn.softmax(jnp.stack(lses, 0), axis=0).astype(v.dtype)
    o = jnp.einsum('rbsh,rbshd->bshd', w, jnp.stack(outs, 0))
    return o.reshape(bsz, seq, GROUP_WIDTH)


def _causal_conv(x, w, b):
    ch = x.shape[-1]
    y = lax.conv_general_dilated(x, w[:, None, :], window_strides=(1,), padding=[(CONV_WIDTH - 1, 0)],
                                 dimension_numbers=('NWC', 'WIO', 'NWC'), feature_group_count=ch)
    return y + b


def _mlstm_chunkwise(q, k, v, i_pre, f_pre):
    dtype = v.dtype
    q, k, v = q.astype(jnp.float32), k.astype(jnp.float32), v.astype(jnp.float32)
    i_log = i_pre.astype(jnp.float32)
    f_log = jax.nn.log_sigmoid(f_pre.astype(jnp.float32))
    bsz, seq, heads, dh = q.shape
    n_chunks = seq // MLSTM_CHUNK
    causal = jnp.tril(jnp.ones((MLSTM_CHUNK, MLSTM_CHUNK), dtype=bool))

    def chunks(x):
        return x.reshape((bsz, n_chunks, MLSTM_CHUNK) + x.shape[2:]).swapaxes(0, 1)

    def step(carry, xs):
        c_mat, n_vec, m_run = carry
        qc, kc, vc, ic, fc = xs
        b_cum = jnp.cumsum(fc, axis=1).transpose(0, 2, 1)
        ic = ic.transpose(0, 2, 1)
        d_log = b_cum[:, :, :, None] - b_cum[:, :, None, :] + ic[:, :, None, :]
        d_log = jnp.where(causal, d_log, -jnp.inf)
        m_inter = b_cum + m_run[:, :, None]
        m_t = jnp.maximum(m_inter, d_log.max(-1))
        w_intra = jnp.exp(d_log - m_t[..., None])
        sqk = jnp.einsum('bthd,bshd->bhts', qc, kc) * w_intra
        scale = jnp.exp(m_inter - m_t)
        num = jnp.einsum('bhts,bshd->bthd', sqk, vc) + \
            scale.transpose(0, 2, 1)[..., None] * jnp.einsum('bthk,bhkv->bthv', qc, c_mat)
        den = sqk.sum(-1) + scale * jnp.einsum('bthk,bhk->bht', qc, n_vec)
        h = num / jnp.maximum(jnp.abs(den), jnp.exp(-m_t)).transpose(0, 2, 1)[..., None]
        b_end = b_cum[:, :, -1]
        w_end = b_end[:, :, None] - b_cum + ic
        m_new = jnp.maximum(b_end + m_run, w_end.max(-1))
        decay = jnp.exp(b_end + m_run - m_new)
        w_k = jnp.exp(w_end - m_new[..., None])
        c_mat = decay[..., None, None] * c_mat + jnp.einsum('bhs,bshk,bshv->bhkv', w_k, kc, vc)
        n_vec = decay[..., None] * n_vec + jnp.einsum('bhs,bshk->bhk', w_k, kc)
        return (c_mat, n_vec, m_new), h

    init = (jnp.zeros((bsz, heads, dh, dh), jnp.float32),
            jnp.zeros((bsz, heads, dh), jnp.float32),
            jnp.zeros((bsz, heads), jnp.float32))
    _, h = lax.scan(step, init, (chunks(q), chunks(k), chunks(v), chunks(i_log), chunks(f_log)))
    return h.swapaxes(0, 1).reshape(bsz, seq, heads, dh).astype(dtype)


def _mlstm_mixer(z, conv_w, conv_b, igate_b, fgate_b):
    bsz, seq, _ = z.shape
    qk, v, o, gates = jnp.split(z, [2 * GROUP_WIDTH, 3 * GROUP_WIDTH, 4 * GROUP_WIDTH], axis=-1)
    qk = jax.nn.silu(_causal_conv(qk, conv_w, conv_b))
    q, k = jnp.split(qk, 2, axis=-1)
    q = q.reshape(bsz, seq, GROUP_HEADS, HEAD_DIM)
    k = k.reshape(bsz, seq, GROUP_HEADS, HEAD_DIM) * (HEAD_DIM ** -0.5)
    v = v.reshape(bsz, seq, GROUP_HEADS, HEAD_DIM)
    i_pre = gates[..., :GROUP_HEADS] + igate_b
    f_pre = gates[..., GROUP_HEADS:] + fgate_b
    h = _mlstm_chunkwise(q, k, v, i_pre, f_pre)
    return jax.nn.sigmoid(o) * h.reshape(bsz, seq, GROUP_WIDTH)


def setup_inputs(seed: int = 0) -> dict:
    key = jax.random.key(seed)
    ks = jax.random.split(key, 23)

    def nrm(k, shape, scale):
        return jax.random.normal(k, shape, jnp.float32) * scale

    L = DEPTH
    x = nrm(ks[0], (BATCH, SEQ, D_MODEL), 1.0)
    offsets = jax.random.randint(ks[1], (BATCH, 1), 0, 4096, dtype=jnp.int32)
    positions = offsets + jnp.arange(SEQ, dtype=jnp.int32)[None, :]
    return {
        'x': x,
        'positions': positions,
        'w_in': nrm(ks[2], (L, D_MODEL, IN_COLS), D_MODEL ** -0.5),
        'a_ln_g': 1.0 + nrm(ks[3], (L, GROUP_WIDTH), 0.02),
        'a_ln_b': nrm(ks[4], (L, GROUP_WIDTH), 0.02),
        'a_ws': nrm(ks[5], (L, GROUP_HEADS, GMLP_CHUNK, GMLP_CHUNK), GMLP_CHUNK ** -0.5),
        'a_bs': 1.0 + nrm(ks[6], (L, GROUP_HEADS, GMLP_CHUNK), 0.02),
        'b_q_norm': 1.0 + nrm(ks[7], (L, MLA_Q_RANK), 0.02),
        'b_kv_norm': 1.0 + nrm(ks[8], (L, MLA_KV_RANK), 0.02),
        'b_w_uq': nrm(ks[9], (L, MLA_Q_RANK, GROUP_HEADS * (MLA_NOPE_DIM + MLA_ROPE_DIM)), MLA_Q_RANK ** -0.5),
        'b_w_ukv': nrm(ks[10], (L, MLA_KV_RANK, GROUP_HEADS * (MLA_NOPE_DIM + MLA_V_DIM)), MLA_KV_RANK ** -0.5),
        'd_conv_w': nrm(ks[11], (L, CONV_WIDTH, 2 * GROUP_WIDTH), CONV_WIDTH ** -0.5),
        'd_conv_b': nrm(ks[12], (L, 2 * GROUP_WIDTH), 0.02),
        'd_igate_b': nrm(ks[13], (L, GROUP_HEADS), 0.1),
        'd_fgate_b': jnp.linspace(3.0, 6.0, GROUP_HEADS, dtype=jnp.float32)[None, :] + nrm(ks[14], (L, GROUP_HEADS), 0.02),
        'w_out': nrm(ks[15], (L, MIX_WIDTH, D_MODEL), DEEPNORM_BETA * MIX_WIDTH ** -0.5),
        'ln1_g': 1.0 + nrm(ks[16], (L, D_MODEL), 0.02),
        'ln1_b': nrm(ks[17], (L, D_MODEL), 0.02),
        'w_gate': nrm(ks[18], (L, D_MODEL, D_FF), D_MODEL ** -0.5),
        'w_up': nrm(ks[19], (L, D_MODEL, D_FF), D_MODEL ** -0.5),
        'w_down': nrm(ks[20], (L, D_FF, D_MODEL), DEEPNORM_BETA * D_FF ** -0.5),
        'ln2_g': 1.0 + nrm(ks[21], (L, D_MODEL), 0.02),
        'ln2_b': nrm(ks[22], (L, D_MODEL), 0.02),
    }


def reference(x, positions, w_in, a_ln_g, a_ln_b, a_ws, a_bs, b_q_norm, b_kv_norm, b_w_uq, b_w_ukv,
              d_conv_w, d_conv_b, d_igate_b, d_fgate_b, w_out, ln1_g, ln1_b, w_gate, w_up, w_down,
              ln2_g, ln2_b):
    for l in range(DEPTH):
        z = x @ w_in[l]
        z_a, z_b, z_c, z_d = jnp.split(z, [A_COLS, A_COLS + B_COLS, A_COLS + B_COLS + C_COLS], axis=-1)
        y_a = _gmlp_mixer(z_a, a_ln_g[l], a_ln_b[l], a_ws[l], a_bs[l])
        y_b = _mla_mixer(z_b, positions, b_q_norm[l], b_kv_norm[l], b_w_uq[l], b_w_ukv[l])
        y_c = _dilated_mixer(z_c, positions)
        y_d = _mlstm_mixer(z_d, d_conv_w[l], d_conv_b[l], d_igate_b[l], d_fgate_b[l])
        y = jnp.concatenate([y_a, y_b, y_c, y_d], axis=-1) @ w_out[l]
        x = _layer_norm(DEEPNORM_ALPHA * x + y, ln1_g[l], ln1_b[l])
        h = (jax.nn.silu(x @ w_gate[l]) * (x @ w_up[l])) @ w_down[l]
        x = _layer_norm(DEEPNORM_ALPHA * x + h, ln2_g[l], ln2_b[l])
    return x
```

```cpp
#include <hip/hip_runtime.h>
#include <cstdio>
#include <cstdint>

#define LAS __attribute__((address_space(3)))
#define GAS __attribute__((address_space(1)))
typedef _Float16 h16;
typedef _Float16 h16x8 __attribute__((ext_vector_type(8)));
typedef _Float16 h16x4 __attribute__((ext_vector_type(4)));
typedef _Float16 h16x2 __attribute__((ext_vector_type(2)));
typedef float f32x2 __attribute__((ext_vector_type(2)));
typedef float f32x4 __attribute__((ext_vector_type(4)));
typedef float f32x16 __attribute__((ext_vector_type(16)));
typedef unsigned u32x2 __attribute__((ext_vector_type(2)));
typedef unsigned u32x4 __attribute__((ext_vector_type(4)));

constexpr int NB = 32, SEQ = 2048, DM = 1024, DEPTH = 4;
constexpr int M = NB * SEQ;
constexpr int IN_COLS = 2664, ZP = 2816;
constexpr int FF = 2816, GU = 2 * FF;
constexpr int GW = 256;
constexpr float LN_EPS = 1e-5f, RMS_EPS = 1e-6f;
constexpr float ALPHA = 1.681792830507429f;
constexpr int ZC_A = 0;
constexpr int ZC_CQ = 512;
constexpr int ZC_CKV = 768;
constexpr int ZC_KR = 896;
constexpr int ZC_GATE = 928;
constexpr int ZC_C = 1024;
constexpr int ZC_D = 1792;
__host__ __device__ __forceinline__ int in_src(int n) {
    if (n < 704) return n;
    if (n < 768) return -1;
    if (n < 928) return n - 768 + 704;
    if (n < 936) return n - 928 + 2656;
    if (n < 1024) return -1;
    if (n < 1792) return n - 1024 + 864;
    return n - 1792 + 1632;
}

constexpr size_t MiB = 1u << 20;
constexpr size_t WS_ZERO = 0, ZERO_BYTES = 8 * MiB;
constexpr size_t WS_C12 = 1 * MiB;
constexpr size_t WS_STATS = 2 * MiB;
constexpr size_t WS_SSQ = 6 * MiB;
constexpr size_t WS_WIN = 8 * MiB, WS_WOUT = 30 * MiB, WS_WGU = 38 * MiB, WS_WDOWN = 82 * MiB, WS_WUQ = 104 * MiB, WS_WUKV = 105 * MiB;
constexpr size_t WS_ROPEB = 106 * MiB, WS_ROPEC = 114 * MiB;
constexpr size_t WS_V16 = 130 * MiB, WS_Z = 258 * MiB, WS_Q = 610 * MiB, WS_KF = 658 * MiB, WS_VM = 706 * MiB, WS_PAR = 738 * MiB, WS_AWS = 739 * MiB, WS_END = 740 * MiB;
constexpr int PF_LN1G = 0, PF_LN1B = 4096, PF_LN2G = 8192, PF_LN2B = 12288, PF_ALNG = 16384, PF_ALNB = 17408, PF_ABS = 18432, PF_CONVW = 20480, PF_CONVB = 28672, PF_IGB = 30720, PF_FGB = 30736, PF_END = 30752;
constexpr size_t OUT_Y = 0, OUT_DP = 128 * MiB, OUT_DL = 224 * MiB;
constexpr int C1IN = 0, C2IN = 4 * ZP, C1GU = 8 * ZP, C2GU = 8 * ZP + 4 * GU;
constexpr int CW_TMO = 0, CW_CODE = 1, CW_BAR = 4096, CW_QUEUE = 8192;

constexpr int RING_BYTES = 131072;
constexpr int LDS_BYTES = 163840;
constexpr int MISC_OFF = LDS_BYTES - 256;

__device__ __forceinline__ unsigned pkh(float lo, float hi) { h16x2 v = {(h16)lo, (h16)hi}; return __builtin_bit_cast(unsigned, v); }
__device__ __forceinline__ float wave_sum(float v) {
#pragma unroll
    for (int o = 1; o < 64; o <<= 1) v += __shfl_xor(v, o);
    return v;
}
__device__ __forceinline__ void atomic_addf(float* p, float v) { __hip_atomic_fetch_add(p, v, __ATOMIC_RELAXED, __HIP_MEMORY_SCOPE_AGENT); }

namespace pg8 {
constexpr int BM = 256, BK = 64, HALF = 128, HTB = HALF * BK * 2, STAGE_BYTES = 8 * HTB, NXCD = 8, WGM = 8;
__host__ __device__ __forceinline__ int lds_byte(int r, int c) { const int st = (r >> 4) * 2 + (c >> 5), rr = r & 15, cc = c & 31, ob = rr * 64 + cc * 2; return st * 1024 + (ob ^ (((ob >> 9) & 1) << 5)); }
__host__ __device__ __forceinline__ void stage_rc(int b, int& R, int& C) { const int st = b / 1024, sb = b % 1024, swz = sb ^ (((sb >> 9) & 1) << 5); R = (st >> 1) * 16 + swz / 64; C = (st & 1) * 32 + (swz % 64) / 2; }
__host__ __device__ __forceinline__ int perm32(int rho) { const int n = rho >> 4, i = rho & 15; return 8 * (i >> 2) + 4 * n + (i & 3); }

struct Unit { int pm, pn; };
struct Gemm { const h16* A; const h16* Bt; int lda, ldb, M, N, K; };

struct StaticOrder {
    int nM, nN, nwg, G, c;
    __host__ __device__ void init(int M_, int N_, int G_, int c_) { nM = M_ / BM; nN = N_ / BM; nwg = nM * nN; G = G_; c = c_; }
    __host__ __device__ bool next(int i, Unit& u) const {
        const long L = (long)i * G + c; if (L >= nwg) return false;
        int wgid = (int)L; { const int q = nwg / NXCD, r = nwg % NXCD, xcd = wgid % NXCD, off = wgid / NXCD; wgid = (xcd < r ? xcd * (q + 1) : r * (q + 1) + (xcd - r) * q) + off; }
        const int nig = WGM * nN, gid = wgid / nig, fm = gid * WGM, gsz = (nM - fm) < WGM ? (nM - fm) : WGM;
        u.pm = fm + ((wgid % nig) % gsz); u.pn = (wgid % nig) / gsz; return true;
    }
};

template <class Epi, class Sched>
__device__ __forceinline__ void gemm_phase(LAS unsigned char* lds, const int wid, const Gemm g, const Sched& S, const Epi& E) {
    int lane = __builtin_amdgcn_mbcnt_hi(~0u, __builtin_amdgcn_mbcnt_lo(~0u, 0u)); asm volatile("" : "+v"(lane));
    const int tid = wid * 64 + lane, wr = wid >> 2, wc = wid & 3, fr = lane & 15, fq = lane >> 4;
    const int K = g.K, nt = K / BK;
    unsigned voffA[2], voffB[2];
#pragma unroll
    for (int i = 0; i < 2; ++i) { int R, C; stage_rc(tid * 16 + i * 8192, R, C); const int Rb = Epi::PERM ? ((R & ~31) + perm32(R & 31)) : R;
        voffA[i] = (unsigned)(R * g.lda + C) * 2u; voffB[i] = (unsigned)(Rb * g.ldb + C) * 2u; }
    const size_t kstep = (size_t)(BK * 2);
    const size_t hstepA = (size_t)HALF * g.lda * 2, hstepB = (size_t)HALF * g.ldb * 2;
    const size_t tstepA = 2 * hstepA, tstepB = 2 * hstepB;
    const unsigned ldsw = (unsigned)wid * 1024u;
    const int aoff = lds_byte(wr * 64 + fr, fq * 8), boff = lds_byte(wc * 32 + fr, fq * 8);
#define PG8_SA(b, h) (((b) * 2 + (h)) * HTB)
#define PG8_SB(b, h) ((4 + (b) * 2 + (h)) * HTB)
#define PG8_STAGE(bufoff, gbase, voff) do { _Pragma("unroll") for (int _i = 0; _i < 2; ++_i) \
        __builtin_amdgcn_global_load_lds((const unsigned*)((const char*)(gbase) + (voff)[_i]), (LAS unsigned*)(lds + (bufoff) + ldsw + _i * 8192), 16, 0, 0); } while (0)
#define PG8_LDA(dst, b, h) do { _Pragma("unroll") for (int m = 0; m < 4; ++m) _Pragma("unroll") for (int k = 0; k < 2; ++k) dst[m][k] = *(const LAS h16x8*)(lds + PG8_SA(b, h) + aoff + m * 2048 + k * 1024); } while (0)
#define PG8_LDB(dst, b, h) do { _Pragma("unroll") for (int n = 0; n < 2; ++n) _Pragma("unroll") for (int k = 0; k < 2; ++k) dst[n][k] = *(const LAS h16x8*)(lds + PG8_SB(b, h) + boff + n * 2048 + k * 1024); } while (0)
#define PG8_MMA(ai, bj, At, Bt) do { __builtin_amdgcn_s_setprio(1); _Pragma("unroll") for (int m = 0; m < 4; ++m) _Pragma("unroll") for (int n = 0; n < 2; ++n) _Pragma("unroll") for (int k = 0; k < 2; ++k) \
        acc[ai][bj][m][n] = __builtin_amdgcn_mfma_f32_16x16x32_f16(Bt[n][k], At[m][k], acc[ai][bj][m][n], 0, 0, 0); __builtin_amdgcn_s_setprio(0); } while (0)
#define PG8_WAIT_V(n) asm volatile("s_waitcnt vmcnt(" #n ")" ::: "memory")
#define PG8_WAIT_L(n) asm volatile("s_waitcnt lgkmcnt(" #n ")" ::: "memory")
#define PG8_BAR __builtin_amdgcn_s_barrier()
#define PG8_SCHED __builtin_amdgcn_sched_barrier(0)
    Unit cur, nxt; int ui = 0;
    if (!S.next(0, cur)) return;
    f32x4 acc[2][2][4][2];
#pragma unroll
    for (int a = 0; a < 2; ++a)
#pragma unroll
        for (int b = 0; b < 2; ++b)
#pragma unroll
            for (int m = 0; m < 4; ++m)
#pragma unroll
                for (int n = 0; n < 2; ++n) acc[a][b][m][n] = (f32x4){0.f, 0.f, 0.f, 0.f};
    h16x8 At[4][2], B0[2][2], B1[2][2];
    const char* cA = (const char*)g.A + (size_t)cur.pm * tstepA; const char* cB = (const char*)g.Bt + (size_t)cur.pn * tstepB;
    PG8_STAGE(PG8_SB(0, 0), cB, voffB); PG8_STAGE(PG8_SB(0, 1), cB + hstepB, voffB); PG8_STAGE(PG8_SA(0, 0), cA, voffA); PG8_STAGE(PG8_SA(0, 1), cA + hstepA, voffA);
    if (wr == 1) PG8_BAR;
    PG8_WAIT_V(2); PG8_BAR;
    PG8_STAGE(PG8_SB(1, 0), cB + kstep, voffB); PG8_STAGE(PG8_SA(1, 0), cA + kstep, voffA); PG8_STAGE(PG8_SB(1, 1), cB + hstepB + kstep, voffB);
    PG8_WAIT_V(6); PG8_BAR;
    for (;;) {
        const bool has_next = S.next(ui + 1, nxt);
        const char* nA = has_next ? (const char*)g.A + (size_t)nxt.pm * tstepA : cA; const char* nB = has_next ? (const char*)g.Bt + (size_t)nxt.pn * tstepB : cB;
#pragma unroll 1
        for (int t = 0; t < nt; t += 2) {
            const bool last = (t == nt - 2);
            const char* a1 = cA + (size_t)(t + 1) * kstep;
            const char* a2 = last ? nA : cA + (size_t)(t + 2) * kstep; const char* b2 = last ? nB : cB + (size_t)(t + 2) * kstep;
            const char* a3 = a2 + kstep; const char* b3 = b2 + kstep;
            PG8_LDB(B0, 0, 0); PG8_LDB(B1, 0, 1); PG8_SCHED; PG8_LDA(At, 0, 0); PG8_STAGE(PG8_SA(1, 1), a1 + hstepA, voffA);
            PG8_WAIT_V(8); PG8_WAIT_L(0); PG8_BAR; PG8_MMA(0, 0, At, B0); PG8_MMA(0, 1, At, B1); PG8_BAR; PG8_SCHED;
            PG8_LDA(At, 0, 1); PG8_STAGE(PG8_SB(0, 0), b2, voffB); PG8_STAGE(PG8_SB(0, 1), b2 + hstepB, voffB); PG8_STAGE(PG8_SA(0, 0), a2, voffA);
            PG8_WAIT_V(8); PG8_WAIT_L(0); PG8_BAR; PG8_MMA(1, 0, At, B0); PG8_MMA(1, 1, At, B1); PG8_BAR; PG8_SCHED;
            PG8_LDB(B0, 1, 0); PG8_LDB(B1, 1, 1); PG8_SCHED; PG8_LDA(At, 1, 0); PG8_STAGE(PG8_SA(0, 1), a2 + hstepA, voffA);
            PG8_WAIT_V(8); PG8_WAIT_L(0); PG8_BAR; PG8_MMA(0, 0, At, B0); PG8_MMA(0, 1, At, B1); PG8_BAR; PG8_SCHED;
            PG8_LDA(At, 1, 1); PG8_STAGE(PG8_SB(1, 0), b3, voffB); PG8_STAGE(PG8_SB(1, 1), b3 + hstepB, voffB); PG8_STAGE(PG8_SA(1, 0), a3, voffA);
            PG8_WAIT_V(8); PG8_WAIT_L(0); PG8_BAR; PG8_MMA(1, 0, At, B0); PG8_MMA(1, 1, At, B1); PG8_BAR; PG8_SCHED;
        }
        if (wr == 0) PG8_BAR;
        E(acc, cur, wr, wc, fr, fq);
        if (!has_next) break;
#pragma unroll
        for (int a = 0; a < 2; ++a)
#pragma unroll
            for (int b = 0; b < 2; ++b)
#pragma unroll
                for (int m = 0; m < 4; ++m)
#pragma unroll
                    for (int n = 0; n < 2; ++n) acc[a][b][m][n] = (f32x4){0.f, 0.f, 0.f, 0.f};
        cur = nxt; cA = nA; cB = nB; ++ui;
        if (wr == 1) PG8_BAR;
    }
    PG8_WAIT_V(0);
    PG8_BAR;
#undef PG8_SA
#undef PG8_SB
#undef PG8_STAGE
#undef PG8_LDA
#undef PG8_LDB
#undef PG8_MMA
#undef PG8_WAIT_V
#undef PG8_WAIT_L
#undef PG8_BAR
#undef PG8_SCHED
}

struct RowStats { const float* s1; const float* s2; };
__device__ __forceinline__ void row_mu_rs(const RowStats& st, int r, float& mu, float& rs) {
    const float a = st.s1[r], b = st.s2[r];
    mu = a * (1.0f / DM); const float var = fmaxf(b * (1.0f / DM) - mu * mu, 0.f); rs = rsqrtf(var + LN_EPS);
}

struct EpiIn {
    static constexpr bool PERM = true;
    h16* Z; const float* c1; const float* c2; RowStats st; int ident; float* ssq_q; float* ssq_kv;
    __device__ __forceinline__ void operator()(const f32x4 (&acc)[2][2][4][2], const Unit& u, int wr, int wc, int fr, int fq) const {
        const int row0 = u.pm * BM + wr * 64 + fr, col0 = u.pn * BM + wc * 32 + 8 * fq;
        f32x4 c1v[2][2], c2v[2][2];
#pragma unroll
        for (int bj = 0; bj < 2; ++bj)
#pragma unroll
            for (int n = 0; n < 2; ++n) { c1v[bj][n] = *(const f32x4*)(c1 + col0 + bj * HALF + 4 * n); c2v[bj][n] = *(const f32x4*)(c2 + col0 + bj * HALF + 4 * n); }
        const bool do_ssq = (u.pn == 2) || (u.pn == 3);
        float sq[2][4];
#pragma unroll
        for (int ai = 0; ai < 2; ++ai)
#pragma unroll
            for (int m = 0; m < 4; ++m) {
                const int r = row0 + ai * HALF + m * 16;
                float mu = 0.f, rs = 1.f; if (!ident) row_mu_rs(st, r, mu, rs);
                float q = 0.f;
#pragma unroll
                for (int bj = 0; bj < 2; ++bj) {
                    f32x4 v0 = acc[ai][bj][m][0], v1 = acc[ai][bj][m][1];
                    if (!ident) { v0 = (v0 - c1v[bj][0] * mu) * rs + c2v[bj][0]; v1 = (v1 - c1v[bj][1] * mu) * rs + c2v[bj][1]; }
                    u32x4 w; w.x = pkh(v0[0], v0[1]); w.y = pkh(v0[2], v0[3]); w.z = pkh(v1[0], v1[1]); w.w = pkh(v1[2], v1[3]);
                    *(u32x4*)(Z + (size_t)r * ZP + col0 + bj * HALF) = w;
                    const bool valid = (u.pn == 2) ? (bj == 0 || wc < 2) : (bj == 0);
                    if (valid) q += (v0[0] * v0[0] + v0[1] * v0[1]) + (v0[2] * v0[2] + v0[3] * v0[3]) + (v1[0] * v1[0] + v1[1] * v1[1]) + (v1[2] * v1[2] + v1[3] * v1[3]);
                }
                sq[ai][m] = q;
            }
        if (do_ssq) {
            float* dst = (u.pn == 2) ? ssq_q : ssq_kv;
#pragma unroll
            for (int ai = 0; ai < 2; ++ai) {
                float t[4];
#pragma unroll
                for (int m = 0; m < 4; ++m) { float q = sq[ai][m]; q += __shfl_xor(q, 16); q += __shfl_xor(q, 32); t[m] = q; }
                const float mine = fq == 0 ? t[0] : fq == 1 ? t[1] : fq == 2 ? t[2] : t[3];
                atomic_addf(dst + u.pm * BM + ai * HALF + wr * 64 + fq * 16 + fr, mine);
            }
        }
    }
};

struct EpiRes {
    static constexpr bool PERM = true;
    h16* V; int ident; RowStats st; const float* g; const float* b; float* o1; float* o2;
    __device__ __forceinline__ void operator()(const f32x4 (&acc)[2][2][4][2], const Unit& u, int wr, int wc, int fr, int fq) const {
        const int row0 = u.pm * BM + wr * 64 + fr, col0 = u.pn * BM + wc * 32 + 8 * fq;
        f32x4 gv[2][2], bv[2][2];
        if (!ident) {
#pragma unroll
            for (int bj = 0; bj < 2; ++bj)
#pragma unroll
                for (int n = 0; n < 2; ++n) { gv[bj][n] = *(const f32x4*)(g + col0 + bj * HALF + 4 * n); bv[bj][n] = *(const f32x4*)(b + col0 + bj * HALF + 4 * n); }
        }
        float s1[2][4], s2[2][4];
#pragma unroll
        for (int ai = 0; ai < 2; ++ai)
#pragma unroll
            for (int m = 0; m < 4; ++m) {
                const int r = row0 + ai * HALF + m * 16;
                float mu = 0.f, rs = 1.f; if (!ident) row_mu_rs(st, r, mu, rs);
                float a1 = 0.f, a2 = 0.f;
#pragma unroll
                for (int bj = 0; bj < 2; ++bj) {
                    const size_t off = (size_t)r * DM + col0 + bj * HALF;
                    const h16x8 hv = *(const h16x8*)(V + off);
                    f32x4 x0 = (f32x4){(float)hv[0], (float)hv[1], (float)hv[2], (float)hv[3]}, x1 = (f32x4){(float)hv[4], (float)hv[5], (float)hv[6], (float)hv[7]};
                    if (!ident) { x0 = (x0 - mu) * rs * gv[bj][0] + bv[bj][0]; x1 = (x1 - mu) * rs * gv[bj][1] + bv[bj][1]; }
                    const f32x4 v0 = x0 * ALPHA + acc[ai][bj][m][0], v1 = x1 * ALPHA + acc[ai][bj][m][1];
                    h16x8 ho = {(h16)v0[0], (h16)v0[1], (h16)v0[2], (h16)v0[3], (h16)v1[0], (h16)v1[1], (h16)v1[2], (h16)v1[3]};
                    *(h16x8*)(V + off) = ho;
#pragma unroll
                    for (int j = 0; j < 8; ++j) { const float f = (float)ho[j]; a1 += f; a2 += f * f; }
                }
                a1 += __shfl_xor(a1, 16); a1 += __shfl_xor(a1, 32); a2 += __shfl_xor(a2, 16); a2 += __shfl_xor(a2, 32);
                s1[ai][m] = a1; s2[ai][m] = a2;
            }
#pragma unroll
        for (int ai = 0; ai < 2; ++ai) {
            const float m1 = fq == 0 ? s1[ai][0] : fq == 1 ? s1[ai][1] : fq == 2 ? s1[ai][2] : s1[ai][3];
            const float m2 = fq == 0 ? s2[ai][0] : fq == 1 ? s2[ai][1] : fq == 2 ? s2[ai][2] : s2[ai][3];
            const int r = u.pm * BM + ai * HALF + wr * 64 + fq * 16 + fr;
            atomic_addf(o1 + r, m1); atomic_addf(o2 + r, m2);
        }
    }
};

struct EpiGU {
    static constexpr bool PERM = true;
    h16* H; const float* c1; const float* c2; RowStats st;
    __device__ __forceinline__ void operator()(const f32x4 (&acc)[2][2][4][2], const Unit& u, int wr, int wc, int fr, int fq) const {
        const int row0 = u.pm * BM + wr * 64 + fr, cin = wc * 32 + 8 * fq, col0 = u.pn * BM + cin;
        f32x4 c1v[2][2], c2v[2][2];
#pragma unroll
        for (int bj = 0; bj < 2; ++bj)
#pragma unroll
            for (int n = 0; n < 2; ++n) { c1v[bj][n] = *(const f32x4*)(c1 + col0 + bj * HALF + 4 * n); c2v[bj][n] = *(const f32x4*)(c2 + col0 + bj * HALF + 4 * n); }
#pragma unroll
        for (int ai = 0; ai < 2; ++ai)
#pragma unroll
            for (int m = 0; m < 4; ++m) {
                const int r = row0 + ai * HALF + m * 16;
                float mu, rs; row_mu_rs(st, r, mu, rs);
                float hv[8];
#pragma unroll
                for (int n = 0; n < 2; ++n) {
                    const f32x4 gg = (acc[ai][0][m][n] - c1v[0][n] * mu) * rs + c2v[0][n];
                    const f32x4 uu = (acc[ai][1][m][n] - c1v[1][n] * mu) * rs + c2v[1][n];
#pragma unroll
                    for (int j = 0; j < 4; ++j) { const float e = __builtin_amdgcn_exp2f(gg[j] * -1.4426950408889634f); hv[4 * n + j] = gg[j] * uu[j] * __builtin_amdgcn_rcpf(1.0f + e); }
                }
                u32x4 w; w.x = pkh(hv[0], hv[1]); w.y = pkh(hv[2], hv[3]); w.z = pkh(hv[4], hv[5]); w.w = pkh(hv[6], hv[7]);
                *(u32x4*)(H + (size_t)r * FF + u.pn * HALF + cin) = w;
            }
    }
};

constexpr float QSCALE96 = 0.10206207261596577f * 1.4426950408889634f;
struct EpiQ {
    static constexpr bool PERM = false;
    h16* Q; const float* ssq; const float* rb;
    __device__ __forceinline__ void operator()(const f32x4 (&acc)[2][2][4][2], const Unit& u, int wr, int wc, int fr, int fq) const {
        const int row0 = u.pm * BM + wr * 64 + fr;
#pragma unroll
        for (int ai = 0; ai < 2; ++ai)
#pragma unroll
            for (int m = 0; m < 4; ++m) {
                const int r = row0 + ai * HALF + m * 16;
                const float rs = rsqrtf(ssq[r] * (1.0f / 192.0f) + RMS_EPS) * QSCALE96;
#pragma unroll
                for (int bj = 0; bj < 2; ++bj) {
                    const int g32 = 8 * u.pn + 4 * bj + wc;
                    if (g32 >= 12) continue;
                    f32x4 v0 = acc[ai][bj][m][0] * rs, v1 = acc[ai][bj][m][1] * rs;
                    if (g32 % 3 == 2) {
                        const f32x4 cc = *(const f32x4*)(rb + (size_t)r * 32 + 4 * fq), ss = *(const f32x4*)(rb + (size_t)r * 32 + 16 + 4 * fq);
                        const f32x4 a = v0 * cc - v1 * ss, b = v0 * ss + v1 * cc; v0 = a; v1 = b;
                    }
                    u32x2 w0, w1; w0.x = pkh(v0[0], v0[1]); w0.y = pkh(v0[2], v0[3]); w1.x = pkh(v1[0], v1[1]); w1.y = pkh(v1[2], v1[3]);
                    h16* dst = Q + (size_t)r * 384 + 32 * g32 + 4 * fq;
                    *(u32x2*)dst = w0; *(u32x2*)(dst + 16) = w1;
                }
                asm volatile("" ::: "memory");
            }
    }
};
struct EpiKV {
    static constexpr bool PERM = true;
    h16* Kf; h16* Vm; const float* ssq;
    __device__ __forceinline__ void operator()(const f32x4 (&acc)[2][2][4][2], const Unit& u, int wr, int wc, int fr, int fq) const {
        const int row0 = u.pm * BM + wr * 64 + fr;
#pragma unroll
        for (int ai = 0; ai < 2; ++ai)
#pragma unroll
            for (int m = 0; m < 4; ++m) {
                const int r = row0 + ai * HALF + m * 16;
                const float rs = rsqrtf(ssq[r] * (1.0f / 128.0f) + RMS_EPS);
#pragma unroll
                for (int bj = 0; bj < 2; ++bj) {
                    const int hd = 2 * u.pn + bj, within = 32 * wc + 8 * fq;
                    const f32x4 v0 = acc[ai][bj][m][0] * rs, v1 = acc[ai][bj][m][1] * rs;
                    u32x4 w; w.x = pkh(v0[0], v0[1]); w.y = pkh(v0[2], v0[3]); w.z = pkh(v1[0], v1[1]); w.w = pkh(v1[2], v1[3]);
                    if (wc < 2) *(u32x4*)(Kf + (size_t)r * 384 + hd * 96 + within) = w;
                    else *(u32x4*)(Vm + (size_t)r * 256 + hd * 64 + within - 64) = w;
                }
                asm volatile("" ::: "memory");
            }
    }
};
}

#define XB_TMO      128
#define XB_XCNT(j)  (256  + 64 * (j))
#define XB_XSUB(j)  (1280 + 64 * (j))
#define XB_XGEN(j)  (2304 + 64 * (j))
#define XB_TOP      3328
#define XB_TOPGEN   3392
#define XCD_BAR_WORDS 3456
#define XB_SPIN_CAP (1u << 18)
__device__ __forceinline__ unsigned xb_ld(unsigned* p)              { return __hip_atomic_load(p, __ATOMIC_RELAXED, __HIP_MEMORY_SCOPE_AGENT); }
__device__ __forceinline__ unsigned xb_add(unsigned* p, unsigned v) { return __hip_atomic_fetch_add(p, v, __ATOMIC_RELAXED, __HIP_MEMORY_SCOPE_AGENT); }
__device__ __forceinline__ unsigned xb_xcc_id() { return (unsigned)__builtin_amdgcn_s_getreg((3 << 11) | 20) & 0xFu; }
#define XB_SPIN(cond, bar) do { unsigned _sp = 0; while (cond) { __builtin_amdgcn_s_sleep(1); \
    if ((++_sp & 255u) == 0u) { if (xb_ld(&(bar)[XB_TMO])) break; if (_sp > XB_SPIN_CAP) { atomicAdd(&(bar)[XB_TMO], 1u); break; } } } } while (0)
struct XcdBarrier { unsigned* bar; unsigned x; volatile LAS unsigned* st; int wave; };
__device__ __forceinline__ bool xb_thread0(int wave) { return wave == 0 && __builtin_amdgcn_mbcnt_hi(~0u, __builtin_amdgcn_mbcnt_lo(~0u, 0u)) == 0; }
__device__ __forceinline__ XcdBarrier xcd_barrier_post(unsigned* bar, volatile LAS unsigned* st, int wave) {
    XcdBarrier b; b.bar = bar; b.x = xb_xcc_id(); b.st = st; b.wave = wave;
    if (xb_thread0(wave)) (void)xb_add(&bar[XB_XCNT(b.x)], 1u);
    return b;
}
__device__ __forceinline__ void xcd_barrier_complete(unsigned* bar, unsigned x, unsigned& nloc, unsigned& nx) {
    const unsigned G = gridDim.x * gridDim.y * gridDim.z;
    unsigned sum, cnt, mine, sp = 0u;
    for (;;) {
        sum = 0u; cnt = 0u; mine = 0u;
#pragma unroll
        for (unsigned j = 0; j < 16; ++j) { const unsigned c = xb_ld(&bar[XB_XCNT(j)]); sum += c; cnt += (c > 0u) ? 1u : 0u; mine = (j == x) ? c : mine; }
        if (sum == G) break;
        __builtin_amdgcn_s_sleep(1);
        if ((++sp & 255u) == 0u) { if (xb_ld(&bar[XB_TMO])) break; if (sp > XB_SPIN_CAP) { atomicAdd(&bar[XB_TMO], 1u); break; } }
    }
    nloc = mine > 0u ? mine : 1u; nx = cnt > 0u ? cnt : 1u;
}
__device__ __forceinline__ void xcd_barrier(const XcdBarrier& b) {
    asm volatile("s_waitcnt vmcnt(0)" ::: "memory");
    __syncthreads();
    if (xb_thread0(b.wave)) {
        unsigned* bar = b.bar;
        __builtin_amdgcn_s_waitcnt(0);
        unsigned nloc = b.st[0], nx = b.st[1];
        if (nloc == 0u) { xcd_barrier_complete(bar, b.x, nloc, nx); b.st[0] = nloc; b.st[1] = nx; }
        const unsigned old = xb_add(&bar[XB_XSUB(b.x)], 1u);
        const unsigned gen = old / nloc;
        if (old + 1u == (gen + 1u) * nloc) {
            __builtin_amdgcn_fence(__ATOMIC_RELEASE, "agent");
            asm volatile("s_waitcnt vmcnt(0)" ::: "memory");
            const unsigned og = xb_add(&bar[XB_TOP], 1u);
            const unsigned tg = og / nx;
            if (og + 1u == (tg + 1u) * nx) xb_add(&bar[XB_TOPGEN], 1u);
            else XB_SPIN(xb_ld(&bar[XB_TOPGEN]) == tg, bar);
            __builtin_amdgcn_fence(__ATOMIC_ACQUIRE, "agent");
            xb_add(&bar[XB_XGEN(b.x)], 1u);
            asm volatile("s_waitcnt vmcnt(0)" ::: "memory");
        } else {
            XB_SPIN(xb_ld(&bar[XB_XGEN(b.x)]) == gen, bar);
            __builtin_amdgcn_fence(__ATOMIC_ACQUIRE, "agent");
            asm volatile("s_waitcnt vmcnt(0)" ::: "memory");
        }
    }
    __syncthreads();
}

struct Args {
    const float* x; const int* pos; const float* w_in; const float* a_ln_g; const float* a_ln_b; const float* a_ws; const float* a_bs;
    const float* b_q_norm; const float* b_kv_norm; const float* b_w_uq; const float* b_w_ukv;
    const float* d_conv_w; const float* d_conv_b; const float* d_igate_b; const float* d_fgate_b;
    const float* w_out; const float* ln1_g; const float* ln1_b; const float* w_gate; const float* w_up; const float* w_down; const float* ln2_g; const float* ln2_b;
    float* out; unsigned char* ws; int ph_lo, ph_hi; int use_bar, pad;
};

template <int MAP>
__device__ __forceinline__ void transpose_item(const float* W, int Ksrc, int Nsrc, const float* g, const float* b, h16* Wt, int Kdst, int Ndst_valid,
                                               float* c1, float* c2, int kb, int nb, LAS float* scr, int lane) {
    const int k0 = 64 * kb, n0 = 32 * nb, nn = lane & 31, kh = lane >> 5;
    int ns, nd;
    if (MAP == 0) { nd = n0 + nn; ns = (nd < Ndst_valid && nd < Nsrc) ? nd : -1; }
    else if (MAP == 1) { nd = n0 + nn; ns = in_src(nd); }
    else { const int j = n0 + nn; ns = j; nd = 256 * (j >> 7) + (j & 127) + (MAP == 3 ? 128 : 0); }
    float s1 = 0.f, s2 = 0.f;
#pragma unroll 8
    for (int i = 0; i < 32; ++i) {
        const int kk = 2 * i + kh, k = k0 + kk;
        float w = 0.f, gk = 1.f, bk = 0.f;
        if (ns >= 0 && k < Ksrc) { w = W[(size_t)k * Nsrc + ns]; if (g) gk = g[k]; if (b) bk = b[k]; }
        const float hf = (float)(h16)(w * gk);
        scr[kk * 33 + nn] = hf; s1 += hf; s2 += bk * w;
    }
    if (c1) { s1 += __shfl_xor(s1, 32); s2 += __shfl_xor(s2, 32); if (lane < 32) { atomic_addf(c1 + nd, s1); atomic_addf(c2 + nd, s2); } }
    asm volatile("s_waitcnt lgkmcnt(0)" ::: "memory");
    const int c = lane & 7;
    int nd0; if (MAP <= 1) nd0 = n0; else nd0 = 256 * (n0 >> 7) + (n0 & 127) + (MAP == 3 ? 128 : 0);
#pragma unroll
    for (int j = 0; j < 4; ++j) { const int n = (lane >> 3) + 8 * j; const LAS float* s = scr + (8 * c) * 33 + n;
        u32x4 o; o.x = pkh(s[0 * 33], s[1 * 33]); o.y = pkh(s[2 * 33], s[3 * 33]); o.z = pkh(s[4 * 33], s[5 * 33]); o.w = pkh(s[6 * 33], s[7 * 33]);
        *(u32x4*)(Wt + (size_t)(nd0 + n) * Kdst + k0 + 8 * c) = o; }
    asm volatile("s_waitcnt lgkmcnt(0)" ::: "memory");
}

struct Frame { LAS unsigned char* lds; int tid, lane, wave, G; };
__device__ __forceinline__ Frame fresh_frame(const Frame& F0) {
    Frame F; int ln = __builtin_amdgcn_mbcnt_hi(~0u, __builtin_amdgcn_mbcnt_lo(~0u, 0u)); asm volatile("" : "+v"(ln));
    F.lds = F0.lds; F.G = F0.G; F.wave = F0.wave; F.lane = ln; F.tid = F0.wave * 64 + ln; return F;
}

__device__ __forceinline__ void p0_prologue(const Args& a, const Frame& F0) {
    const Frame F = fresh_frame(F0);
    LAS float* scr = (LAS float*)(F.lds + F.wave * 16384);
    const int gw = blockIdx.x * 8 + F.wave, NGW = F.G * 8;
    float* c12 = (float*)(a.ws + WS_C12);
    constexpr int I_IN = 16 * (ZP / 32), I_OUT = 16 * 32, I_G = 16 * (FF / 32), I_DN = (FF / 64) * 32, I_UQ = 4 * 16, I_UKV = 4 * 16;
    constexpr int PER_LAYER = I_IN + I_OUT + 2 * I_G + I_DN + I_UQ + I_UKV;
    for (int it = gw; it < DEPTH * PER_LAYER; it += NGW) {
        const int l = it / PER_LAYER; int r = it % PER_LAYER;
        if (r < I_IN) { const int kb = r / (ZP / 32), nb = r % (ZP / 32);
            transpose_item<1>(a.w_in + (size_t)l * DM * IN_COLS, DM, IN_COLS, l ? a.ln2_g + (l - 1) * DM : nullptr, l ? a.ln2_b + (l - 1) * DM : nullptr,
                              (h16*)(a.ws + WS_WIN) + (size_t)l * ZP * DM, DM, ZP, c12 + C1IN + l * ZP, c12 + C2IN + l * ZP, kb, nb, scr, F.lane); continue; } r -= I_IN;
        if (r < I_OUT) { const int kb = r / 32, nb = r % 32;
            transpose_item<0>(a.w_out + (size_t)l * DM * DM, DM, DM, nullptr, nullptr, (h16*)(a.ws + WS_WOUT) + (size_t)l * DM * DM, DM, DM, nullptr, nullptr, kb, nb, scr, F.lane); continue; } r -= I_OUT;
        if (r < I_G) { const int kb = r / (FF / 32), nb = r % (FF / 32);
            transpose_item<2>(a.w_gate + (size_t)l * DM * FF, DM, FF, a.ln1_g + l * DM, a.ln1_b + l * DM, (h16*)(a.ws + WS_WGU) + (size_t)l * GU * DM, DM, GU, c12 + C1GU + l * GU, c12 + C2GU + l * GU, kb, nb, scr, F.lane); continue; } r -= I_G;
        if (r < I_G) { const int kb = r / (FF / 32), nb = r % (FF / 32);
            transpose_item<3>(a.w_up + (size_t)l * DM * FF, DM, FF, a.ln1_g + l * DM, a.ln1_b + l * DM, (h16*)(a.ws + WS_WGU) + (size_t)l * GU * DM, DM, GU, c12 + C1GU + l * GU, c12 + C2GU + l * GU, kb, nb, scr, F.lane); continue; } r -= I_G;
        if (r < I_DN) { const int kb = r / 32, nb = r % 32;
            transpose_item<0>(a.w_down + (size_t)l * FF * DM, FF, DM, nullptr, nullptr, (h16*)(a.ws + WS_WDOWN) + (size_t)l * DM * FF, FF, DM, nullptr, nullptr, kb, nb, scr, F.lane); continue; } r -= I_DN;
        if (r < I_UQ) { const int kb = r / 16, nb = r % 16;
            transpose_item<0>(a.b_w_uq + (size_t)l * 192 * 384, 192, 384, a.b_q_norm + l * 192, nullptr, (h16*)(a.ws + WS_WUQ) + (size_t)l * 512 * 256, 256, 384, nullptr, nullptr, kb, nb, scr, F.lane); continue; } r -= I_UQ;
        { const int kb = r / 16, nb = r % 16;
            transpose_item<0>(a.b_w_ukv + (size_t)l * 128 * 512, 128, 512, a.b_kv_norm + l * 128, nullptr, (h16*)(a.ws + WS_WUKV) + (size_t)l * 512 * 256, 256, 512, nullptr, nullptr, kb, nb, scr, F.lane); }
    }
    const size_t gt = (size_t)blockIdx.x * 512 + F.tid, NT = (size_t)F.G * 512;
    h16* V = (h16*)(a.ws + WS_V16);
    for (size_t i = gt; i < (size_t)M * DM / 8; i += NT) {
        const f32x4 p = *(const f32x4*)(a.x + i * 8), q = *(const f32x4*)(a.x + i * 8 + 4);
        u32x4 w; w.x = pkh(p[0], p[1]); w.y = pkh(p[2], p[3]); w.z = pkh(q[0], q[1]); w.w = pkh(q[2], q[3]);
        *(u32x4*)(V + i * 8) = w;
    }
    float* rb = (float*)(a.ws + WS_ROPEB); float* rc = (float*)(a.ws + WS_ROPEC);
    for (size_t i = gt; i < (size_t)M * 48; i += NT) {
        const int row = (int)(i / 48), j = (int)(i % 48);
        const float p = (float)a.pos[row];
        if (j < 16) { const float inv = powf(10000.0f, -(float)j / 16.0f); float s, c; sincosf(p * inv, &s, &c); rb[(size_t)row * 32 + j] = c; rb[(size_t)row * 32 + 16 + j] = s; }
        else { const int jj = j - 16; const float inv = powf(10000.0f, -(float)jj / 32.0f); float s, c; sincosf(p * inv, &s, &c); rc[(size_t)row * 64 + jj] = c; rc[(size_t)row * 64 + 32 + jj] = s; }
    }
    float* par = (float*)(a.ws + WS_PAR);
    for (size_t i = gt; i < (size_t)PF_END; i += NT) {
        const int k = (int)i; float v;
        if (k < PF_LN1B) v = a.ln1_g[k - PF_LN1G]; else if (k < PF_LN2G) v = a.ln1_b[k - PF_LN1B]; else if (k < PF_LN2B) v = a.ln2_g[k - PF_LN2G]; else if (k < PF_ALNG) v = a.ln2_b[k - PF_LN2B];
        else if (k < PF_ALNB) v = a.a_ln_g[k - PF_ALNG]; else if (k < PF_ABS) v = a.a_ln_b[k - PF_ALNB]; else if (k < PF_CONVW) v = a.a_bs[k - PF_ABS]; else if (k < PF_CONVB) v = a.d_conv_w[k - PF_CONVW];
        else if (k < PF_IGB) v = a.d_conv_b[k - PF_CONVB]; else if (k < PF_FGB) v = (k - PF_IGB < 16) ? a.d_igate_b[k - PF_IGB] : 0.f; else v = a.d_fgate_b[k - PF_FGB];
        par[k] = v;
    }
    h16* aws = (h16*)(a.ws + WS_AWS);
    for (size_t i = gt; i < (size_t)DEPTH * 4 * 128 * 128; i += NT) aws[i] = (h16)a.a_ws[i];
}

struct Core { float* out; unsigned char* ws; };
__device__ __forceinline__ void final_ln(const Core& a, const Frame& F0) {
    const Frame F = fresh_frame(F0);
    const int gw = blockIdx.x * 8 + F.wave, NGW = F.G * 8;
    const h16* V = (const h16*)(a.ws + WS_V16);
    const float* par = (const float*)(a.ws + WS_PAR); const float* g = par + PF_LN2G + (DEPTH - 1) * DM; const float* b = par + PF_LN2B + (DEPTH - 1) * DM;
    for (int r = gw; r < M; r += NGW) {
        float v[16];
#pragma unroll
        for (int j = 0; j < 2; ++j) { const h16x8 h = *(const h16x8*)(V + (size_t)r * DM + j * 512 + F.lane * 8);
#pragma unroll
            for (int k = 0; k < 8; ++k) v[j * 8 + k] = (float)h[k]; }
        float s = 0.f;
#pragma unroll
        for (int k = 0; k < 16; ++k) s += v[k];
        const float mean = wave_sum(s) * (1.0f / DM); float q = 0.f;
#pragma unroll
        for (int k = 0; k < 16; ++k) { v[k] -= mean; q += v[k] * v[k]; }
        const float rs = rsqrtf(wave_sum(q) * (1.0f / DM) + LN_EPS);
#pragma unroll
        for (int j = 0; j < 2; ++j)
#pragma unroll
            for (int k4 = 0; k4 < 2; ++k4) { const int c = j * 512 + F.lane * 8 + k4 * 4;
                const f32x4 gg = *(const f32x4*)(g + c), bb = *(const f32x4*)(b + c);
                f32x4 o; o[0] = v[j * 8 + k4 * 4 + 0] * rs * gg[0] + bb[0]; o[1] = v[j * 8 + k4 * 4 + 1] * rs * gg[1] + bb[1]; o[2] = v[j * 8 + k4 * 4 + 2] * rs * gg[2] + bb[2]; o[3] = v[j * 8 + k4 * 4 + 3] * rs * gg[3] + bb[3];
                *(f32x4*)(a.out + (size_t)r * DM + c) = o; }
    }
}

#ifndef EN_C
#define EN_C 1
#endif
#ifndef EN_B
#define EN_B 1
#endif
#ifndef EN_D
#define EN_D 1
#endif
#ifndef EN_B1
#define EN_B1 1
#endif
#ifndef EN_B2
#define EN_B2 1
#endif
#ifndef EN_A
#define EN_A 1
#endif
#ifndef ZERO_FROM
#define ZERO_FROM 1024
#endif
#ifndef LOOP_START
#define LOOP_START 0
#endif
#ifndef LOOP_DEPTH
#define LOOP_DEPTH DEPTH
#endif
#ifndef EN_P0
#define EN_P0 1
#endif
#ifndef EN_P1
#define EN_P1 1
#endif
#ifndef EN_P3
#define EN_P3 1
#endif
#ifndef EN_P4
#define EN_P4 1
#endif
#ifndef EN_P5
#define EN_P5 1
#endif
#ifndef EN_PF
#define EN_PF 1
#endif

typedef short v4i16_t __attribute__((ext_vector_type(4)));
__device__ __forceinline__ f32x16 mfma32(h16x8 a, h16x8 b, f32x16 c) { return __builtin_amdgcn_mfma_f32_32x32x16_f16(a, b, c, 0, 0, 0); }
__device__ __forceinline__ int crow(int i, int hh) { return (i & 3) + 8 * (i >> 2) + 4 * hh; }
template <bool NAT>
__device__ __forceinline__ h16x8 tr_frag(const LAS h16* T, int pitch, int k0, int c0, int lane) {
    const int i = lane & 15, g4 = lane >> 4, hh = g4 >> 1;
    const int ra = k0 + (NAT ? 8 * hh : 4 * hh) + (i >> 2), rb = ra + (NAT ? 4 : 8);
    const int cc = c0 + 16 * (g4 & 1) + 4 * (i & 3);
    const v4i16_t x = __builtin_amdgcn_ds_read_tr16_b64_v4i16((LAS v4i16_t*)(T + ra * pitch + cc));
    const v4i16_t y = __builtin_amdgcn_ds_read_tr16_b64_v4i16((LAS v4i16_t*)(T + rb * pitch + cc));
    typedef short s16x8 __attribute__((ext_vector_type(8)));
    const s16x8 r = {x[0], x[1], x[2], x[3], y[0], y[1], y[2], y[3]};
    return __builtin_bit_cast(h16x8, r);
}
__device__ __forceinline__ float gelu_erf(float x) { return 0.5f * x * (1.0f + erff(x * 0.7071067811865476f)); }

constexpr int GM_PITCH = 288;
template <int l>
__device__ __forceinline__ void gmlp_unit(const Core& C, const Frame& F0, int unit) {
    const Frame F = fresh_frame(F0);
    const h16* Z = (const h16*)(C.ws + WS_Z); h16* Y = (h16*)((unsigned char*)C.out + OUT_Y);
    const float* par = (const float*)(C.ws + WS_PAR);
    const h16* W = (const h16*)(C.ws + WS_AWS) + (size_t)l * 4 * 128 * 128;
    LAS h16* Vt = (LAS h16*)F.lds;
    const int row0 = (unit >> 4) * SEQ + (unit & 15) * 128;
    const int lane = F.lane, w = F.wave;
    {
        const f32x4 gg = *(const f32x4*)(par + PF_ALNG + l * GW + 4 * lane), bb = *(const f32x4*)(par + PF_ALNB + l * GW + 4 * lane);
#pragma unroll 4
        for (int i = 0; i < 16; ++i) {
            const int t = w * 16 + i;
            const h16x4 hv = *(const h16x4*)(Z + (size_t)(row0 + t) * ZP + ZC_A + 256 + 4 * lane);
            float x[4]; float s = 0.f;
#pragma unroll
            for (int j = 0; j < 4; ++j) { x[j] = gelu_erf((float)hv[j]); s += x[j]; }
            const float mean = wave_sum(s) * (1.0f / 256.0f); float q = 0.f;
#pragma unroll
            for (int j = 0; j < 4; ++j) { x[j] -= mean; q += x[j] * x[j]; }
            const float rs = rsqrtf(wave_sum(q) * (1.0f / 256.0f) + LN_EPS);
            u32x2 o; o.x = pkh(x[0] * rs * gg[0] + bb[0], x[1] * rs * gg[1] + bb[1]); o.y = pkh(x[2] * rs * gg[2] + bb[2], x[3] * rs * gg[3] + bb[3]);
            *(LAS u32x2*)(Vt + t * GM_PITCH + 4 * lane) = o;
        }
    }
    __syncthreads();
    {
        const int h = w >> 1, db = w & 1, tl = lane & 31, hh = lane >> 5;
        const float* bs = par + PF_ABS + (l * 4 + h) * 128;
#pragma unroll 1
        for (int tb = 0; tb < 4; ++tb) {
            const int t = 32 * tb + tl;
            f32x16 acc;
#pragma unroll
            for (int i = 0; i < 16; ++i) acc[i] = 0.f;
            const h16* wrow = W + ((size_t)h * 128 + t) * 128 + 8 * hh;
            for (int ks = 0; ks < 2 * (tb + 1); ++ks) {
                const h16x8 a = tr_frag<true>(Vt, GM_PITCH, 16 * ks, h * 64 + 32 * db, lane);
                h16x8 bw = *(const h16x8*)(wrow + 16 * ks);
                const int s0 = 16 * ks + 8 * hh;
#pragma unroll
                for (int j = 0; j < 8; ++j) if (s0 + j > t) bw[j] = (h16)0.f;
                acc = mfma32(a, bw, acc);
            }
            const float bias = bs[t];
            const size_t zoff = (size_t)(row0 + t) * ZP + ZC_A + h * 64 + 32 * db + 4 * hh;
            const size_t yoff = (size_t)(row0 + t) * DM + 0 + h * 64 + 32 * db + 4 * hh;
#pragma unroll
            for (int g = 0; g < 4; ++g) {
                const h16x4 uu = *(const h16x4*)(Z + zoff + 8 * g);
                u32x2 o; o.x = pkh(gelu_erf((float)uu[0]) * (acc[4 * g + 0] + bias), gelu_erf((float)uu[1]) * (acc[4 * g + 1] + bias));
                o.y = pkh(gelu_erf((float)uu[2]) * (acc[4 * g + 2] + bias), gelu_erf((float)uu[3]) * (acc[4 * g + 3] + bias));
                *(u32x2*)(Y + yoff + 8 * g) = o;
            }
        }
    }
    __syncthreads();
}


template <int DQ>
__device__ __forceinline__ void attn_tile(const LAS h16* Kt, int kpitch, const LAS h16* Vt, int vpitch, const h16x8 (&qf)[DQ / 16], float& m, float& ls, f32x16 (&o)[2],
                                          bool masked, int lo, int hi, int lane) {
    const int kr = lane & 31, hh = lane >> 5;
    f32x16 sc;
#pragma unroll
    for (int i = 0; i < 16; ++i) sc[i] = 0.f;
#pragma unroll
    for (int ds = 0; ds < DQ / 16; ++ds) { const h16x8 a = *(const LAS h16x8*)(Kt + kr * kpitch + 16 * ds + 8 * hh); sc = mfma32(a, qf[ds], sc); }
    if (masked) {
#pragma unroll
        for (int i = 0; i < 16; ++i) { const int kk = crow(i, hh); if (kk < lo || kk > hi) sc[i] = -INFINITY; }
    }
    float mx = sc[0];
#pragma unroll
    for (int i = 1; i < 16; ++i) mx = fmaxf(mx, sc[i]);
    mx = fmaxf(mx, __shfl_xor(mx, 32));
    const float mn = fmaxf(m, mx);
    const float alpha = __builtin_amdgcn_exp2f(m - mn);
    float ps = 0.f;
#pragma unroll
    for (int i = 0; i < 16; ++i) { sc[i] = __builtin_amdgcn_exp2f(sc[i] - mn); ps += sc[i]; }
    ls = ls * alpha + ps; m = mn;
#pragma unroll
    for (int i = 0; i < 16; ++i) { o[0][i] *= alpha; o[1][i] *= alpha; }
    h16x8 pf[2];
#pragma unroll
    for (int s2 = 0; s2 < 2; ++s2)
#pragma unroll
        for (int j = 0; j < 8; ++j) pf[s2][j] = (h16)sc[8 * s2 + j];
#pragma unroll
    for (int db = 0; db < 2; ++db)
#pragma unroll
        for (int s2 = 0; s2 < 2; ++s2) { const h16x8 a = tr_frag<false>(Vt, vpitch, 16 * s2, 32 * db, lane); o[db] = mfma32(a, pf[s2], o[db]); }
}

constexpr int DK_PITCH = 72, DV_PITCH = 96;
constexpr int DIL_V_OFF = 384 * DK_PITCH * 2;
constexpr float QK_SCALE64 = 0.125f * 1.4426950408889634f;
template <int l>
__device__ __forceinline__ void dilated_unit(const Core& C, const Frame& F0, int unit) {
    const Frame F = fresh_frame(F0);
    const h16* Z = (const h16*)(C.ws + WS_Z); const float* rc = (const float*)(C.ws + WS_ROPEC);
    h16* DP = (h16*)((unsigned char*)C.out + OUT_DP); float* DL = (float*)((unsigned char*)C.out + OUT_DL);
    LAS h16* Kt = (LAS h16*)F.lds; LAS h16* Vt = (LAS h16*)(F.lds + DIL_V_OFF);
    const int br = unit >> 10, rem = unit & 1023, b = rem >> 5, h = (rem >> 3) & 3, x = rem & 7;
    const int d = br == 0 ? 1 : br == 1 ? 4 : 16;
    const int lane = F.lane, w = F.wave, tid = F.tid;
    const int tok0 = b * SEQ;
    int res0, U0, nrows;
    if (br == 0) { res0 = 0; U0 = 256 * x; nrows = 384; } else if (br == 1) { res0 = x >> 1; U0 = 256 * (x & 1); nrows = 384; } else { res0 = 2 * x; U0 = 128; nrows = 256; }
    const int segbase = U0 - 128;
    for (int it = tid; it < nrows * 4; it += 512) {
        const int ri = it >> 2, c4 = it & 3;
        int up, res; if (br == 2) { up = ri & 127; res = res0 + (ri >> 7); } else { up = segbase + ri; res = res0; }
        if (up < 0) continue;
        const int tok = tok0 + up * d + res;
        const h16* src = Z + (size_t)tok * ZP + ZC_C + 256 + h * 64 + 8 * c4;
        const h16x8 k1 = *(const h16x8*)src, k2 = *(const h16x8*)(src + 32);
        const float* cs = rc + (size_t)tok * 64 + 8 * c4;
        const f32x4 c0 = *(const f32x4*)cs, c1 = *(const f32x4*)(cs + 4), s0 = *(const f32x4*)(cs + 32), s1 = *(const f32x4*)(cs + 36);
        h16x8 o1, o2;
#pragma unroll
        for (int j = 0; j < 8; ++j) { const float cc = j < 4 ? c0[j & 3] : c1[j & 3], ss = j < 4 ? s0[j & 3] : s1[j & 3]; const float a = (float)k1[j], bq = (float)k2[j];
            o1[j] = (h16)(a * cc - bq * ss); o2[j] = (h16)(a * ss + bq * cc); }
        *(LAS h16x8*)(Kt + ri * DK_PITCH + 8 * c4) = o1; *(LAS h16x8*)(Kt + ri * DK_PITCH + 32 + 8 * c4) = o2;
    }
    for (int it = tid; it < nrows * 8; it += 512) {
        const int ri = it >> 3, c8 = it & 7;
        int up, res; if (br == 2) { up = ri & 127; res = res0 + (ri >> 7); } else { up = segbase + ri; res = res0; }
        if (up < 0) continue;
        const int tok = tok0 + up * d + res;
        *(LAS h16x8*)(Vt + ri * DV_PITCH + 8 * c8) = *(const h16x8*)(Z + (size_t)tok * ZP + ZC_C + 512 + h * 64 + 8 * c8);
    }
    int res, jblk, rowoff;
    if (br == 2) { res = res0 + (w >> 2); jblk = w & 3; rowoff = 128 * (w >> 2); } else { res = res0; jblk = (U0 >> 5) + w; rowoff = -segbase; }
    const int qi = lane & 31, hh = lane >> 5;
    const int qtok = tok0 + (32 * jblk + qi) * d + res;
    h16x8 qf[4];
    {
        const h16* qsrc = Z + (size_t)qtok * ZP + ZC_C + h * 64 + 8 * hh;
        h16x8 qa[4];
#pragma unroll
        for (int ds = 0; ds < 4; ++ds) qa[ds] = *(const h16x8*)(qsrc + 16 * ds);
        const float* cs = rc + (size_t)qtok * 64 + 8 * hh;
#pragma unroll
        for (int ds = 0; ds < 2; ++ds) {
            const f32x4 c0 = *(const f32x4*)(cs + 16 * ds), c1 = *(const f32x4*)(cs + 16 * ds + 4), s0 = *(const f32x4*)(cs + 32 + 16 * ds), s1 = *(const f32x4*)(cs + 32 + 16 * ds + 4);
#pragma unroll
            for (int j = 0; j < 8; ++j) { const float cc = j < 4 ? c0[j & 3] : c1[j & 3], ss = j < 4 ? s0[j & 3] : s1[j & 3]; const float a = (float)qa[ds][j], bq = (float)qa[ds + 2][j];
                qf[ds][j] = (h16)((a * cc - bq * ss) * QK_SCALE64); qf[ds + 2][j] = (h16)((a * ss + bq * cc) * QK_SCALE64); }
        }
    }
    __syncthreads();
    float m = -INFINITY, ls = 0.f; f32x16 o[2];
#pragma unroll
    for (int i = 0; i < 16; ++i) { o[0][i] = 0.f; o[1][i] = 0.f; }
#pragma unroll 1
    for (int tt = 0; tt < 5; ++tt) {
        const int ub = 32 * (jblk - 4 + tt);
        if (ub < 0) continue;
        const int rowb = ub + rowoff;
        const bool masked = (tt == 0) || (tt == 4);
        const int lo = tt == 0 ? qi : -1, hi = tt == 4 ? qi : 64;
        attn_tile<64>(Kt + rowb * DK_PITCH, DK_PITCH, Vt + rowb * DV_PITCH, DV_PITCH, qf, m, ls, o, masked, lo, hi, lane);
    }
    const float lt = ls + __shfl_xor(ls, 32);
    const float inv = 1.0f / lt;
    h16* dst = DP + ((size_t)qtok * 3 + br) * 256 + h * 64 + 4 * hh;
#pragma unroll
    for (int db = 0; db < 2; ++db)
#pragma unroll
        for (int g = 0; g < 4; ++g) { u32x2 v; v.x = pkh(o[db][4 * g] * inv, o[db][4 * g + 1] * inv); v.y = pkh(o[db][4 * g + 2] * inv, o[db][4 * g + 3] * inv);
            *(u32x2*)(dst + 32 * db + 8 * g) = v; }
    if (hh == 0) DL[((size_t)qtok * 3 + br) * 4 + h] = m + __builtin_amdgcn_logf(lt);
    __syncthreads();
}
__device__ __forceinline__ void dil_combine(const Core& C, const Frame& F0) {
    const Frame F = fresh_frame(F0);
    const h16* DP = (const h16*)((unsigned char*)C.out + OUT_DP); const float* DL = (const float*)((unsigned char*)C.out + OUT_DL); h16* Y = (h16*)((unsigned char*)C.out + OUT_Y);
    const size_t gt = (size_t)blockIdx.x * 512 + F.tid, NT = (size_t)F.G * 512;
    for (size_t it = gt; it < (size_t)M * 32; it += NT) {
        const size_t tok = it >> 5; const int c8 = (int)(it & 31), h = c8 >> 3;
        const float l0 = DL[(tok * 3 + 0) * 4 + h], l1 = DL[(tok * 3 + 1) * 4 + h], l2 = DL[(tok * 3 + 2) * 4 + h];
        const float mx = fmaxf(l0, fmaxf(l1, l2));
        float w0 = __builtin_amdgcn_exp2f(l0 - mx), w1 = __builtin_amdgcn_exp2f(l1 - mx), w2 = __builtin_amdgcn_exp2f(l2 - mx);
        const float inv = 1.0f / (w0 + w1 + w2); w0 *= inv; w1 *= inv; w2 *= inv;
        const h16x8 a0 = *(const h16x8*)(DP + (tok * 3 + 0) * 256 + 8 * c8), a1 = *(const h16x8*)(DP + (tok * 3 + 1) * 256 + 8 * c8), a2 = *(const h16x8*)(DP + (tok * 3 + 2) * 256 + 8 * c8);
        h16x8 r;
#pragma unroll
        for (int j = 0; j < 8; ++j) r[j] = (h16)((float)a0[j] * w0 + (float)a1[j] * w1 + (float)a2[j] * w2);
        *(h16x8*)(Y + tok * DM + 512 + 8 * c8) = r;
    }
}


__device__ __forceinline__ void mla_krope(const Core& C, const Frame& F0) {
    const Frame F = fresh_frame(F0);
    const h16* Z = (const h16*)(C.ws + WS_Z); const float* rb = (const float*)(C.ws + WS_ROPEB); h16* Kf = (h16*)(C.ws + WS_KF);
    const size_t gt = (size_t)blockIdx.x * 512 + F.tid, NT = (size_t)F.G * 512;
    for (size_t it = gt; it < (size_t)M * 2; it += NT) {
        const size_t tok = it >> 1; const int c = (int)(it & 1);
        const h16x8 x1 = *(const h16x8*)(Z + tok * ZP + ZC_KR + 8 * c), x2 = *(const h16x8*)(Z + tok * ZP + ZC_KR + 16 + 8 * c);
        const float* cs = rb + tok * 32 + 8 * c;
        h16x8 o1, o2;
#pragma unroll
        for (int j = 0; j < 8; ++j) { const float cc = cs[j], ss = cs[16 + j], a = (float)x1[j], b = (float)x2[j]; o1[j] = (h16)(a * cc - b * ss); o2[j] = (h16)(a * ss + b * cc); }
#pragma unroll
        for (int hd = 0; hd < 4; ++hd) { *(h16x8*)(Kf + tok * 384 + hd * 96 + 64 + 8 * c) = o1; *(h16x8*)(Kf + tok * 384 + hd * 96 + 80 + 8 * c) = o2; }
    }
}
constexpr int MK_PITCH = 104, MV_PITCH = 96;
constexpr int MLA_KB = 64 * MK_PITCH * 2, MLA_VB = 64 * MV_PITCH * 2;
__device__ __forceinline__ void mla_qblock(const Core& C, const Frame& F0, int b, int h, int qblk) {
    const Frame F = fresh_frame(F0);
    const h16* Qm = (const h16*)(C.ws + WS_Q); const h16* Kf = (const h16*)(C.ws + WS_KF); const h16* Vm = (const h16*)(C.ws + WS_VM); h16* Y = (h16*)((unsigned char*)C.out + OUT_Y);
    const int lane = F.lane, w = F.wave, tid = F.tid, qi = lane & 31, hh = lane >> 5;
    const int tok0 = b * SEQ, q0w = 256 * qblk + 32 * w;
    h16x8 qf[6];
    { const h16* qsrc = Qm + (size_t)(tok0 + q0w + qi) * 384 + h * 96 + 8 * hh;
#pragma unroll
      for (int ds = 0; ds < 6; ++ds) qf[ds] = *(const h16x8*)(qsrc + 16 * ds); }
    float m = -INFINITY, ls = 0.f; f32x16 o[2];
#pragma unroll
    for (int i = 0; i < 16; ++i) { o[0][i] = 0.f; o[1][i] = 0.f; }
    const int nkt = 4 * (qblk + 1);
    const int kr0 = tid / 12, kc0 = tid % 12, kr1 = (tid + 512) / 12, kc1 = (tid + 512) % 12, vr = tid >> 3, vc = tid & 7;
    const bool has2 = tid < 256;
    h16x8 ka, kb2, va;
    { const size_t t0 = tok0;
      ka = *(const h16x8*)(Kf + (t0 + kr0) * 384 + h * 96 + 8 * kc0); if (has2) kb2 = *(const h16x8*)(Kf + (t0 + kr1) * 384 + h * 96 + 8 * kc1);
      va = *(const h16x8*)(Vm + (t0 + vr) * 256 + h * 64 + 8 * vc); }
    {
        LAS h16* Kt = (LAS h16*)F.lds; LAS h16* Vt = (LAS h16*)(F.lds + 2 * MLA_KB);
        *(LAS h16x8*)(Kt + kr0 * MK_PITCH + 8 * kc0) = ka; if (has2) *(LAS h16x8*)(Kt + kr1 * MK_PITCH + 8 * kc1) = kb2;
        *(LAS h16x8*)(Vt + vr * MV_PITCH + 8 * vc) = va;
    }
    __syncthreads();
#pragma unroll 1
    for (int kt = 0; kt < nkt; ++kt) {
        const int cur = kt & 1;
        if (kt + 1 < nkt) { const size_t t0 = tok0 + 64 * (kt + 1);
            ka = *(const h16x8*)(Kf + (t0 + kr0) * 384 + h * 96 + 8 * kc0); if (has2) kb2 = *(const h16x8*)(Kf + (t0 + kr1) * 384 + h * 96 + 8 * kc1);
            va = *(const h16x8*)(Vm + (t0 + vr) * 256 + h * 64 + 8 * vc); }
        const LAS h16* Kt = (const LAS h16*)(F.lds + cur * MLA_KB); const LAS h16* Vt = (const LAS h16*)(F.lds + 2 * MLA_KB + cur * MLA_VB);
#pragma unroll
        for (int half = 0; half < 2; ++half) {
            const int kbase = 64 * kt + 32 * half;
            if (kbase <= q0w + 31) {
                const bool masked = kbase + 31 > q0w;
                attn_tile<96>(Kt + 32 * half * MK_PITCH, MK_PITCH, Vt + 32 * half * MV_PITCH, MV_PITCH, qf, m, ls, o, masked, -1, q0w + qi - kbase, lane);
            }
        }
        if (kt + 1 < nkt) {
            LAS h16* Kn = (LAS h16*)(F.lds + (cur ^ 1) * MLA_KB); LAS h16* Vn = (LAS h16*)(F.lds + 2 * MLA_KB + (cur ^ 1) * MLA_VB);
            *(LAS h16x8*)(Kn + kr0 * MK_PITCH + 8 * kc0) = ka; if (has2) *(LAS h16x8*)(Kn + kr1 * MK_PITCH + 8 * kc1) = kb2;
            *(LAS h16x8*)(Vn + vr * MV_PITCH + 8 * vc) = va;
        }
        __syncthreads();
    }
    const float lt = ls + __shfl_xor(ls, 32);
    const float inv = 1.0f / lt;
    h16* dst = Y + (size_t)(tok0 + q0w + qi) * DM + 256 + h * 64 + 4 * hh;
#pragma unroll
    for (int db = 0; db < 2; ++db)
#pragma unroll
        for (int g = 0; g < 4; ++g) { u32x2 v; v.x = pkh(o[db][4 * g] * inv, o[db][4 * g + 1] * inv); v.y = pkh(o[db][4 * g + 2] * inv, o[db][4 * g + 3] * inv);
            *(u32x2*)(dst + 32 * db + 8 * g) = v; }
}
__device__ __forceinline__ void mla_unit(const Core& C, const Frame& F, int unit) {
    const int b = unit >> 4, h = (unit >> 2) & 3, p = unit & 3;
    mla_qblock(C, F, b, h, 7 - p);
    mla_qblock(C, F, b, h, p);
}


constexpr int ML_QP = 72, ML_VP = 96;
constexpr int ML_Q = 0, ML_K = ML_Q + 128 * ML_QP * 2, ML_KW = ML_K + 128 * ML_QP * 2, ML_V = ML_KW + 128 * ML_VP * 2, ML_C = ML_V + 128 * ML_VP * 2, ML_F = ML_C + 64 * ML_VP * 2;
constexpr float LOG2E = 1.4426950408889634f;
template <int l>
__device__ __forceinline__ void mlstm_unit(const Core& C, const Frame& F0, int unit) {
    const Frame F = fresh_frame(F0);
    const h16* Z = (const h16*)(C.ws + WS_Z); h16* Y = (h16*)((unsigned char*)C.out + OUT_Y); const float* par = (const float*)(C.ws + WS_PAR);
    const int b = unit >> 2, h = unit & 3, lane = F.lane, w = F.wave, tid = F.tid, qi = lane & 31, hh = lane >> 5;
    LAS h16* Qt = (LAS h16*)(F.lds + ML_Q); LAS h16* Kt = (LAS h16*)(F.lds + ML_K); LAS h16* KWt = (LAS h16*)(F.lds + ML_KW); LAS h16* Vt = (LAS h16*)(F.lds + ML_V); LAS h16* Cs = (LAS h16*)(F.lds + ML_C);
    LAS float* gk = (LAS float*)(F.lds + ML_F); LAS float* Mt = gk + 128; LAS float* bc = gk + 256; LAS float* nvec = gk + 384; LAS float* mrun = gk + 448;
    const float* cw = par + PF_CONVW + l * 4 * 512; const float* cb = par + PF_CONVB + l * 512;
    const float igb = par[PF_IGB + l * 4 + h], fgb = par[PF_FGB + l * 4 + h];
    for (int i = tid; i < 64 * ML_VP; i += 512) Cs[i] = (h16)0.f;
    if (tid < 64) nvec[tid] = 0.f;
    if (tid == 0) mrun[0] = 0.f;
    f32x16 Cacc;
#pragma unroll
    for (int i = 0; i < 16; ++i) Cacc[i] = 0.f;
    __syncthreads();
#pragma unroll 1
    for (int c = 0; c < 16; ++c) {
        const int tokc = b * SEQ + 128 * c;
#pragma unroll 1
        for (int it = tid; it < 2048; it += 512) {
            const int isk = it >> 10, r = (it >> 3) & 127, c8 = it & 7;
            const int col = isk * 256 + h * 64 + 8 * c8;
            float acc[8];
            { const f32x4 b0 = *(const f32x4*)(cb + col), b1 = *(const f32x4*)(cb + col + 4);
#pragma unroll
              for (int j = 0; j < 4; ++j) { acc[j] = b0[j]; acc[4 + j] = b1[j]; } }
#pragma unroll
            for (int j = 0; j < 4; ++j) {
                const int pos = 128 * c + r - 3 + j;
                if (pos >= 0) {
                    const h16x8 xv = *(const h16x8*)(Z + (size_t)(b * SEQ + pos) * ZP + ZC_D + col);
                    const f32x4 w0 = *(const f32x4*)(cw + j * 512 + col), w1 = *(const f32x4*)(cw + j * 512 + col + 4);
#pragma unroll
                    for (int e = 0; e < 4; ++e) { acc[e] += w0[e] * (float)xv[e]; acc[4 + e] += w1[e] * (float)xv[4 + e]; }
                }
            }
            h16x8 ov; const float sc = isk ? 0.125f : 1.0f;
#pragma unroll
            for (int e = 0; e < 8; ++e) { const float y = acc[e]; ov[e] = (h16)(y * sc * __builtin_amdgcn_rcpf(1.0f + __builtin_amdgcn_exp2f(-y * LOG2E))); }
            *(LAS h16x8*)((isk ? Kt : Qt) + r * ML_QP + 8 * c8) = ov;
        }
#pragma unroll 1
        for (int it = tid; it < 1024; it += 512) { const int r = it >> 3, c8 = it & 7;
            *(LAS h16x8*)(Vt + r * ML_VP + 8 * c8) = *(const h16x8*)(Z + (size_t)(tokc + r) * ZP + ZC_D + 512 + h * 64 + 8 * c8); }
        if (w == 0) {
            const float mr = mrun[0];
            const size_t z0 = (size_t)(tokc + 2 * lane) * ZP + ZC_GATE + h;
            const float i0 = (float)Z[z0] + igb, i1 = (float)Z[z0 + ZP] + igb, f0 = (float)Z[z0 + 4] + fgb, f1 = (float)Z[z0 + ZP + 4] + fgb;
            const float fl0 = fminf(f0, 0.f) - log1pf(expf(-fabsf(f0))), fl1 = fminf(f1, 0.f) - log1pf(expf(-fabsf(f1)));
            float sc = fl0 + fl1;
#pragma unroll
            for (int o = 1; o < 64; o <<= 1) { const float t = __shfl_up(sc, o); if (lane >= o) sc += t; }
            const float bc1 = sc, bc0 = sc - fl1;
            const float g0 = i0 - bc0, g1 = i1 - bc1;
            float pm = fmaxf(g0, g1);
#pragma unroll
            for (int o = 1; o < 64; o <<= 1) { const float t = __shfl_up(pm, o); if (lane >= o) pm = fmaxf(pm, t); }
            float pprev = __shfl_up(pm, 1); if (lane == 0) pprev = -INFINITY;
            const float pm0 = fmaxf(pprev, g0), pm1 = pm;
            gk[2 * lane] = g0; gk[2 * lane + 1] = g1; bc[2 * lane] = bc0; bc[2 * lane + 1] = bc1;
            Mt[2 * lane] = fmaxf(mr, pm0); Mt[2 * lane + 1] = fmaxf(mr, pm1);
        }
        __syncthreads();
        {
            const float Mend = Mt[127];
            for (int it = tid; it < 1024; it += 512) { const int r = it >> 3, c8 = it & 7; const float wk = __builtin_amdgcn_exp2f((gk[r] - Mend) * LOG2E);
                const h16x8 kv = *(const LAS h16x8*)(Kt + r * ML_QP + 8 * c8); h16x8 o;
#pragma unroll
                for (int e = 0; e < 8; ++e) o[e] = (h16)((float)kv[e] * wk);
                *(LAS h16x8*)(KWt + r * ML_VP + 8 * c8) = o; }
            const int tb = w >> 1, dvb = w & 1, t = 32 * tb + qi;
            const float mr = mrun[0], Mtt = Mt[t], bct = bc[t];
            h16x8 qf[4];
#pragma unroll
            for (int ds = 0; ds < 4; ++ds) qf[ds] = *(const LAS h16x8*)(Qt + t * ML_QP + 16 * ds + 8 * hh);
            f32x16 num, inter; float den = 0.f;
#pragma unroll
            for (int i = 0; i < 16; ++i) { num[i] = 0.f; inter[i] = 0.f; }
#pragma unroll 1
            for (int sb = 0; sb <= tb; ++sb) {
                f32x16 sc;
#pragma unroll
                for (int i = 0; i < 16; ++i) sc[i] = 0.f;
#pragma unroll
                for (int ds = 0; ds < 4; ++ds) { const h16x8 a = *(const LAS h16x8*)(Kt + (32 * sb + qi) * ML_QP + 16 * ds + 8 * hh); sc = mfma32(a, qf[ds], sc); }
                float ps = 0.f;
#pragma unroll
                for (int i = 0; i < 16; ++i) { const int kk = crow(i, hh); const float wgt = __builtin_amdgcn_exp2f((gk[32 * sb + kk] - Mtt) * LOG2E);
                    float p = sc[i] * wgt; if (sb == tb && kk > qi) p = 0.f; sc[i] = p; ps += p; }
                den += ps;
                h16x8 pf[2];
#pragma unroll
                for (int s2 = 0; s2 < 2; ++s2)
#pragma unroll
                    for (int j = 0; j < 8; ++j) pf[s2][j] = (h16)sc[8 * s2 + j];
#pragma unroll
                for (int s2 = 0; s2 < 2; ++s2) { const h16x8 a = tr_frag<false>(Vt + 32 * sb * ML_VP, ML_VP, 16 * s2, 32 * dvb, lane); num = mfma32(a, pf[s2], num); }
            }
            float dq = 0.f;
#pragma unroll
            for (int ks = 0; ks < 4; ++ks) { const h16x8 a = tr_frag<true>(Cs, ML_VP, 16 * ks, 32 * dvb, lane); inter = mfma32(a, qf[ks], inter);
#pragma unroll
                for (int j = 0; j < 8; ++j) dq += (float)qf[ks][j] * nvec[16 * ks + 8 * hh + j]; }
            den += __shfl_xor(den, 32); dq += __shfl_xor(dq, 32);
            const float scl = __builtin_amdgcn_exp2f((mr - Mtt) * LOG2E);
            const float dtot = den + scl * dq;
            const float dnm = fmaxf(fabsf(dtot), __builtin_amdgcn_exp2f(-(bct + Mtt) * LOG2E));
            const float inv = 1.0f / dnm;
            const size_t zo = (size_t)(tokc + t) * ZP + ZC_D + 768 + h * 64 + 32 * dvb + 4 * hh;
            h16* dst = Y + (size_t)(tokc + t) * DM + 768 + h * 64 + 32 * dvb + 4 * hh;
#pragma unroll
            for (int g = 0; g < 4; ++g) { const h16x4 og = *(const h16x4*)(Z + zo + 8 * g); float r4[4];
#pragma unroll
                for (int j = 0; j < 4; ++j) { const float hv = (num[4 * g + j] + scl * inter[4 * g + j]) * inv; r4[j] = hv * __builtin_amdgcn_rcpf(1.0f + __builtin_amdgcn_exp2f(-(float)og[j] * LOG2E)); }
                u32x2 v; v.x = pkh(r4[0], r4[1]); v.y = pkh(r4[2], r4[3]); *(u32x2*)(dst + 8 * g) = v; }
        }
        __syncthreads();
        {
            const float mr = mrun[0], Mend = Mt[127], bend = bc[127];
            const float decay = __builtin_amdgcn_exp2f((mr - Mend) * LOG2E);
            if (w < 4) {
                const int dkb = w >> 1, dvb = w & 1;
#pragma unroll
                for (int i = 0; i < 16; ++i) Cacc[i] *= decay;
#pragma unroll
                for (int ks = 0; ks < 8; ++ks) { const h16x8 a = tr_frag<true>(KWt, ML_VP, 16 * ks, 32 * dkb, lane), bq = tr_frag<true>(Vt, ML_VP, 16 * ks, 32 * dvb, lane); Cacc = mfma32(a, bq, Cacc); }
            } else if (w == 4) {
                float sacc = 0.f;
#pragma unroll 8
                for (int r = 0; r < 128; ++r) sacc += (float)KWt[r * ML_VP + lane];
                nvec[lane] = decay * nvec[lane] + sacc;
            }
            __syncthreads();
            if (w < 4) { const int dkb = w >> 1, dvb = w & 1;
#pragma unroll
                for (int i = 0; i < 16; ++i) Cs[(32 * dkb + crow(i, hh)) * ML_VP + 32 * dvb + qi] = (h16)Cacc[i]; }
            if (tid == 320) mrun[0] = bend + Mend;
        }
        __syncthreads();
    }
}

template <int l>
__device__ __forceinline__ void layer_body(const Core& C, const Frame& F, const XcdBarrier& bar, const int lo, const int hi, const int use_bar) {
#define IN(k) (lo <= (k) && (k) < hi)
#define SEAM(k) do { if (use_bar && IN(k) && IN((k) + 1)) xcd_barrier(bar); } while (0)
    h16* V16 = (h16*)(C.ws + WS_V16); h16* Z = (h16*)(C.ws + WS_Z); h16* Hb = (h16*)(C.ws + WS_Z); h16* Y = (h16*)((unsigned char*)C.out + OUT_Y);
    float* c12 = (float*)(C.ws + WS_C12); float* stats = (float*)(C.ws + WS_STATS); float* ssq = (float*)(C.ws + WS_SSQ); const float* par = (const float*)(C.ws + WS_PAR);
    {
        const int pb = 1 + 6 * l;
        float* st_ln1 = stats + (size_t)(2 * l) * 2 * M; float* st_ln2 = stats + (size_t)(2 * l + 1) * 2 * M;
        const float* st_prev = l ? stats + (size_t)(2 * l - 1) * 2 * M : nullptr;
        if (IN(pb) && EN_P1) {
            pg8::Gemm g{V16, (const h16*)(C.ws + WS_WIN) + (size_t)l * ZP * DM, DM, DM, M, ZP, DM};
            pg8::StaticOrder S; S.init(M, ZP, F.G, (int)blockIdx.x);
            pg8::EpiIn E{Z, c12 + C1IN + l * ZP, c12 + C2IN + l * ZP, pg8::RowStats{st_prev, st_prev ? st_prev + M : nullptr}, l == 0 ? 1 : 0, ssq + (size_t)(2 * l) * M, ssq + (size_t)(2 * l + 1) * M};
            pg8::gemm_phase(F.lds, F.wave, g, S, E);
        }
        SEAM(pb);
        if (IN(pb + 1)) {
            if (ZERO_FROM < DM) { const Frame Fz = fresh_frame(F); const size_t gt = (size_t)blockIdx.x * 512 + Fz.tid, NT = (size_t)F.G * 512; constexpr int ZW = (DM - ZERO_FROM) / 8 > 0 ? (DM - ZERO_FROM) / 8 : 1;
            for (size_t i = gt; i < (size_t)M * (DM - ZERO_FROM) / 8; i += NT) { const size_t r = i / ZW, c = i % ZW; *(u32x4*)(Y + r * DM + ZERO_FROM + c * 8) = (u32x4){0u, 0u, 0u, 0u}; } }
            if (EN_D) for (int u = blockIdx.x; u < NB * 4; u += F.G) mlstm_unit<l>(C, F, u);
            if (EN_A) for (int u = blockIdx.x; u < NB * 16; u += F.G) gmlp_unit<l>(C, F, u);
            if (EN_C) for (int u = blockIdx.x; u < 3072; u += F.G) dilated_unit<l>(C, F, u);
            if (EN_B && EN_B1) {
                mla_krope(C, F);
                { pg8::Gemm g{Z + ZC_CQ, (const h16*)(C.ws + WS_WUQ) + (size_t)l * 512 * 256, ZP, 256, M, 512, 256};
                  pg8::StaticOrder S; S.init(M, 512, F.G, (int)blockIdx.x);
                  pg8::EpiQ E{(h16*)(C.ws + WS_Q), ssq + (size_t)(2 * l) * M, (const float*)(C.ws + WS_ROPEB)};
                  pg8::gemm_phase(F.lds, F.wave, g, S, E); }
                { pg8::Gemm g{Z + ZC_CKV, (const h16*)(C.ws + WS_WUKV) + (size_t)l * 512 * 256, ZP, 256, M, 512, 256};
                  pg8::StaticOrder S; S.init(M, 512, F.G, (int)blockIdx.x);
                  pg8::EpiKV E{(h16*)(C.ws + WS_KF), (h16*)(C.ws + WS_VM), ssq + (size_t)(2 * l + 1) * M};
                  pg8::gemm_phase(F.lds, F.wave, g, S, E); }
            }
        }
        SEAM(pb + 1);
        if (IN(pb + 2)) { if (EN_C) dil_combine(C, F); if (EN_B && EN_B2) for (int u = blockIdx.x; u < 512; u += F.G) mla_unit(C, F, u); }
        SEAM(pb + 2);
        if (IN(pb + 3) && EN_P3) {
            pg8::Gemm g{Y, (const h16*)(C.ws + WS_WOUT) + (size_t)l * DM * DM, DM, DM, M, DM, DM};
            pg8::StaticOrder S; S.init(M, DM, F.G, (int)blockIdx.x);
            pg8::EpiRes E{V16, l == 0 ? 1 : 0, pg8::RowStats{st_prev, st_prev ? st_prev + M : nullptr}, par + PF_LN2G + (l ? l - 1 : 0) * DM, par + PF_LN2B + (l ? l - 1 : 0) * DM, st_ln1, st_ln1 + M};
            pg8::gemm_phase(F.lds, F.wave, g, S, E);
        }
        SEAM(pb + 3);
        if (IN(pb + 4) && EN_P4) {
            pg8::Gemm g{V16, (const h16*)(C.ws + WS_WGU) + (size_t)l * GU * DM, DM, DM, M, GU, DM};
            pg8::StaticOrder S; S.init(M, GU, F.G, (int)blockIdx.x);
            pg8::EpiGU E{Hb, c12 + C1GU + l * GU, c12 + C2GU + l * GU, pg8::RowStats{st_ln1, st_ln1 + M}};
            pg8::gemm_phase(F.lds, F.wave, g, S, E);
        }
        SEAM(pb + 4);
        if (IN(pb + 5) && EN_P5) {
            pg8::Gemm g{Hb, (const h16*)(C.ws + WS_WDOWN) + (size_t)l * DM * FF, FF, FF, M, DM, FF};
            pg8::StaticOrder S; S.init(M, DM, F.G, (int)blockIdx.x);
            pg8::EpiRes E{V16, 0, pg8::RowStats{st_ln1, st_ln1 + M}, par + PF_LN1G + l * DM, par + PF_LN1B + l * DM, st_ln2, st_ln2 + M};
            pg8::gemm_phase(F.lds, F.wave, g, S, E);
        }
        SEAM(pb + 5);
        }
#undef IN
#undef SEAM
}
constexpr int N_PHASES = 2 + 6 * DEPTH;
__global__ void __launch_bounds__(512, 2) fwd_kernel(Args a) {
    extern __shared__ __attribute__((aligned(16))) unsigned char lds_raw[];
    Frame F; F.lds = (LAS unsigned char*)lds_raw; F.tid = threadIdx.x; F.lane = F.tid & 63; F.wave = __builtin_amdgcn_readfirstlane(F.tid >> 6); F.G = gridDim.x;
    volatile LAS unsigned* MISC = (volatile LAS unsigned*)(F.lds + MISC_OFF);
    if (F.tid < 64) MISC[F.tid] = 0u;
    __syncthreads();
    unsigned* ctl = (unsigned*)(a.ws + WS_ZERO);
    XcdBarrier bar; bar.bar = ctl + CW_BAR; bar.x = 0; bar.st = nullptr; bar.wave = F.wave;
    if (a.use_bar) bar = xcd_barrier_post(ctl + CW_BAR, MISC + 8, F.wave);
    const int lo = a.ph_lo, hi = a.ph_hi;
#define IN(k) (lo <= (k) && (k) < hi)
#define SEAM(k) do { if (a.use_bar && IN(k) && IN((k) + 1)) xcd_barrier(bar); } while (0)
    const Core C{a.out, a.ws};

    if (IN(0) && EN_P0) { p0_prologue(a, F); }
    SEAM(0);
    if (LOOP_START <= 0 && 0 < LOOP_DEPTH) layer_body<0>(C, F, bar, lo, hi, a.use_bar);
    if (LOOP_START <= 1 && 1 < LOOP_DEPTH) layer_body<1>(C, F, bar, lo, hi, a.use_bar);
    if (LOOP_START <= 2 && 2 < LOOP_DEPTH) layer_body<2>(C, F, bar, lo, hi, a.use_bar);
    if (LOOP_START <= 3 && 3 < LOOP_DEPTH) layer_body<3>(C, F, bar, lo, hi, a.use_bar);
    if (IN(N_PHASES - 1) && EN_PF) final_ln(C, F);
#undef IN
#undef SEAM
}

#ifndef MK_PER_PHASE
#define MK_PER_PHASE 0
#endif
extern "C" void kernel_launch(void* const* d_in, const int* in_sizes, int n_in, void* d_out, int out_size, void* d_ws, size_t ws_size, hipStream_t stream) {
    static int grid = 0;
    if (grid == 0) {
        if (n_in != 23 || out_size != M * DM || ws_size < WS_END) { fprintf(stderr, "kernel_launch: unexpected shapes n_in %d out %d ws %zu\n", n_in, out_size, ws_size); grid = -1; return; }
        int dev = 0, cus = 0;
        if (hipGetDevice(&dev) != hipSuccess || hipDeviceGetAttribute(&cus, hipDeviceAttributeMultiprocessorCount, dev) != hipSuccess) { grid = -1; return; }
        if (hipFuncSetAttribute((const void*)fwd_kernel, hipFuncAttributeMaxDynamicSharedMemorySize, LDS_BYTES) != hipSuccess) { fprintf(stderr, "kernel_launch: hipFuncSetAttribute failed\n"); grid = -1; return; }
        int per_cu = 0;
        if (hipOccupancyMaxActiveBlocksPerMultiprocessor(&per_cu, (const void*)fwd_kernel, 512, LDS_BYTES) != hipSuccess || per_cu < 1) fprintf(stderr, "kernel_launch: occupancy query says %d\n", per_cu);
        (void)hipGetLastError();
        grid = cus;
    }
    if (grid < 0) return;
    (void)hipMemsetAsync((char*)d_ws + WS_ZERO, 0, ZERO_BYTES, stream);
    Args a{};
    a.x = (const float*)d_in[0]; a.pos = (const int*)d_in[1]; a.w_in = (const float*)d_in[2]; a.a_ln_g = (const float*)d_in[3]; a.a_ln_b = (const float*)d_in[4];
    a.a_ws = (const float*)d_in[5]; a.a_bs = (const float*)d_in[6]; a.b_q_norm = (const float*)d_in[7]; a.b_kv_norm = (const float*)d_in[8];
    a.b_w_uq = (const float*)d_in[9]; a.b_w_ukv = (const float*)d_in[10]; a.d_conv_w = (const float*)d_in[11]; a.d_conv_b = (const float*)d_in[12];
    a.d_igate_b = (const float*)d_in[13]; a.d_fgate_b = (const float*)d_in[14]; a.w_out = (const float*)d_in[15]; a.ln1_g = (const float*)d_in[16]; a.ln1_b = (const float*)d_in[17];
    a.w_gate = (const float*)d_in[18]; a.w_up = (const float*)d_in[19]; a.w_down = (const float*)d_in[20]; a.ln2_g = (const float*)d_in[21]; a.ln2_b = (const float*)d_in[22];
    a.out = (float*)d_out; a.ws = (unsigned char*)d_ws; a.pad = 0;
#if MK_PER_PHASE
    a.use_bar = 0;
    for (int p = 0; p < N_PHASES; ++p) { a.ph_lo = p; a.ph_hi = p + 1; hipLaunchKernelGGL(fwd_kernel, dim3(grid), dim3(512), LDS_BYTES, stream, a); }
#else
    a.use_bar = 1; a.ph_lo = 0; a.ph_hi = N_PHASES;
    hipLaunchKernelGGL(fwd_kernel, dim3(grid), dim3(512), LDS_BYTES, stream, a);
#endif
}
```

```cpp
#include <hip/hip_runtime.h>
#include <cstdio>
#include <cstdint>

#ifndef DUP_MASK
#define DUP_MASK 0
#endif
#define LAS __attribute__((address_space(3)))
#define GAS __attribute__((address_space(1)))
typedef _Float16 h16;
typedef _Float16 h16x8 __attribute__((ext_vector_type(8)));
typedef _Float16 h16x4 __attribute__((ext_vector_type(4)));
typedef _Float16 h16x2 __attribute__((ext_vector_type(2)));
typedef float f32x2 __attribute__((ext_vector_type(2)));
typedef float f32x4 __attribute__((ext_vector_type(4)));
typedef float f32x16 __attribute__((ext_vector_type(16)));
typedef unsigned u32x2 __attribute__((ext_vector_type(2)));
typedef unsigned u32x4 __attribute__((ext_vector_type(4)));

constexpr int NB = 32, SEQ = 2048, DM = 1024, DEPTH = 4;
constexpr int M = NB * SEQ;
constexpr int IN_COLS = 2664, ZP = 2816;
constexpr int FF = 2816, GU = 2 * FF;
constexpr int GW = 256;
constexpr float LN_EPS = 1e-5f, RMS_EPS = 1e-6f;
constexpr float ALPHA = 1.681792830507429f;
constexpr int ZC_A = 0;
constexpr int ZC_CQ = 512;
constexpr int ZC_CKV = 768;
constexpr int ZC_KR = 896;
constexpr int ZC_GATE = 928;
constexpr int ZC_C = 1024;
constexpr int ZC_D = 1792;
__host__ __device__ __forceinline__ int in_src(int n) {
    if (n < 704) return n;
    if (n < 768) return -1;
    if (n < 928) return n - 768 + 704;
    if (n < 936) return n - 928 + 2656;
    if (n < 1024) return -1;
    if (n < 1536) {
        const int t = (n - 1024) >> 8, c = (n - 1024) & 255, cc = c & 127;
        return 864 + t * 256 + (cc >> 5) * 64 + (c >> 7) * 32 + (cc & 31); }
    if (n < 1792) return n - 1024 + 864;
    return n - 1792 + 1632;
}

constexpr size_t MiB = 1u << 20;
constexpr size_t WS_ZERO = 0, ZERO_BYTES = 8 * MiB;
constexpr size_t WS_C12 = 1 * MiB;
constexpr size_t WS_STATS = 2 * MiB;
constexpr size_t WS_SSQ = 6 * MiB;
constexpr size_t WS_WIN = 8 * MiB, WS_WOUT = 30 * MiB, WS_WGU = 38 * MiB, WS_WDOWN = 82 * MiB, WS_WUQ = 104 * MiB, WS_WUKV = 105 * MiB;
constexpr size_t WS_ROPEB = 106 * MiB, WS_ROPEC = 114 * MiB;
constexpr size_t WS_V16 = 130 * MiB, WS_Z = 258 * MiB, WS_Q = 610 * MiB, WS_KF = 658 * MiB, WS_VM = 706 * MiB, WS_PAR = 738 * MiB, WS_AWS = 739 * MiB, WS_MLC = 740 * MiB, WS_MLN = 756 * MiB, WS_MLG = 758 * MiB, WS_DUMV = 762 * MiB, WS_DUMS = 890 * MiB, WS_END = (DUP_MASK ? 892 : 762) * MiB;
constexpr int PF_LN1G = 0, PF_LN1B = 4096, PF_LN2G = 8192, PF_LN2B = 12288, PF_ALNG = 16384, PF_ALNB = 17408, PF_ABS = 18432, PF_CONVW = 20480, PF_CONVB = 28672, PF_IGB = 30720, PF_FGB = 30736, PF_END = 30752;
constexpr size_t OUT_Y = 0, OUT_DP = 128 * MiB, OUT_DL = 224 * MiB;
constexpr int C1IN = 0, C2IN = 4 * ZP, C1GU = 8 * ZP, C2GU = 8 * ZP + 4 * GU;
constexpr int CW_TMO = 0, CW_CODE = 1, CW_BAR = 4096, CW_QUEUE = 8192;

constexpr int RING_BYTES = 131072;
constexpr int LDS_BYTES = 163840;
constexpr int MISC_OFF = LDS_BYTES - 256;

__device__ __forceinline__ unsigned pkh(float lo, float hi) { h16x2 v = {(h16)lo, (h16)hi}; return __builtin_bit_cast(unsigned, v); }
__device__ __forceinline__ float wave_sum(float v) {
    v += __builtin_bit_cast(float, __builtin_amdgcn_update_dpp(0, __builtin_bit_cast(int, v), 0xB1, 0xF, 0xF, true));
    v += __builtin_bit_cast(float, __builtin_amdgcn_update_dpp(0, __builtin_bit_cast(int, v), 0x4E, 0xF, 0xF, true));
    v += __builtin_bit_cast(float, __builtin_amdgcn_update_dpp(0, __builtin_bit_cast(int, v), 0x141, 0xF, 0xF, true));
    v += __builtin_bit_cast(float, __builtin_amdgcn_update_dpp(0, __builtin_bit_cast(int, v), 0x140, 0xF, 0xF, true));
    const int vi = __builtin_bit_cast(int, v);
    return (__builtin_bit_cast(float, __builtin_amdgcn_readlane(vi, 0)) + __builtin_bit_cast(float, __builtin_amdgcn_readlane(vi, 16)))
         + (__builtin_bit_cast(float, __builtin_amdgcn_readlane(vi, 32)) + __builtin_bit_cast(float, __builtin_amdgcn_readlane(vi, 48)));
}
__device__ __forceinline__ void atomic_addf(float* p, float v) { __hip_atomic_fetch_add(p, v, __ATOMIC_RELAXED, __HIP_MEMORY_SCOPE_AGENT); }

namespace pg8 {
constexpr float DIL_QSCALE = 0.125f * 1.4426950408889634f;
constexpr int BM = 256, BK = 64, HALF = 128, HTB = HALF * BK * 2, STAGE_BYTES = 8 * HTB, NXCD = 8, WGM = 8;
__host__ __device__ __forceinline__ int lds_byte(int r, int c) { const int st = (r >> 4) * 2 + (c >> 5), rr = r & 15, cc = c & 31, ob = rr * 64 + cc * 2; return st * 1024 + (ob ^ (((ob >> 9) & 1) << 5)); }
__host__ __device__ __forceinline__ void stage_rc(int b, int& R, int& C) { const int st = b / 1024, sb = b % 1024, swz = sb ^ (((sb >> 9) & 1) << 5); R = (st >> 1) * 16 + swz / 64; C = (st & 1) * 32 + (swz % 64) / 2; }
__host__ __device__ __forceinline__ int perm32(int rho) { const int n = rho >> 4, i = rho & 15; return 8 * (i >> 2) + 4 * n + (i & 3); }

struct Unit { int pm, pn; };
struct Gemm { const h16* A; const h16* Bt; int lda, ldb, M, N, K; };

struct StaticOrder {
    int nM, nN, nwg, G, c;
    __host__ __device__ void init(int M_, int N_, int G_, int c_) { nM = M_ / BM; nN = N_ / BM; nwg = nM * nN; G = G_; c = c_; }
    __host__ __device__ bool next(int i, Unit& u) const {
        const long L = (long)i * G + c; if (L >= nwg) return false;
        int wgid = (int)L; { const int q = nwg / NXCD, r = nwg % NXCD, xcd = wgid % NXCD, off = wgid / NXCD; wgid = (xcd < r ? xcd * (q + 1) : r * (q + 1) + (xcd - r) * q) + off; }
        const int nig = WGM * nN, gid = wgid / nig, fm = gid * WGM, gsz = (nM - fm) < WGM ? (nM - fm) : WGM;
        u.pm = fm + ((wgid % nig) % gsz); u.pn = (wgid % nig) / gsz; return true;
    }
};

struct FixedOrder { StaticOrder S; __host__ __device__ bool next(int i, Unit& u) const { const bool ok = S.next(i, u); u.pm = (int)(blockIdx.x & 7); u.pn = (int)((blockIdx.x >> 3) & 3); return ok; } };
template <class Epi, class Sched>
__device__ __forceinline__ void gemm_phase(LAS unsigned char* lds, const int wid, const Gemm g, const Sched& S, const Epi& E) {
    int lane = __builtin_amdgcn_mbcnt_hi(~0u, __builtin_amdgcn_mbcnt_lo(~0u, 0u)); asm volatile("" : "+v"(lane));
    const int tid = wid * 64 + lane, wr = wid >> 2, wc = wid & 3, fr = lane & 15, fq = lane >> 4;
    const int K = g.K, nt = K / BK;
    unsigned voffA[2], voffB[2];
#pragma unroll
    for (int i = 0; i < 2; ++i) { int R, C; stage_rc(tid * 16 + i * 8192, R, C); const int Rb = Epi::PERM ? ((R & ~31) + perm32(R & 31)) : R;
        voffA[i] = (unsigned)(R * g.lda + C) * 2u; voffB[i] = (unsigned)(Rb * g.ldb + C) * 2u; }
    const size_t kstep = (size_t)(BK * 2);
    const size_t hstepA = (size_t)HALF * g.lda * 2, hstepB = (size_t)HALF * g.ldb * 2;
    const size_t tstepA = 2 * hstepA, tstepB = 2 * hstepB;
    const unsigned ldsw = (unsigned)wid * 1024u;
    const int aoff = lds_byte(wr * 64 + fr, fq * 8), boff = lds_byte(wc * 32 + fr, fq * 8);
#define PG8_SA(b, h) (((b) * 2 + (h)) * HTB)
#define PG8_SB(b, h) ((4 + (b) * 2 + (h)) * HTB)
#define PG8_STAGE(bufoff, gbase, voff) do { _Pragma("unroll") for (int _i = 0; _i < 2; ++_i) \
        __builtin_amdgcn_global_load_lds((const unsigned*)((const char*)(gbase) + (voff)[_i]), (LAS unsigned*)(lds + (bufoff) + ldsw + _i * 8192), 16, 0, 0); } while (0)
#define PG8_LDA(dst, b, h) do { _Pragma("unroll") for (int m = 0; m < 4; ++m) _Pragma("unroll") for (int k = 0; k < 2; ++k) dst[m][k] = *(const LAS h16x8*)(lds + PG8_SA(b, h) + aoff + m * 2048 + k * 1024); } while (0)
#define PG8_LDB(dst, b, h) do { _Pragma("unroll") for (int n = 0; n < 2; ++n) _Pragma("unroll") for (int k = 0; k < 2; ++k) dst[n][k] = *(const LAS h16x8*)(lds + PG8_SB(b, h) + boff + n * 2048 + k * 1024); } while (0)
#define PG8_MMA(ai, bj, At, Bt) do { __builtin_amdgcn_s_setprio(1); _Pragma("unroll") for (int m = 0; m < 4; ++m) _Pragma("unroll") for (int n = 0; n < 2; ++n) _Pragma("unroll") for (int k = 0; k < 2; ++k) \
        acc[ai][bj][m][n] = __builtin_amdgcn_mfma_f32_16x16x32_f16(Bt[n][k], At[m][k], acc[ai][bj][m][n], 0, 0, 0); __builtin_amdgcn_s_setprio(0); } while (0)
#define PG8_WAIT_V(n) asm volatile("s_waitcnt vmcnt(" #n ")" ::: "memory")
#define PG8_WAIT_L(n) asm volatile("s_waitcnt lgkmcnt(" #n ")" ::: "memory")
#define PG8_BAR __builtin_amdgcn_s_barrier()
#define PG8_SCHED __builtin_amdgcn_sched_barrier(0)
    Unit cur, nxt; int ui = 0;
    if (!S.next(0, cur)) return;
    f32x4 acc[2][2][4][2];
#pragma unroll
    for (int a = 0; a < 2; ++a)
#pragma unroll
        for (int b = 0; b < 2; ++b)
#pragma unroll
            for (int m = 0; m < 4; ++m)
#pragma unroll
                for (int n = 0; n < 2; ++n) acc[a][b][m][n] = (f32x4){0.f, 0.f, 0.f, 0.f};
    h16x8 At[4][2], B0[2][2], B1[2][2];
    const char* cA = (const char*)g.A + (size_t)cur.pm * tstepA; const char* cB = (const char*)g.Bt + (size_t)cur.pn * tstepB;
    PG8_STAGE(PG8_SB(0, 0), cB, voffB); PG8_STAGE(PG8_SB(0, 1), cB + hstepB, voffB); PG8_STAGE(PG8_SA(0, 0), cA, voffA); PG8_STAGE(PG8_SA(0, 1), cA + hstepA, voffA);
    if (wr == 1) PG8_BAR;
    PG8_WAIT_V(2); PG8_BAR;
    PG8_STAGE(PG8_SB(1, 0), cB + kstep, voffB); PG8_STAGE(PG8_SA(1, 0), cA + kstep, voffA); PG8_STAGE(PG8_SB(1, 1), cB + hstepB + kstep, voffB);
    PG8_WAIT_V(6); PG8_BAR;
    for (;;) {
        const bool has_next = S.next(ui + 1, nxt);
        const char* nA = has_next ? (const char*)g.A + (size_t)nxt.pm * tstepA : cA; const char* nB = has_next ? (const char*)g.Bt + (size_t)nxt.pn * tstepB : cB;
#pragma unroll 1
        for (int t = 0; t < nt; t += 2) {
            const bool last = (t == nt - 2);
            const char* a1 = cA + (size_t)(t + 1) * kstep;
            const char* a2 = last ? nA : cA + (size_t)(t + 2) * kstep; const char* b2 = last ? nB : cB + (size_t)(t + 2) * kstep;
            const char* a3 = a2 + kstep; const char* b3 = b2 + kstep;
            PG8_LDB(B0, 0, 0); PG8_LDB(B1, 0, 1); PG8_SCHED; PG8_LDA(At, 0, 0); PG8_STAGE(PG8_SA(1, 1), a1 + hstepA, voffA);
            PG8_WAIT_V(8); PG8_WAIT_L(0); PG8_BAR; PG8_MMA(0, 0, At, B0); PG8_MMA(0, 1, At, B1); PG8_BAR; PG8_SCHED;
            PG8_LDA(At, 0, 1); PG8_STAGE(PG8_SB(0, 0), b2, voffB); PG8_STAGE(PG8_SB(0, 1), b2 + hstepB, voffB); PG8_STAGE(PG8_SA(0, 0), a2, voffA);
            PG8_WAIT_V(8); PG8_WAIT_L(0); PG8_BAR; PG8_MMA(1, 0, At, B0); PG8_MMA(1, 1, At, B1); PG8_BAR; PG8_SCHED;
            PG8_LDB(B0, 1, 0); PG8_LDB(B1, 1, 1); PG8_SCHED; PG8_LDA(At, 1, 0); PG8_STAGE(PG8_SA(0, 1), a2 + hstepA, voffA);
            PG8_WAIT_V(8); PG8_WAIT_L(0); PG8_BAR; PG8_MMA(0, 0, At, B0); PG8_MMA(0, 1, At, B1); PG8_BAR; PG8_SCHED;
            PG8_LDA(At, 1, 1); PG8_STAGE(PG8_SB(1, 0), b3, voffB); PG8_STAGE(PG8_SB(1, 1), b3 + hstepB, voffB); PG8_STAGE(PG8_SA(1, 0), a3, voffA);
            PG8_WAIT_V(8); PG8_WAIT_L(0); PG8_BAR; PG8_MMA(1, 0, At, B0); PG8_MMA(1, 1, At, B1); PG8_BAR; PG8_SCHED;
        }
        if (wr == 0) PG8_BAR;
        E(acc, cur, wr, wc, fr, fq);
        if (!has_next) break;
#pragma unroll
        for (int a = 0; a < 2; ++a)
#pragma unroll
            for (int b = 0; b < 2; ++b)
#pragma unroll
                for (int m = 0; m < 4; ++m)
#pragma unroll
                    for (int n = 0; n < 2; ++n) acc[a][b][m][n] = (f32x4){0.f, 0.f, 0.f, 0.f};
        cur = nxt; cA = nA; cB = nB; ++ui;
        if (wr == 1) PG8_BAR;
    }
    PG8_WAIT_V(0);
    PG8_BAR;
#undef PG8_SA
#undef PG8_SB
#undef PG8_STAGE
#undef PG8_LDA
#undef PG8_LDB
#undef PG8_MMA
#undef PG8_WAIT_V
#undef PG8_WAIT_L
#undef PG8_BAR
#undef PG8_SCHED
}

struct RowStats { const float* s1; const float* s2; };
__device__ __forceinline__ void row_mu_rs(const RowStats& st, int r, float& mu, float& rs) {
    const float a = st.s1[r], b = st.s2[r];
    mu = a * (1.0f / DM); const float var = fmaxf(b * (1.0f / DM) - mu * mu, 0.f); rs = rsqrtf(var + LN_EPS);
}

struct EpiIn {
    static constexpr bool PERM = true;
    h16* Z; const float* c1; const float* c2; RowStats st; int ident; float* ssq_q; float* ssq_kv; int rmask; const h16* rope;
    __device__ __forceinline__ void operator()(const f32x4 (&acc)[2][2][4][2], const Unit& u, int wr, int wc, int fr, int fq) const {
        const int row0 = u.pm * BM + wr * 64 + fr, col0 = u.pn * BM + wc * 32 + 8 * fq;
        f32x4 c1v[2][2], c2v[2][2];
#pragma unroll
        for (int bj = 0; bj < 2; ++bj)
#pragma unroll
            for (int n = 0; n < 2; ++n) { c1v[bj][n] = *(const f32x4*)(c1 + col0 + bj * HALF + 4 * n); c2v[bj][n] = *(const f32x4*)(c2 + col0 + bj * HALF + 4 * n); }
        const bool do_ssq = (u.pn == 2) || (u.pn == 3);
        float sq[2][4];
        float mus[2][4], rss[2][4];
#pragma unroll
        for (int ai = 0; ai < 2; ++ai)
#pragma unroll
            for (int m = 0; m < 4; ++m) { mus[ai][m] = 0.f; rss[ai][m] = 1.f; if (!ident) row_mu_rs(st, row0 + ai * HALF + m * 16, mus[ai][m], rss[ai][m]); }
        const bool rp = (u.pn == 4) || (u.pn == 5);
        const float qsc = (u.pn == 4) ? DIL_QSCALE : 1.0f;
#pragma unroll
        for (int ai = 0; ai < 2; ++ai) {
#pragma unroll
            for (int m = 0; m < 4; ++m) {
                const int r = row0 + ai * HALF + m * 16;
                const float mu = mus[ai][m], rs = rss[ai][m];
                float q = 0.f;
                if (rp) {
                    const h16x8 rcm = *(const h16x8*)(rope + (size_t)r * 64 + 8 * fq), rsm = *(const h16x8*)(rope + (size_t)r * 64 + 32 + 8 * fq);
                    f32x4 a0 = acc[ai][0][m][0], a1 = acc[ai][0][m][1], b0 = acc[ai][1][m][0], b1 = acc[ai][1][m][1];
                    if (!ident) { a0 = (a0 - c1v[0][0] * mu) * rs + c2v[0][0]; a1 = (a1 - c1v[0][1] * mu) * rs + c2v[0][1]; b0 = (b0 - c1v[1][0] * mu) * rs + c2v[1][0]; b1 = (b1 - c1v[1][1] * mu) * rs + c2v[1][1]; }
                    float o1[8], o2[8];
#pragma unroll
                    for (int j = 0; j < 8; ++j) { const float x1 = j < 4 ? a0[j & 3] : a1[j & 3], x2 = j < 4 ? b0[j & 3] : b1[j & 3], cc = (float)rcm[j] * qsc, ss = (float)rsm[j] * qsc;
                        o1[j] = x1 * cc - x2 * ss; o2[j] = x1 * ss + x2 * cc; }
                    u32x4 w1, w2; w1.x = pkh(o1[0], o1[1]); w1.y = pkh(o1[2], o1[3]); w1.z = pkh(o1[4], o1[5]); w1.w = pkh(o1[6], o1[7]);
                    w2.x = pkh(o2[0], o2[1]); w2.y = pkh(o2[2], o2[3]); w2.z = pkh(o2[4], o2[5]); w2.w = pkh(o2[6], o2[7]);
                    h16* zd = Z + (size_t)(r & rmask) * ZP + u.pn * BM + wc * 64 + 8 * fq;
                    *(u32x4*)zd = w1; *(u32x4*)(zd + 32) = w2;
                } else {
#pragma unroll
                for (int bj = 0; bj < 2; ++bj) {
                    f32x4 v0 = acc[ai][bj][m][0], v1 = acc[ai][bj][m][1];
                    if (!ident) { v0 = (v0 - c1v[bj][0] * mu) * rs + c2v[bj][0]; v1 = (v1 - c1v[bj][1] * mu) * rs + c2v[bj][1]; }
                    u32x4 w; w.x = pkh(v0[0], v0[1]); w.y = pkh(v0[2], v0[3]); w.z = pkh(v1[0], v1[1]); w.w = pkh(v1[2], v1[3]);
                    *(u32x4*)(Z + (size_t)(r & rmask) * ZP + col0 + bj * HALF) = w;
                    const bool valid = (u.pn == 2) ? (bj == 0 || wc < 2) : (bj == 0);
                    if (valid) q += (v0[0] * v0[0] + v0[1] * v0[1]) + (v0[2] * v0[2] + v0[3] * v0[3]) + (v1[0] * v1[0] + v1[1] * v1[1]) + (v1[2] * v1[2] + v1[3] * v1[3]);
                }
                }
                sq[ai][m] = q;
            }
        }
        if (do_ssq) {
            float* dst = (u.pn == 2) ? ssq_q : ssq_kv;
#pragma unroll
            for (int ai = 0; ai < 2; ++ai) {
                float t[4];
#pragma unroll
                for (int m = 0; m < 4; ++m) { float q = sq[ai][m]; q += __shfl_xor(q, 16); q += __shfl_xor(q, 32); t[m] = q; }
                const float mine = fq == 0 ? t[0] : fq == 1 ? t[1] : fq == 2 ? t[2] : t[3];
                atomic_addf(dst + u.pm * BM + ai * HALF + wr * 64 + fq * 16 + fr, mine);
            }
        }
    }
};

struct EpiRes {
    static constexpr bool PERM = true;
    h16* V; h16* Vo; int ident; RowStats st; const LAS float* g; const LAS float* b; float* o1; float* o2;
    __device__ __forceinline__ void operator()(const f32x4 (&acc)[2][2][4][2], const Unit& u, int wr, int wc, int fr, int fq) const {
        const int row0 = u.pm * BM + wr * 64 + fr, col0 = u.pn * BM + wc * 32 + 8 * fq;
        float s1[2][4], s2[2][4];
#pragma unroll
        for (int ai = 0; ai < 2; ++ai) {
            h16x8 hv[4][2]; float mus[4], rss[4];
#pragma unroll
            for (int m = 0; m < 4; ++m) {
                const int r = row0 + ai * HALF + m * 16;
#pragma unroll
                for (int bj = 0; bj < 2; ++bj) hv[m][bj] = *(const h16x8*)(V + (size_t)r * DM + col0 + bj * HALF);
                mus[m] = 0.f; rss[m] = 1.f; if (!ident) row_mu_rs(st, r, mus[m], rss[m]);
            }
#pragma unroll
            for (int m = 0; m < 4; ++m) {
                const int r = row0 + ai * HALF + m * 16;
                const float mu = mus[m], rs = rss[m];
                float a1 = 0.f, a2 = 0.f;
#pragma unroll
                for (int bj = 0; bj < 2; ++bj) {
                    const size_t off = (size_t)r * DM + col0 + bj * HALF;
                    const h16x8 hx = hv[m][bj];
                    f32x4 x0 = (f32x4){(float)hx[0], (float)hx[1], (float)hx[2], (float)hx[3]}, x1 = (f32x4){(float)hx[4], (float)hx[5], (float)hx[6], (float)hx[7]};
                    if (!ident) { const LAS float* gp = g + col0 + bj * HALF; const LAS float* bp = b + col0 + bj * HALF;
                        x0 = (x0 - mu) * rs * *(const LAS f32x4*)gp + *(const LAS f32x4*)bp; x1 = (x1 - mu) * rs * *(const LAS f32x4*)(gp + 4) + *(const LAS f32x4*)(bp + 4); }
                    const f32x4 v0 = x0 * ALPHA + acc[ai][bj][m][0], v1 = x1 * ALPHA + acc[ai][bj][m][1];
                    h16x8 ho = {(h16)v0[0], (h16)v0[1], (h16)v0[2], (h16)v0[3], (h16)v1[0], (h16)v1[1], (h16)v1[2], (h16)v1[3]};
                    *(h16x8*)(Vo + off) = ho;
#pragma unroll
                    for (int j = 0; j < 8; ++j) { const float f = (float)ho[j]; a1 += f; a2 += f * f; }
                }
                a1 += __shfl_xor(a1, 16); a1 += __shfl_xor(a1, 32); a2 += __shfl_xor(a2, 16); a2 += __shfl_xor(a2, 32);
                s1[ai][m] = a1; s2[ai][m] = a2;
            }
        }
#pragma unroll
        for (int ai = 0; ai < 2; ++ai) {
            const float m1 = fq == 0 ? s1[ai][0] : fq == 1 ? s1[ai][1] : fq == 2 ? s1[ai][2] : s1[ai][3];
            const float m2 = fq == 0 ? s2[ai][0] : fq == 1 ? s2[ai][1] : fq == 2 ? s2[ai][2] : s2[ai][3];
            const int r = u.pm * BM + ai * HALF + wr * 64 + fq * 16 + fr;
            atomic_addf(o1 + r, m1); atomic_addf(o2 + r, m2);
        }
    }
};

struct EpiGU {
    static constexpr bool PERM = true;
    h16* H; const float* c1; const float* c2; RowStats st;
    __device__ __forceinline__ void operator()(const f32x4 (&acc)[2][2][4][2], const Unit& u, int wr, int wc, int fr, int fq) const {
        const int row0 = u.pm * BM + wr * 64 + fr, cin = wc * 32 + 8 * fq, col0 = u.pn * BM + cin;
        f32x4 c1v[2][2], c2v[2][2];
#pragma unroll
        for (int bj = 0; bj < 2; ++bj)
#pragma unroll
            for (int n = 0; n < 2; ++n) { c1v[bj][n] = *(const f32x4*)(c1 + col0 + bj * HALF + 4 * n); c2v[bj][n] = *(const f32x4*)(c2 + col0 + bj * HALF + 4 * n); }
        float mus[2][4], rss[2][4];
#pragma unroll
        for (int ai = 0; ai < 2; ++ai)
#pragma unroll
            for (int m = 0; m < 4; ++m) row_mu_rs(st, row0 + ai * HALF + m * 16, mus[ai][m], rss[ai][m]);
#pragma unroll
        for (int ai = 0; ai < 2; ++ai)
#pragma unroll
            for (int m = 0; m < 4; ++m) {
                const int r = row0 + ai * HALF + m * 16;
                const float mu = mus[ai][m], rs = rss[ai][m];
                float hv[8];
#pragma unroll
                for (int n = 0; n < 2; ++n) {
                    const f32x4 gg = (acc[ai][0][m][n] - c1v[0][n] * mu) * rs + c2v[0][n];
                    const f32x4 uu = (acc[ai][1][m][n] - c1v[1][n] * mu) * rs + c2v[1][n];
#pragma unroll
                    for (int j = 0; j < 4; ++j) { const float e = __builtin_amdgcn_exp2f(gg[j] * -1.4426950408889634f); hv[4 * n + j] = gg[j] * uu[j] * __builtin_amdgcn_rcpf(1.0f + e); }
                }
                u32x4 w; w.x = pkh(hv[0], hv[1]); w.y = pkh(hv[2], hv[3]); w.z = pkh(hv[4], hv[5]); w.w = pkh(hv[6], hv[7]);
                *(u32x4*)(H + (size_t)r * FF + u.pn * HALF + cin) = w;
            }
    }
};


struct EpiNull {
    static constexpr bool PERM = true;
    __device__ __forceinline__ void operator()(const f32x4 (&acc)[2][2][4][2], const Unit& u, int wr, int wc, int fr, int fq) const {
#pragma unroll
        for (int ai = 0; ai < 2; ++ai)
#pragma unroll
            for (int bj = 0; bj < 2; ++bj)
#pragma unroll
                for (int m = 0; m < 4; ++m)
#pragma unroll
                    for (int n = 0; n < 2; ++n) asm volatile("" :: "v"(acc[ai][bj][m][n]));
    }
};
constexpr float QSCALE96 = 0.10206207261596577f * 1.4426950408889634f;
struct EpiQ {
    static constexpr bool PERM = false;
    h16* Q; const float* ssq; const float* rb;
    __device__ __forceinline__ void operator()(const f32x4 (&acc)[2][2][4][2], const Unit& u, int wr, int wc, int fr, int fq) const {
        const int row0 = u.pm * BM + wr * 64 + fr;
#pragma unroll
        for (int ai = 0; ai < 2; ++ai)
#pragma unroll
            for (int m = 0; m < 4; ++m) {
                const int r = row0 + ai * HALF + m * 16;
                const float rs = rsqrtf(ssq[r] * (1.0f / 192.0f) + RMS_EPS) * QSCALE96;
#pragma unroll
                for (int bj = 0; bj < 2; ++bj) {
                    const int g32 = 8 * u.pn + 4 * bj + wc;
                    if (g32 >= 12) continue;
                    f32x4 v0 = acc[ai][bj][m][0] * rs, v1 = acc[ai][bj][m][1] * rs;
                    if (g32 % 3 == 2) {
                        const f32x4 cc = *(const f32x4*)(rb + (size_t)r * 32 + 4 * fq), ss = *(const f32x4*)(rb + (size_t)r * 32 + 16 + 4 * fq);
                        const f32x4 a = v0 * cc - v1 * ss, b = v0 * ss + v1 * cc; v0 = a; v1 = b;
                    }
                    u32x2 w0, w1; w0.x = pkh(v0[0], v0[1]); w0.y = pkh(v0[2], v0[3]); w1.x = pkh(v1[0], v1[1]); w1.y = pkh(v1[2], v1[3]);
                    h16* dst = Q + (size_t)r * 384 + 32 * g32 + 4 * fq;
                    *(u32x2*)dst = w0; *(u32x2*)(dst + 16) = w1;
                }
                asm volatile("" ::: "memory");
            }
    }
};
struct EpiKV {
    static constexpr bool PERM = true;
    h16* Kf; h16* Vm; const float* ssq;
    __device__ __forceinline__ void operator()(const f32x4 (&acc)[2][2][4][2], const Unit& u, int wr, int wc, int fr, int fq) const {
        const int row0 = u.pm * BM + wr * 64 + fr;
#pragma unroll
        for (int ai = 0; ai < 2; ++ai)
#pragma unroll
            for (int m = 0; m < 4; ++m) {
                const int r = row0 + ai * HALF + m * 16;
                const float rs = rsqrtf(ssq[r] * (1.0f / 128.0f) + RMS_EPS);
#pragma unroll
                for (int bj = 0; bj < 2; ++bj) {
                    const int hd = 2 * u.pn + bj, within = 32 * wc + 8 * fq;
                    const f32x4 v0 = acc[ai][bj][m][0] * rs, v1 = acc[ai][bj][m][1] * rs;
                    u32x4 w; w.x = pkh(v0[0], v0[1]); w.y = pkh(v0[2], v0[3]); w.z = pkh(v1[0], v1[1]); w.w = pkh(v1[2], v1[3]);
                    if (wc < 2) *(u32x4*)(Kf + (size_t)r * 384 + hd * 96 + within) = w;
                    else *(u32x4*)(Vm + (size_t)r * 256 + hd * 64 + within - 64) = w;
                }
                asm volatile("" ::: "memory");
            }
    }
};
}

#define XB_TMO      128
#define XB_XCNT(j)  (256  + 64 * (j))
#define XB_XSUB(j)  (1280 + 64 * (j))
#define XB_XGEN(j)  (2304 + 64 * (j))
#define XB_TOP      3328
#define XB_TOPGEN   3392
#define XCD_BAR_WORDS 3456
#define XB_SPIN_CAP (1u << 18)
__device__ __forceinline__ unsigned xb_ld(unsigned* p)              { return __hip_atomic_load(p, __ATOMIC_RELAXED, __HIP_MEMORY_SCOPE_AGENT); }
__device__ __forceinline__ unsigned xb_add(unsigned* p, unsigned v) { return __hip_atomic_fetch_add(p, v, __ATOMIC_RELAXED, __HIP_MEMORY_SCOPE_AGENT); }
__device__ __forceinline__ unsigned xb_xcc_id() { return (unsigned)__builtin_amdgcn_s_getreg((3 << 11) | 20) & 0xFu; }
#define XB_SPIN(cond, bar) do { unsigned _sp = 0; while (cond) { __builtin_amdgcn_s_sleep(1); \
    if ((++_sp & 255u) == 0u) { if (xb_ld(&(bar)[XB_TMO])) break; if (_sp > XB_SPIN_CAP) { atomicAdd(&(bar)[XB_TMO], 1u); break; } } } } while (0)
struct XcdBarrier { unsigned* bar; unsigned x; volatile LAS unsigned* st; int wave; };
__device__ __forceinline__ bool xb_thread0(int wave) { return wave == 0 && __builtin_amdgcn_mbcnt_hi(~0u, __builtin_amdgcn_mbcnt_lo(~0u, 0u)) == 0; }
__device__ __forceinline__ XcdBarrier xcd_barrier_post(unsigned* bar, volatile LAS unsigned* st, int wave) {
    XcdBarrier b; b.bar = bar; b.x = xb_xcc_id(); b.st = st; b.wave = wave;
    if (xb_thread0(wave)) (void)xb_add(&bar[XB_XCNT(b.x)], 1u);
    return b;
}
__device__ __forceinline__ void xcd_barrier_complete(unsigned* bar, unsigned x, unsigned& nloc, unsigned& nx) {
    const unsigned G = gridDim.x * gridDim.y * gridDim.z;
    unsigned sum, cnt, mine, sp = 0u;
    for (;;) {
        sum = 0u; cnt = 0u; mine = 0u;
#pragma unroll
        for (unsigned j = 0; j < 16; ++j) { const unsigned c = xb_ld(&bar[XB_XCNT(j)]); sum += c; cnt += (c > 0u) ? 1u : 0u; mine = (j == x) ? c : mine; }
        if (sum == G) break;
        __builtin_amdgcn_s_sleep(1);
        if ((++sp & 255u) == 0u) { if (xb_ld(&bar[XB_TMO])) break; if (sp > XB_SPIN_CAP) { atomicAdd(&bar[XB_TMO], 1u); break; } }
    }
    nloc = mine > 0u ? mine : 1u; nx = cnt > 0u ? cnt : 1u;
}
__device__ __forceinline__ void xcd_barrier(const XcdBarrier& b) {
    asm volatile("s_waitcnt vmcnt(0)" ::: "memory");
    __syncthreads();
    if (xb_thread0(b.wave)) {
        unsigned* bar = b.bar;
        __builtin_amdgcn_s_waitcnt(0);
        unsigned nloc = b.st[0], nx = b.st[1];
        if (nloc == 0u) { xcd_barrier_complete(bar, b.x, nloc, nx); b.st[0] = nloc; b.st[1] = nx; }
        const unsigned old = xb_add(&bar[XB_XSUB(b.x)], 1u);
        const unsigned gen = old / nloc;
        if (old + 1u == (gen + 1u) * nloc) {
            __builtin_amdgcn_fence(__ATOMIC_RELEASE, "agent");
            asm volatile("s_waitcnt vmcnt(0)" ::: "memory");
            const unsigned og = xb_add(&bar[XB_TOP], 1u);
            const unsigned tg = og / nx;
            if (og + 1u == (tg + 1u) * nx) xb_add(&bar[XB_TOPGEN], 1u);
            else XB_SPIN(xb_ld(&bar[XB_TOPGEN]) == tg, bar);
            __builtin_amdgcn_fence(__ATOMIC_ACQUIRE, "agent");
            xb_add(&bar[XB_XGEN(b.x)], 1u);
            asm volatile("s_waitcnt vmcnt(0)" ::: "memory");
        } else {
            XB_SPIN(xb_ld(&bar[XB_XGEN(b.x)]) == gen, bar);
            __builtin_amdgcn_fence(__ATOMIC_ACQUIRE, "agent");
            asm volatile("s_waitcnt vmcnt(0)" ::: "memory");
        }
    }
    __syncthreads();
}

struct Args {
    const float* x; const int* pos; const float* w_in; const float* a_ln_g; const float* a_ln_b; const float* a_ws; const float* a_bs;
    const float* b_q_norm; const float* b_kv_norm; const float* b_w_uq; const float* b_w_ukv;
    const float* d_conv_w; const float* d_conv_b; const float* d_igate_b; const float* d_fgate_b;
    const float* w_out; const float* ln1_g; const float* ln1_b; const float* w_gate; const float* w_up; const float* w_down; const float* ln2_g; const float* ln2_b;
    float* out; unsigned char* ws; int ph_lo, ph_hi; int use_bar, pad;
};

template <int MAP>
__device__ __forceinline__ void transpose_item(const float* W, int Ksrc, int Nsrc, const float* g, const float* b, h16* Wt, int Kdst, int Ndst_valid,
                                               float* c1, float* c2, int kb, int nb, LAS float* scr, int lane) {
    const int k0 = 64 * kb, n0 = 32 * nb, nn = lane & 31, kh = lane >> 5;
    int ns, nd;
    if (MAP == 0) { nd = n0 + nn; ns = (nd < Ndst_valid && nd < Nsrc) ? nd : -1; }
    else if (MAP == 1) { nd = n0 + nn; ns = in_src(nd); }
    else { const int j = n0 + nn; ns = j; nd = 256 * (j >> 7) + (j & 127) + (MAP == 3 ? 128 : 0); }
    float s1 = 0.f, s2 = 0.f;
    const bool okn = ns >= 0; const int nsc = okn ? ns : 0;
    float wv[32], gv[32], bv[32];
#pragma unroll
    for (int i = 0; i < 32; ++i) { int k = k0 + 2 * i + kh; if (k >= Ksrc) k = Ksrc - 1; wv[i] = W[(size_t)k * Nsrc + nsc]; gv[i] = g ? g[k] : 1.0f; bv[i] = b ? b[k] : 0.0f; }
#pragma unroll
    for (int i = 0; i < 32; ++i) {
        const int kk = 2 * i + kh, k = k0 + kk;
        const float w = (okn && k < Ksrc) ? wv[i] : 0.f;
        const float hf = (float)(h16)(w * gv[i]);
        scr[kk * 33 + nn] = hf; s1 += hf; s2 += bv[i] * w;
    }
    if (c1) { s1 += __shfl_xor(s1, 32); s2 += __shfl_xor(s2, 32); if (lane < 32) { atomic_addf(c1 + nd, s1); atomic_addf(c2 + nd, s2); } }
    asm volatile("s_waitcnt lgkmcnt(0)" ::: "memory");
    const int c = lane & 7;
    int nd0; if (MAP <= 1) nd0 = n0; else nd0 = 256 * (n0 >> 7) + (n0 & 127) + (MAP == 3 ? 128 : 0);
#pragma unroll
    for (int j = 0; j < 4; ++j) { const int n = (lane >> 3) + 8 * j; const LAS float* s = scr + (8 * c) * 33 + n;
        u32x4 o; o.x = pkh(s[0 * 33], s[1 * 33]); o.y = pkh(s[2 * 33], s[3 * 33]); o.z = pkh(s[4 * 33], s[5 * 33]); o.w = pkh(s[6 * 33], s[7 * 33]);
        *(u32x4*)(Wt + (size_t)(nd0 + n) * Kdst + k0 + 8 * c) = o; }
    asm volatile("s_waitcnt lgkmcnt(0)" ::: "memory");
}

struct Frame { LAS unsigned char* lds; int tid, lane, wave, G; };
#define UNIT_END_BAR() do { asm volatile("s_waitcnt lgkmcnt(0)" ::: "memory"); __builtin_amdgcn_s_barrier(); asm volatile("" ::: "memory"); } while (0)
__device__ __forceinline__ Frame fresh_frame(const Frame& F0) {
    Frame F; int ln = __builtin_amdgcn_mbcnt_hi(~0u, __builtin_amdgcn_mbcnt_lo(~0u, 0u)); asm volatile("" : "+v"(ln));
    F.lds = F0.lds; F.G = F0.G; F.wave = F0.wave; F.lane = ln; F.tid = F0.wave * 64 + ln; return F;
}

__device__ __forceinline__ void p0_prologue(const Args& a, const Frame& F0, float* c12) {
    const Frame F = fresh_frame(F0);
    LAS float* scr = (LAS float*)(F.lds + F.wave * 16384);
    const int gw = blockIdx.x * 8 + F.wave, NGW = F.G * 8;
    constexpr int I_IN = 16 * (ZP / 32), I_OUT = 16 * 32, I_G = 16 * (FF / 32), I_DN = (FF / 64) * 32, I_UQ = 4 * 16, I_UKV = 4 * 16;
    constexpr int PER_LAYER = I_IN + I_OUT + 2 * I_G + I_DN + I_UQ + I_UKV;
    for (int it = gw; it < DEPTH * PER_LAYER; it += NGW) {
        const int l = it / PER_LAYER; int r = it % PER_LAYER;
        if (r < I_IN) { const int kb = r / (ZP / 32), nb = r % (ZP / 32);
            transpose_item<1>(a.w_in + (size_t)l * DM * IN_COLS, DM, IN_COLS, l ? a.ln2_g + (l - 1) * DM : nullptr, l ? a.ln2_b + (l - 1) * DM : nullptr,
                              (h16*)(a.ws + WS_WIN) + (size_t)l * ZP * DM, DM, ZP, c12 + C1IN + l * ZP, c12 + C2IN + l * ZP, kb, nb, scr, F.lane); continue; } r -= I_IN;
        if (r < I_OUT) { const int kb = r / 32, nb = r % 32;
            transpose_item<0>(a.w_out + (size_t)l * DM * DM, DM, DM, nullptr, nullptr, (h16*)(a.ws + WS_WOUT) + (size_t)l * DM * DM, DM, DM, nullptr, nullptr, kb, nb, scr, F.lane); continue; } r -= I_OUT;
        if (r < I_G) { const int kb = r / (FF / 32), nb = r % (FF / 32);
            transpose_item<2>(a.w_gate + (size_t)l * DM * FF, DM, FF, a.ln1_g + l * DM, a.ln1_b + l * DM, (h16*)(a.ws + WS_WGU) + (size_t)l * GU * DM, DM, GU, c12 + C1GU + l * GU, c12 + C2GU + l * GU, kb, nb, scr, F.lane); continue; } r -= I_G;
        if (r < I_G) { const int kb = r / (FF / 32), nb = r % (FF / 32);
            transpose_item<3>(a.w_up + (size_t)l * DM * FF, DM, FF, a.ln1_g + l * DM, a.ln1_b + l * DM, (h16*)(a.ws + WS_WGU) + (size_t)l * GU * DM, DM, GU, c12 + C1GU + l * GU, c12 + C2GU + l * GU, kb, nb, scr, F.lane); continue; } r -= I_G;
        if (r < I_DN) { const int kb = r / 32, nb = r % 32;
            transpose_item<0>(a.w_down + (size_t)l * FF * DM, FF, DM, nullptr, nullptr, (h16*)(a.ws + WS_WDOWN) + (size_t)l * DM * FF, FF, DM, nullptr, nullptr, kb, nb, scr, F.lane); continue; } r -= I_DN;
        if (r < I_UQ) { const int kb = r / 16, nb = r % 16;
            transpose_item<0>(a.b_w_uq + (size_t)l * 192 * 384, 192, 384, a.b_q_norm + l * 192, nullptr, (h16*)(a.ws + WS_WUQ) + (size_t)l * 512 * 256, 256, 384, nullptr, nullptr, kb, nb, scr, F.lane); continue; } r -= I_UQ;
        { const int kb = r / 16, nb = r % 16;
            transpose_item<0>(a.b_w_ukv + (size_t)l * 128 * 512, 128, 512, a.b_kv_norm + l * 128, nullptr, (h16*)(a.ws + WS_WUKV) + (size_t)l * 512 * 256, 256, 512, nullptr, nullptr, kb, nb, scr, F.lane); }
    }
    const size_t gt = (size_t)blockIdx.x * 512 + F.tid, NT = (size_t)F.G * 512;
    h16* V = (h16*)(a.ws + WS_V16);
    for (size_t i0 = gt; i0 < (size_t)M * DM / 8; i0 += 8 * NT) {
        f32x4 p[8], q[8];
#pragma unroll
        for (int k = 0; k < 8; ++k) { size_t i = i0 + k * NT; if (i >= (size_t)M * DM / 8) i = (size_t)M * DM / 8 - 1; p[k] = *(const f32x4*)(a.x + i * 8); q[k] = *(const f32x4*)(a.x + i * 8 + 4); }
#pragma unroll
        for (int k = 0; k < 8; ++k) { const size_t i = i0 + k * NT; if (i >= (size_t)M * DM / 8) continue;
            u32x4 w; w.x = pkh(p[k][0], p[k][1]); w.y = pkh(p[k][2], p[k][3]); w.z = pkh(q[k][0], q[k][1]); w.w = pkh(q[k][2], q[k][3]);
            *(u32x4*)(V + i * 8) = w; }
    }
    float* rb = (float*)(a.ws + WS_ROPEB); h16* rc = (h16*)(a.ws + WS_ROPEC);
    for (size_t i = gt; i < (size_t)M * 48; i += NT) {
        const int row = (int)(i / 48), j = (int)(i % 48);
        const float p = (float)a.pos[row];
        if (j < 16) { const float inv = powf(10000.0f, -(float)j / 16.0f); float s, c; sincosf(p * inv, &s, &c); rb[(size_t)row * 32 + j] = c; rb[(size_t)row * 32 + 16 + j] = s; }
        else { const int jj = j - 16; const float inv = powf(10000.0f, -(float)jj / 32.0f); float s, c; sincosf(p * inv, &s, &c); rc[(size_t)row * 64 + jj] = (h16)c; rc[(size_t)row * 64 + 32 + jj] = (h16)s; }
    }
    float* par = (float*)(a.ws + WS_PAR);
    for (size_t i = gt; i < (size_t)PF_END; i += NT) {
        const int k = (int)i; float v;
        if (k < PF_LN1B) v = a.ln1_g[k - PF_LN1G]; else if (k < PF_LN2G) v = a.ln1_b[k - PF_LN1B]; else if (k < PF_LN2B) v = a.ln2_g[k - PF_LN2G]; else if (k < PF_ALNG) v = a.ln2_b[k - PF_LN2B];
        else if (k < PF_ALNB) v = a.a_ln_g[k - PF_ALNG]; else if (k < PF_ABS) v = a.a_ln_b[k - PF_ALNB]; else if (k < PF_CONVW) v = a.a_bs[k - PF_ABS]; else if (k < PF_CONVB) v = a.d_conv_w[k - PF_CONVW];
        else if (k < PF_IGB) v = a.d_conv_b[k - PF_CONVB]; else if (k < PF_FGB) v = (k - PF_IGB < 16) ? a.d_igate_b[k - PF_IGB] : 0.f; else v = a.d_fgate_b[k - PF_FGB];
        par[k] = v;
    }
    h16* aws = (h16*)(a.ws + WS_AWS);
    for (size_t i = gt; i < (size_t)DEPTH * 4 * 128 * 128; i += NT) aws[i] = (h16)a.a_ws[i];
}

struct Core { float* out; unsigned char* ws; };
__device__ __forceinline__ void final_ln(const Core& a, const Frame& F0) {
    const Frame F = fresh_frame(F0);
    const int gw = blockIdx.x * 8 + F.wave, NGW = F.G * 8;
    const h16* V = (const h16*)(a.ws + WS_V16);
    const float* par = (const float*)(a.ws + WS_PAR); const float* g = par + PF_LN2G + (DEPTH - 1) * DM; const float* b = par + PF_LN2B + (DEPTH - 1) * DM;
    f32x4 gg[4], bb[4];
#pragma unroll
    for (int j = 0; j < 2; ++j)
#pragma unroll
        for (int k4 = 0; k4 < 2; ++k4) { const int c = j * 512 + F.lane * 8 + k4 * 4; gg[j * 2 + k4] = *(const f32x4*)(g + c); bb[j * 2 + k4] = *(const f32x4*)(b + c); }
    for (int r0 = gw; r0 < M; r0 += 4 * NGW) {
        h16x8 hv[4][2];
#pragma unroll
        for (int k = 0; k < 4; ++k) { int r = r0 + k * NGW; if (r >= M) r = M - 1;
#pragma unroll
            for (int j = 0; j < 2; ++j) hv[k][j] = *(const h16x8*)(V + (size_t)r * DM + j * 512 + F.lane * 8); }
#pragma unroll
        for (int k = 0; k < 4; ++k) { const int r = r0 + k * NGW; if (r >= M) continue;
            float v[16];
#pragma unroll
            for (int j = 0; j < 2; ++j)
#pragma unroll
                for (int e = 0; e < 8; ++e) v[j * 8 + e] = (float)hv[k][j][e];
            float s = 0.f;
#pragma unroll
            for (int e = 0; e < 16; ++e) s += v[e];
            const float mean = wave_sum(s) * (1.0f / DM); float q = 0.f;
#pragma unroll
            for (int e = 0; e < 16; ++e) { v[e] -= mean; q += v[e] * v[e]; }
            const float rs = rsqrtf(wave_sum(q) * (1.0f / DM) + LN_EPS);
#pragma unroll
            for (int j = 0; j < 2; ++j)
#pragma unroll
                for (int k4 = 0; k4 < 2; ++k4) { const int c = j * 512 + F.lane * 8 + k4 * 4; const f32x4 G4 = gg[j * 2 + k4], B4 = bb[j * 2 + k4];
                    f32x4 o; o[0] = v[j * 8 + k4 * 4 + 0] * rs * G4[0] + B4[0]; o[1] = v[j * 8 + k4 * 4 + 1] * rs * G4[1] + B4[1]; o[2] = v[j * 8 + k4 * 4 + 2] * rs * G4[2] + B4[2]; o[3] = v[j * 8 + k4 * 4 + 3] * rs * G4[3] + B4[3];
                    *(f32x4*)(a.out + (size_t)r * DM + c) = o; }
        }
    }
}

#ifndef EN_C
#define EN_C 1
#endif
#ifndef EN_B
#define EN_B 1
#endif
#ifndef EN_D
#define EN_D 1
#endif
#ifndef EN_B1
#define EN_B1 1
#endif
#ifndef EN_B2
#define EN_B2 1
#endif
#ifndef DUP_MASK
#define DUP_MASK 0
#endif
#ifndef EN_A
#define EN_A 1
#endif
#ifndef ZERO_FROM
#define ZERO_FROM 1024
#endif
#ifndef LOOP_START
#define LOOP_START 0
#endif
#ifndef LOOP_DEPTH
#define LOOP_DEPTH DEPTH
#endif
#ifndef EN_P0
#define EN_P0 1
#endif
#ifndef EN_P1
#define EN_P1 1
#endif
#ifndef EN_P3
#define EN_P3 1
#endif
#ifndef EN_P4
#define EN_P4 1
#endif
#ifndef EN_P5
#define EN_P5 1
#endif
#ifndef EN_PF
#define EN_PF 1
#endif

typedef short v4i16_t __attribute__((ext_vector_type(4)));
__device__ __forceinline__ f32x16 mfma32(h16x8 a, h16x8 b, f32x16 c) { return __builtin_amdgcn_mfma_f32_32x32x16_f16(a, b, c, 0, 0, 0); }
__device__ __forceinline__ int crow(int i, int hh) { return (i & 3) + 8 * (i >> 2) + 4 * hh; }
template <bool NAT>
__device__ __forceinline__ h16x8 tr_frag(const LAS h16* T, int pitch, int k0, int c0, int lane) {
    const int i = lane & 15, g4 = lane >> 4, hh = g4 >> 1;
    const int ra = k0 + (NAT ? 8 * hh : 4 * hh) + (i >> 2), rb = ra + (NAT ? 4 : 8);
    const int cc = c0 + 16 * (g4 & 1) + 4 * (i & 3);
    const v4i16_t x = __builtin_amdgcn_ds_read_tr16_b64_v4i16((LAS v4i16_t*)(T + ra * pitch + cc));
    const v4i16_t y = __builtin_amdgcn_ds_read_tr16_b64_v4i16((LAS v4i16_t*)(T + rb * pitch + cc));
    typedef short s16x8 __attribute__((ext_vector_type(8)));
    const s16x8 r = {x[0], x[1], x[2], x[3], y[0], y[1], y[2], y[3]};
    return __builtin_bit_cast(h16x8, r);
}
__device__ __forceinline__ float gelu_erf(float v) {
    const float av = fabsf(v), t = __builtin_amdgcn_rcpf(av * 0.2316418882f + 1.0f);
    float q = t * 0.5307027145f + (-0.7265760135f); q = q * t + 0.7107068705f; q = q * t + (-0.142248368f); q = q * t + 0.127414796f; q = q * t;
    const float e = __builtin_amdgcn_exp2f((v * v) * (-0.72134752044f));
    const float m = v * (q * e);
    return v < 0.f ? m : v - m;
}


__device__ __forceinline__ void store_row32(h16* rowp, const u32x2 (&v)[4], int hh) {
#pragma unroll
    for (int p = 0; p < 2; ++p) {
        const auto r0 = __builtin_amdgcn_permlane32_swap(v[2 * p].x, v[2 * p + 1].x, false, false);
        const auto r1 = __builtin_amdgcn_permlane32_swap(v[2 * p].y, v[2 * p + 1].y, false, false);
        const u32x4 w = {r0[0], r1[0], r0[1], r1[1]};
        *(u32x4*)(rowp + 16 * p + 8 * hh) = w;
    }
}
constexpr int GM_PITCH = 288;
template <int l>
__device__ __forceinline__ void gmlp_unit(const Core& C, const Frame& F0, int unit) {
    const Frame F = fresh_frame(F0);
    const h16* Z = (const h16*)(C.ws + WS_Z); h16* Y = (h16*)((unsigned char*)C.out + OUT_Y);
    const float* par = (const float*)(C.ws + WS_PAR);
    const h16* W = (const h16*)(C.ws + WS_AWS) + (size_t)l * 4 * 128 * 128;
    LAS h16* Vt = (LAS h16*)F.lds;
    const int row0 = (unit >> 4) * SEQ + (unit & 15) * 128;
    const int lane = F.lane, w = F.wave;
    {
        const f32x4 gg = *(const f32x4*)(par + PF_ALNG + l * GW + 4 * lane), bb = *(const f32x4*)(par + PF_ALNB + l * GW + 4 * lane);
        h16x4 hvv[16];
#pragma unroll
        for (int i = 0; i < 16; ++i) hvv[i] = *(const h16x4*)(Z + (size_t)(row0 + w * 16 + i) * ZP + ZC_A + 256 + 4 * lane);
#pragma unroll
        for (int i = 0; i < 16; ++i) {
            const int t = w * 16 + i;
            const h16x4 hv = hvv[i];
            float x[4]; float s = 0.f;
#pragma unroll
            for (int j = 0; j < 4; ++j) { x[j] = gelu_erf((float)hv[j]); s += x[j]; }
            const float mean = wave_sum(s) * (1.0f / 256.0f); float q = 0.f;
#pragma unroll
            for (int j = 0; j < 4; ++j) { x[j] -= mean; q += x[j] * x[j]; }
            const float rs = rsqrtf(wave_sum(q) * (1.0f / 256.0f) + LN_EPS);
            u32x2 o; o.x = pkh(x[0] * rs * gg[0] + bb[0], x[1] * rs * gg[1] + bb[1]); o.y = pkh(x[2] * rs * gg[2] + bb[2], x[3] * rs * gg[3] + bb[3]);
            *(LAS u32x2*)(Vt + t * GM_PITCH + 4 * lane) = o;
        }
    }
    __syncthreads();
    {
        const int h = w >> 1, db = w & 1, tl = lane & 31, hh = lane >> 5;
        const float* bs = par + PF_ABS + (l * 4 + h) * 128;
#pragma unroll 1
        for (int tb = 0; tb < 4; ++tb) {
            const int t = 32 * tb + tl;
            f32x16 acc;
#pragma unroll
            for (int i = 0; i < 16; ++i) acc[i] = 0.f;
            const h16* wrow = W + ((size_t)h * 128 + t) * 128 + 8 * hh;
            h16x4 uv[4];
            { const size_t zoff = (size_t)(row0 + t) * ZP + ZC_A + h * 64 + 32 * db + 4 * hh;
#pragma unroll
              for (int g = 0; g < 4; ++g) uv[g] = *(const h16x4*)(Z + zoff + 8 * g); }
            for (int ks = 0; ks < 2 * (tb + 1); ++ks) {
                const h16x8 a = tr_frag<true>(Vt, GM_PITCH, 16 * ks, h * 64 + 32 * db, lane);
                h16x8 bw = *(const h16x8*)(wrow + 16 * ks);
                const int s0 = 16 * ks + 8 * hh;
#pragma unroll
                for (int j = 0; j < 8; ++j) if (s0 + j > t) bw[j] = (h16)0.f;
                acc = mfma32(a, bw, acc);
            }
            const float bias = bs[t];
            u32x2 ov[4];
#pragma unroll
            for (int g = 0; g < 4; ++g) {
                const h16x4 uu = uv[g];
                ov[g].x = pkh(gelu_erf((float)uu[0]) * (acc[4 * g + 0] + bias), gelu_erf((float)uu[1]) * (acc[4 * g + 1] + bias));
                ov[g].y = pkh(gelu_erf((float)uu[2]) * (acc[4 * g + 2] + bias), gelu_erf((float)uu[3]) * (acc[4 * g + 3] + bias));
            }
            store_row32(Y + (size_t)(row0 + t) * DM + h * 64 + 32 * db, ov, hh);
        }
    }
    UNIT_END_BAR();
}


__device__ __forceinline__ bool bh_unit(int it, int n_per, int G, int& bh, int& r) {
    if (G != 256) { const int L = it * G + (int)blockIdx.x; if (L >= 128 * n_per) return false; bh = L / n_per; r = L % n_per; return true; }
    const int xcd = blockIdx.x & 7, s = blockIdx.x >> 3, j = it * 32 + s;
    if (j >= 16 * n_per) return false;
    bh = (j / n_per) * 8 + xcd; r = j % n_per; return true;
}
template <int DQ, int NT>
__device__ __forceinline__ void attn_tile(const LAS h16* Kt, int kpitch, const LAS h16* Vt, int vpitch, const h16x8 (&qf)[DQ / 16], float& m, float& ls, f32x16 (&o)[2],
                                          bool masked, int lo, int hi, int lane) {
    const int kr = lane & 31, hh = lane >> 5;
    f32x16 sc[NT];
#pragma unroll
    for (int t = 0; t < NT; ++t) {
#pragma unroll
        for (int i = 0; i < 16; ++i) sc[t][i] = 0.f;
#pragma unroll
        for (int ds = 0; ds < DQ / 16; ++ds) { const h16x8 a = *(const LAS h16x8*)(Kt + (32 * t + kr) * kpitch + 16 * ds + 8 * hh); sc[t] = mfma32(a, qf[ds], sc[t]); }
    }
    if (masked) {
#pragma unroll
        for (int t = 0; t < NT; ++t)
#pragma unroll
            for (int i = 0; i < 16; ++i) { const int kk = 32 * t + crow(i, hh); if (kk < lo || kk > hi) sc[t][i] = -INFINITY; }
    }
    float mx = sc[0][0];
#pragma unroll
    for (int t = 0; t < NT; ++t)
#pragma unroll
        for (int i = 0; i < 16; ++i) mx = fmaxf(mx, sc[t][i]);
    mx = fmaxf(mx, __shfl_xor(mx, 32));
    if (__any(mx > m)) {
        const float mn = fmaxf(m, mx);
        const float alpha = __builtin_amdgcn_exp2f(m - mn);
        ls *= alpha; m = mn;
#pragma unroll
        for (int i = 0; i < 16; ++i) { o[0][i] *= alpha; o[1][i] *= alpha; }
    }
    float ps = 0.f;
#pragma unroll
    for (int t = 0; t < NT; ++t)
#pragma unroll
        for (int i = 0; i < 16; ++i) { sc[t][i] = __builtin_amdgcn_exp2f(sc[t][i] - m); ps += sc[t][i]; }
    ls += ps;
#pragma unroll
    for (int t = 0; t < NT; ++t) {
        h16x8 pf[2];
#pragma unroll
        for (int s2 = 0; s2 < 2; ++s2)
#pragma unroll
            for (int j = 0; j < 8; ++j) pf[s2][j] = (h16)sc[t][8 * s2 + j];
#pragma unroll
        for (int db = 0; db < 2; ++db)
#pragma unroll
            for (int s2 = 0; s2 < 2; ++s2) { const h16x8 a = tr_frag<false>(Vt + 32 * t * vpitch, vpitch, 16 * s2, 32 * db, lane); o[db] = mfma32(a, pf[s2], o[db]); }
    }
}


template <int DQ>
__device__ __forceinline__ void attn_tile_dual(const LAS h16* Kt, int kpitch, const LAS h16* Vt, int vpitch, const h16x8 (&qA)[DQ / 16], const h16x8 (&qB)[DQ / 16],
                                               float& mA, float& lsA, f32x16 (&oA)[2], float& mB, float& lsB, f32x16 (&oB)[2], bool maskA, int hiA, bool maskB, int hiB, int lane) {
    const int kr = lane & 31, hh = lane >> 5;
    f32x16 sA, sB;
#pragma unroll
    for (int i = 0; i < 16; ++i) { sA[i] = 0.f; sB[i] = 0.f; }
#pragma unroll
    for (int ds = 0; ds < DQ / 16; ++ds) { const h16x8 a = *(const LAS h16x8*)(Kt + kr * kpitch + 16 * ds + 8 * hh); sA = mfma32(a, qA[ds], sA); sB = mfma32(a, qB[ds], sB); }
    if (maskA) {
#pragma unroll
        for (int i = 0; i < 16; ++i) if (crow(i, hh) > hiA) sA[i] = -INFINITY;
    }
    if (maskB) {
#pragma unroll
        for (int i = 0; i < 16; ++i) if (crow(i, hh) > hiB) sB[i] = -INFINITY;
    }
    float xa = sA[0], xb = sB[0];
#pragma unroll
    for (int i = 1; i < 16; ++i) { xa = fmaxf(xa, sA[i]); xb = fmaxf(xb, sB[i]); }
    xa = fmaxf(xa, __shfl_xor(xa, 32)); xb = fmaxf(xb, __shfl_xor(xb, 32));
    if (__any(xa > mA)) { const float mn = fmaxf(mA, xa), al = __builtin_amdgcn_exp2f(mA - mn); lsA *= al; mA = mn;
#pragma unroll
        for (int i = 0; i < 16; ++i) { oA[0][i] *= al; oA[1][i] *= al; } }
    if (__any(xb > mB)) { const float mn = fmaxf(mB, xb), al = __builtin_amdgcn_exp2f(mB - mn); lsB *= al; mB = mn;
#pragma unroll
        for (int i = 0; i < 16; ++i) { oB[0][i] *= al; oB[1][i] *= al; } }
    float pa = 0.f, pb = 0.f;
#pragma unroll
    for (int i = 0; i < 16; ++i) { sA[i] = __builtin_amdgcn_exp2f(sA[i] - mA); pa += sA[i]; sB[i] = __builtin_amdgcn_exp2f(sB[i] - mB); pb += sB[i]; }
    lsA += pa; lsB += pb;
    h16x8 fA[2], fB[2];
#pragma unroll
    for (int s2 = 0; s2 < 2; ++s2)
#pragma unroll
        for (int j = 0; j < 8; ++j) { fA[s2][j] = (h16)sA[8 * s2 + j]; fB[s2][j] = (h16)sB[8 * s2 + j]; }
#pragma unroll
    for (int db = 0; db < 2; ++db)
#pragma unroll
        for (int s2 = 0; s2 < 2; ++s2) { const h16x8 a = tr_frag<false>(Vt, vpitch, 16 * s2, 32 * db, lane); oA[db] = mfma32(a, fA[s2], oA[db]); oB[db] = mfma32(a, fB[s2], oB[db]); }
}
constexpr int DK_PITCH = 72, DV_PITCH = 96;
constexpr int DIL_V_OFF = 384 * DK_PITCH * 2;
constexpr float QK_SCALE64 = 0.125f * 1.4426950408889634f;
struct DilGeo { int br, b, h, d, tok0, res0, U0, nrows, segbase; };
struct DilPre { h16x8 vreg[6], kreg[6], qa[4]; };
__device__ __forceinline__ DilGeo dil_geo(int bh, int rr) {
    DilGeo g; const int x = rr & 7; g.br = rr >> 3; g.b = bh >> 2; g.h = bh & 3; g.d = g.br == 0 ? 1 : g.br == 1 ? 4 : 16; g.tok0 = g.b * SEQ;
    if (g.br == 0) { g.res0 = 0; g.U0 = 256 * x; g.nrows = 384; } else if (g.br == 1) { g.res0 = x >> 1; g.U0 = 256 * (x & 1); g.nrows = 384; } else { g.res0 = 2 * x; g.U0 = 128; g.nrows = 256; }
    g.segbase = g.U0 - 128;
    return g;
}
__device__ __forceinline__ void dil_qgeo(const DilGeo& g, int w, int& res, int& jblk, int& rowoff) {
    if (g.br == 2) { res = g.res0 + (w >> 2); jblk = w & 3; rowoff = 128 * (w >> 2); } else { res = g.res0; jblk = (g.U0 >> 5) + w; rowoff = -g.segbase; }
}
__device__ __forceinline__ void dil_issue(const Core& C, const Frame& F, const DilGeo& g, DilPre& P) {
    const h16* Z = (const h16*)(C.ws + WS_Z);
    const int tid = F.tid, lane = F.lane, br = g.br, d = g.d, h = g.h;
#pragma unroll
    for (int i = 0; i < 6; ++i) {
        int it = tid + 512 * i; if (it >= g.nrows * 8) it = g.nrows * 8 - 1;
        const int ri = it >> 3, c8 = it & 7;
        int up, res; if (br == 2) { up = ri & 127; res = g.res0 + (ri >> 7); } else { up = g.segbase + ri; res = g.res0; }
        if (up < 0) up = 0;
        const h16* src = Z + (size_t)(g.tok0 + up * d + res) * ZP + ZC_C + h * 64 + 8 * c8;
        P.vreg[i] = *(const h16x8*)(src + 512); P.kreg[i] = *(const h16x8*)(src + 256);
    }
    int res, jblk, rowoff; dil_qgeo(g, F.wave, res, jblk, rowoff);
    const int qi = lane & 31, hh = lane >> 5;
    const int qtok = g.tok0 + (32 * jblk + qi) * d + res;
    const h16* qsrc = Z + (size_t)qtok * ZP + ZC_C + h * 64 + 8 * hh;
#pragma unroll
    for (int ds = 0; ds < 4; ++ds) P.qa[ds] = *(const h16x8*)(qsrc + 16 * ds);
}
__device__ __forceinline__ void dil_stage(const Frame& F, const DilGeo& g, const DilPre& P, h16x8 (&qf)[4]) {
    LAS h16* Kt = (LAS h16*)F.lds; LAS h16* Vt = (LAS h16*)(F.lds + DIL_V_OFF);
    const int tid = F.tid, br = g.br;
#pragma unroll
    for (int i = 0; i < 6; ++i) {
        const int it = tid + 512 * i; const int ri = it >> 3, c8 = it & 7;
        int up; if (br == 2) up = ri & 127; else up = g.segbase + ri;
        if (it < g.nrows * 8 && up >= 0) { *(LAS h16x8*)(Vt + ri * DV_PITCH + 8 * c8) = P.vreg[i]; *(LAS h16x8*)(Kt + ri * DK_PITCH + 8 * c8) = P.kreg[i]; }
    }
#pragma unroll
    for (int ds = 0; ds < 4; ++ds) qf[ds] = P.qa[ds];
}
__device__ __forceinline__ void dil_compute(const Core& C, const Frame& F, const DilGeo& g, const h16x8 (&qf)[4]) {
    h16* DP = (h16*)((unsigned char*)C.out + OUT_DP); float* DL = (float*)((unsigned char*)C.out + OUT_DL);
    const LAS h16* Kt = (const LAS h16*)F.lds; const LAS h16* Vt = (const LAS h16*)(F.lds + DIL_V_OFF);
    const int lane = F.lane, br = g.br, h = g.h;
    int res, jblk, rowoff; dil_qgeo(g, F.wave, res, jblk, rowoff);
    const int qi = lane & 31, hh = lane >> 5;
    const int qtok = g.tok0 + (32 * jblk + qi) * g.d + res;
    float m = -INFINITY, ls = 0.f; f32x16 o[2];
#pragma unroll
    for (int i = 0; i < 16; ++i) { o[0][i] = 0.f; o[1][i] = 0.f; }
    {
        const int ub0 = 32 * (jblk - 4);
        if (ub0 >= 0) { const int rowb = ub0 + rowoff; attn_tile<64, 1>(Kt + rowb * DK_PITCH, DK_PITCH, Vt + rowb * DV_PITCH, DV_PITCH, qf, m, ls, o, true, qi, 64, lane); }
        if (ub0 + 32 >= 0) { const int rowb = ub0 + 32 + rowoff; attn_tile<64, 2>(Kt + rowb * DK_PITCH, DK_PITCH, Vt + rowb * DV_PITCH, DV_PITCH, qf, m, ls, o, false, -1, 64, lane); }
        else if (ub0 + 64 >= 0) { const int rowb = ub0 + 64 + rowoff; attn_tile<64, 1>(Kt + rowb * DK_PITCH, DK_PITCH, Vt + rowb * DV_PITCH, DV_PITCH, qf, m, ls, o, false, -1, 64, lane); }
        if (ub0 + 96 >= 0) { const int rowb = ub0 + 96 + rowoff; attn_tile<64, 2>(Kt + rowb * DK_PITCH, DK_PITCH, Vt + rowb * DV_PITCH, DV_PITCH, qf, m, ls, o, true, -1, 32 + qi, lane); }
        else { const int rowb = ub0 + 128 + rowoff; attn_tile<64, 1>(Kt + rowb * DK_PITCH, DK_PITCH, Vt + rowb * DV_PITCH, DV_PITCH, qf, m, ls, o, true, -1, qi, lane); }
    }
    const float lt = ls + __shfl_xor(ls, 32);
    const float inv = 1.0f / lt;
    unsigned char* dst8 = (unsigned char*)DP + ((size_t)qtok * 3 + br) * 256 + h * 64 + 16 * hh;
#pragma unroll
    for (int db = 0; db < 2; ++db) { u32x4 w;
#pragma unroll
        for (int gq = 0; gq < 4; ++gq) { int p = __builtin_amdgcn_cvt_pk_fp8_f32(o[db][4 * gq] * inv, o[db][4 * gq + 1] * inv, 0, false); p = __builtin_amdgcn_cvt_pk_fp8_f32(o[db][4 * gq + 2] * inv, o[db][4 * gq + 3] * inv, p, true); w[gq] = (unsigned)p; }
        *(u32x4*)(dst8 + 32 * db) = w; }
    if (hh == 0) DL[((size_t)qtok * 3 + br) * 4 + h] = m + __builtin_amdgcn_logf(lt);
}
template <int l>
__device__ __forceinline__ void dilated_phase(const Core& C, const Frame& F0) {
    const Frame F = fresh_frame(F0);
    int bh, rr;
    if (!bh_unit(0, 24, F.G, bh, rr)) return;
    DilGeo g = dil_geo(bh, rr); DilPre P;
    dil_issue(C, F, g, P);
    int it = 0;
#pragma unroll 1
    for (;;) {
        h16x8 qf[4];
        dil_stage(F, g, P, qf);
        __syncthreads();
        int bh2, rr2; const bool hn = bh_unit(it + 1, 24, F.G, bh2, rr2);
        DilGeo g2 = g;
        if (hn) { g2 = dil_geo(bh2, rr2); dil_issue(C, F, g2, P); }
        dil_compute(C, F, g, qf);
        asm volatile("s_waitcnt lgkmcnt(0)" ::: "memory"); __builtin_amdgcn_s_barrier(); asm volatile("" ::: "memory");
        if (!hn) break;
        g = g2; ++it;
    }
}
__device__ __forceinline__ void dil_combine(const Core& C, const Frame& F0) {
    const Frame F = fresh_frame(F0);
    const h16* DP = (const h16*)((unsigned char*)C.out + OUT_DP); const float* DL = (const float*)((unsigned char*)C.out + OUT_DL); h16* Y = (h16*)((unsigned char*)C.out + OUT_Y);
    const size_t gt = (size_t)blockIdx.x * 512 + F.tid, NT = (size_t)F.G * 512;
    const unsigned char* DP8 = (const unsigned char*)DP;
    for (size_t it0 = gt; it0 < (size_t)M * 8; it0 += 2 * NT) {
        float l0[2], l1[2], l2[2]; u32x4 av[2][3][2];
#pragma unroll
        for (int k = 0; k < 2; ++k) { size_t it = it0 + k * NT; if (it >= (size_t)M * 8) it = (size_t)M * 8 - 1; const size_t tok = it >> 3; const int hd = (int)(it & 7), h = hd >> 1, db = hd & 1;
            const size_t off = (size_t)h * 64 + 32 * db;
            l0[k] = DL[(tok * 3 + 0) * 4 + h]; l1[k] = DL[(tok * 3 + 1) * 4 + h]; l2[k] = DL[(tok * 3 + 2) * 4 + h];
#pragma unroll
            for (int br = 0; br < 3; ++br) { av[k][br][0] = *(const u32x4*)(DP8 + (tok * 3 + br) * 256 + off); av[k][br][1] = *(const u32x4*)(DP8 + (tok * 3 + br) * 256 + off + 16); } }
#pragma unroll
        for (int k = 0; k < 2; ++k) { const size_t it = it0 + k * NT; if (it >= (size_t)M * 8) continue; const size_t tok = it >> 3; const int hd = (int)(it & 7);
            const float mx = fmaxf(l0[k], fmaxf(l1[k], l2[k]));
            float w0 = __builtin_amdgcn_exp2f(l0[k] - mx), w1 = __builtin_amdgcn_exp2f(l1[k] - mx), w2 = __builtin_amdgcn_exp2f(l2[k] - mx);
            const float inv = 1.0f / (w0 + w1 + w2); w0 *= inv; w1 *= inv; w2 *= inv;
#pragma unroll
            for (int g = 0; g < 4; ++g) {
                float r[8];
#pragma unroll
                for (int half = 0; half < 2; ++half) {
                    const unsigned x0 = av[k][0][half][g], x1 = av[k][1][half][g], x2 = av[k][2][half][g];
                    const f32x2 p0 = __builtin_amdgcn_cvt_pk_f32_fp8((int)x0, false), q0 = __builtin_amdgcn_cvt_pk_f32_fp8((int)x0, true);
                    const f32x2 p1 = __builtin_amdgcn_cvt_pk_f32_fp8((int)x1, false), q1 = __builtin_amdgcn_cvt_pk_f32_fp8((int)x1, true);
                    const f32x2 p2 = __builtin_amdgcn_cvt_pk_f32_fp8((int)x2, false), q2 = __builtin_amdgcn_cvt_pk_f32_fp8((int)x2, true);
                    r[4 * half + 0] = p0[0] * w0 + p1[0] * w1 + p2[0] * w2; r[4 * half + 1] = p0[1] * w0 + p1[1] * w1 + p2[1] * w2;
                    r[4 * half + 2] = q0[0] * w0 + q1[0] * w1 + q2[0] * w2; r[4 * half + 3] = q0[1] * w0 + q1[1] * w1 + q2[1] * w2;
                }
                h16x8 rr;
#pragma unroll
                for (int j = 0; j < 8; ++j) rr[j] = (h16)r[j];
                *(h16x8*)(Y + tok * DM + 512 + 32 * hd + 8 * g) = rr; }
        }
    }
}
__device__ __forceinline__ void mla_krope(const Core& C, const Frame& F0) {
    const Frame F = fresh_frame(F0);
    const h16* Z = (const h16*)(C.ws + WS_Z); const float* rb = (const float*)(C.ws + WS_ROPEB); h16* Kf = (h16*)(C.ws + WS_KF);
    const size_t gt = (size_t)blockIdx.x * 512 + F.tid, NT = (size_t)F.G * 512;
    for (size_t it = gt; it < (size_t)M * 2; it += NT) {
        const size_t tok = it >> 1; const int c = (int)(it & 1);
        const h16x8 x1 = *(const h16x8*)(Z + tok * ZP + ZC_KR + 8 * c), x2 = *(const h16x8*)(Z + tok * ZP + ZC_KR + 16 + 8 * c);
        const float* cs = rb + tok * 32 + 8 * c;
        h16x8 o1, o2;
#pragma unroll
        for (int j = 0; j < 8; ++j) { const float cc = cs[j], ss = cs[16 + j], a = (float)x1[j], b = (float)x2[j]; o1[j] = (h16)(a * cc - b * ss); o2[j] = (h16)(a * ss + b * cc); }
#pragma unroll
        for (int hd = 0; hd < 4; ++hd) { *(h16x8*)(Kf + tok * 384 + hd * 96 + 64 + 8 * c) = o1; *(h16x8*)(Kf + tok * 384 + hd * 96 + 80 + 8 * c) = o2; }
    }
}
constexpr int MK_PITCH = 104, MV_PITCH = 96;
constexpr int MLA_KB = 64 * MK_PITCH * 2, MLA_VB = 64 * MV_PITCH * 2;
template <int MODE>
__device__ __forceinline__ void mla_qblock(const Core& C, const Frame& F0, int b, int h, int qblk, h16* Yout) {
    const Frame F = fresh_frame(F0);
    const h16* Qm = (const h16*)(C.ws + WS_Q); const h16* Kf = (const h16*)(C.ws + WS_KF); const h16* Vm = (const h16*)(C.ws + WS_VM); h16* Y = Yout;
    const int lane = F.lane, w = F.wave, tid = F.tid, qi = lane & 31, hh = lane >> 5;
    const int tok0 = b * SEQ, q0w = 256 * qblk + 32 * w;
    h16x8 qf[6];
    { const h16* qsrc = Qm + (size_t)(tok0 + q0w + qi) * 384 + h * 96 + 8 * hh;
#pragma unroll
      for (int ds = 0; ds < 6; ++ds) qf[ds] = *(const h16x8*)(qsrc + 16 * ds); }
    float m = -INFINITY, ls = 0.f; f32x16 o[2];
#pragma unroll
    for (int i = 0; i < 16; ++i) { o[0][i] = 0.f; o[1][i] = 0.f; }
    const int nkt = 4 * (qblk + 1);
    const int kr0 = tid / 12, kc0 = tid % 12, kr1 = (tid + 512) / 12, kc1 = (tid + 512) % 12, vr = tid >> 3, vc = tid & 7;
    const bool has2 = tid < 256;
    const h16* kp0 = Kf + (size_t)(tok0 + kr0) * 384 + h * 96 + 8 * kc0; const h16* kp1 = Kf + (size_t)(tok0 + (has2 ? kr1 : kr0)) * 384 + h * 96 + 8 * (has2 ? kc1 : kc0);
    const h16* vp = Vm + (size_t)(tok0 + vr) * 256 + h * 64 + 8 * vc;
    const int ko0 = kr0 * MK_PITCH + 8 * kc0, ko1 = kr1 * MK_PITCH + 8 * kc1, vo = vr * MV_PITCH + 8 * vc;
#define MLA_LOAD(KA, KB, VA, t) do { const size_t o_ = (MODE & 1) ? 0 : (size_t)64 * (t); KA = *(const h16x8*)(kp0 + o_ * 384); KB = *(const h16x8*)(kp1 + o_ * 384); VA = *(const h16x8*)(vp + o_ * 256); } while (0)
#define MLA_STORE(KA, KB, VA, buf) do { LAS h16* Kn = (LAS h16*)(F.lds + (buf) * MLA_KB); LAS h16* Vn = (LAS h16*)(F.lds + 3 * MLA_KB + (buf) * MLA_VB); \
        *(LAS h16x8*)(Kn + ko0) = KA; if (has2) *(LAS h16x8*)(Kn + ko1) = KB; *(LAS h16x8*)(Vn + vo) = VA; } while (0)
#define MLA_BAR() do { asm volatile("s_waitcnt lgkmcnt(0)" ::: "memory"); __builtin_amdgcn_s_barrier(); asm volatile("" ::: "memory"); } while (0)
#define MLA_COMPUTE(kt_, buf) do { const LAS h16* Kt = (const LAS h16*)(F.lds + (buf) * MLA_KB); const LAS h16* Vt = (const LAS h16*)(F.lds + 3 * MLA_KB + (buf) * MLA_VB); \
        const int kbase = 64 * (kt_); \
        if (kbase + 32 <= q0w + 31) { attn_tile<96, 2>(Kt, MK_PITCH, Vt, MV_PITCH, qf, m, ls, o, kbase + 63 > q0w, -1, q0w + qi - kbase, lane); } \
        else if (kbase <= q0w + 31) { attn_tile<96, 1>(Kt, MK_PITCH, Vt, MV_PITCH, qf, m, ls, o, true, -1, q0w + qi - kbase, lane); } } while (0)
    h16x8 kaA, kbA, vaA, kaB, kbB, vaB;
    MLA_LOAD(kaA, kbA, vaA, 0);
    MLA_LOAD(kaB, kbB, vaB, 1);
    MLA_STORE(kaA, kbA, vaA, 0);
    MLA_BAR();
    int buf = 0;
#pragma unroll 1
    for (int kt = 0; kt < nkt; kt += 2) {
        const int b1 = buf == 2 ? 0 : buf + 1, b2 = b1 == 2 ? 0 : b1 + 1;
        if (kt + 2 < nkt) MLA_LOAD(kaA, kbA, vaA, kt + 2);
        MLA_COMPUTE(kt, buf);
        MLA_STORE(kaB, kbB, vaB, b1);
        MLA_BAR();
        if (kt + 3 < nkt) MLA_LOAD(kaB, kbB, vaB, kt + 3);
        MLA_COMPUTE(kt + 1, b1);
        if (kt + 2 < nkt) MLA_STORE(kaA, kbA, vaA, b2);
        MLA_BAR();
        buf = b2;
    }
#undef MLA_LOAD
#undef MLA_STORE
#undef MLA_BAR
#undef MLA_COMPUTE
    const float lt = ls + __shfl_xor(ls, 32);
    const float inv = 1.0f / lt;
    h16* dst = Y + (size_t)(tok0 + q0w + qi) * DM + 256 + h * 64;
#pragma unroll
    for (int db = 0; db < 2; ++db) { u32x2 ov[4];
#pragma unroll
        for (int g = 0; g < 4; ++g) { ov[g].x = pkh(o[db][4 * g] * inv, o[db][4 * g + 1] * inv); ov[g].y = pkh(o[db][4 * g + 2] * inv, o[db][4 * g + 3] * inv); }
        store_row32(dst + 32 * db, ov, hh); }
}
template <int MODE>
__device__ __forceinline__ void mla_qblock2(const Core& C, const Frame& F0, int b, int h, int qblk, h16* Yout) {
    const Frame F = fresh_frame(F0);
    const h16* Qm = (const h16*)(C.ws + WS_Q); const h16* Kf = (const h16*)(C.ws + WS_KF); const h16* Vm = (const h16*)(C.ws + WS_VM); h16* Y = Yout;
    const int lane = F.lane, w = F.wave, tid = F.tid, qi = lane & 31, hh = lane >> 5;
    const int tok0 = b * SEQ, q0w = 512 * qblk + 64 * w;
    h16x8 qf[6], qg[6];
    { const h16* qsrc = Qm + (size_t)(tok0 + q0w + qi) * 384 + h * 96 + 8 * hh;
#pragma unroll
      for (int ds = 0; ds < 6; ++ds) { qf[ds] = *(const h16x8*)(qsrc + 16 * ds); qg[ds] = *(const h16x8*)(qsrc + (size_t)32 * 384 + 16 * ds); } }
    float m = -INFINITY, ls = 0.f, m2 = -INFINITY, ls2 = 0.f; f32x16 o[2], o2[2];
#pragma unroll
    for (int i = 0; i < 16; ++i) { o[0][i] = 0.f; o[1][i] = 0.f; o2[0][i] = 0.f; o2[1][i] = 0.f; }
    const int nkt = 8 * (qblk + 1);
    const int kr0 = tid / 12, kc0 = tid % 12, kr1 = (tid + 512) / 12, kc1 = (tid + 512) % 12, vr = tid >> 3, vc = tid & 7;
    const bool has2 = tid < 256;
    const h16* kp0 = Kf + (size_t)(tok0 + kr0) * 384 + h * 96 + 8 * kc0; const h16* kp1 = Kf + (size_t)(tok0 + (has2 ? kr1 : kr0)) * 384 + h * 96 + 8 * (has2 ? kc1 : kc0);
    const h16* vp = Vm + (size_t)(tok0 + vr) * 256 + h * 64 + 8 * vc;
    const int ko0 = kr0 * MK_PITCH + 8 * kc0, ko1 = kr1 * MK_PITCH + 8 * kc1, vo = vr * MV_PITCH + 8 * vc;
#define MLA_LOAD(KA, KB, VA, t) do { const size_t o_ = (MODE & 1) ? 0 : (size_t)64 * (t); KA = *(const h16x8*)(kp0 + o_ * 384); KB = *(const h16x8*)(kp1 + o_ * 384); VA = *(const h16x8*)(vp + o_ * 256); } while (0)
#define MLA_STORE(KA, KB, VA, buf) do { LAS h16* Kn = (LAS h16*)(F.lds + (buf) * MLA_KB); LAS h16* Vn = (LAS h16*)(F.lds + 3 * MLA_KB + (buf) * MLA_VB); \
        *(LAS h16x8*)(Kn + ko0) = KA; if (has2) *(LAS h16x8*)(Kn + ko1) = KB; *(LAS h16x8*)(Vn + vo) = VA; } while (0)
#define MLA_BAR() do { asm volatile("s_waitcnt lgkmcnt(0)" ::: "memory"); __builtin_amdgcn_s_barrier(); asm volatile("" ::: "memory"); } while (0)
#define MLA_COMPUTE(kt_, buf) do { const LAS h16* Kt = (const LAS h16*)(F.lds + (buf) * MLA_KB); const LAS h16* Vt = (const LAS h16*)(F.lds + 3 * MLA_KB + (buf) * MLA_VB); \
        _Pragma("unroll") for (int sub_ = 0; sub_ < 2; ++sub_) { const int kbase = 64 * (kt_) + 32 * sub_; \
            const LAS h16* Ks = Kt + 32 * sub_ * MK_PITCH; const LAS h16* Vs = Vt + 32 * sub_ * MV_PITCH; \
              \
            if (kbase <= q0w + 63) attn_tile_dual<96>(Ks, MK_PITCH, Vs, MV_PITCH, qf, qg, m, ls, o, m2, ls2, o2, kbase + 31 > q0w, q0w + qi - kbase, kbase + 31 > q0w + 32, q0w + 32 + qi - kbase, lane); } } while (0)
    h16x8 kaA, kbA, vaA, kaB, kbB, vaB;
    MLA_LOAD(kaA, kbA, vaA, 0);
    MLA_LOAD(kaB, kbB, vaB, 1);
    MLA_STORE(kaA, kbA, vaA, 0);
    MLA_BAR();
    int buf = 0;
#pragma unroll 1
    for (int kt = 0; kt < nkt; kt += 2) {
        const int b1 = buf == 2 ? 0 : buf + 1, b2 = b1 == 2 ? 0 : b1 + 1;
        if (kt + 2 < nkt) MLA_LOAD(kaA, kbA, vaA, kt + 2);
        MLA_COMPUTE(kt, buf);
        MLA_STORE(kaB, kbB, vaB, b1);
        MLA_BAR();
        if (kt + 3 < nkt) MLA_LOAD(kaB, kbB, vaB, kt + 3);
        MLA_COMPUTE(kt + 1, b1);
        if (kt + 2 < nkt) MLA_STORE(kaA, kbA, vaA, b2);
        MLA_BAR();
        buf = b2;
    }
#undef MLA_LOAD
#undef MLA_STORE
#undef MLA_BAR
#undef MLA_COMPUTE
    {
    const float lt = ls + __shfl_xor(ls, 32);
    const float inv = 1.0f / lt;
    h16* dst = Y + (size_t)(tok0 + q0w + qi) * DM + 256 + h * 64;
#pragma unroll
    for (int db = 0; db < 2; ++db) { u32x2 ov[4];
#pragma unroll
        for (int g = 0; g < 4; ++g) { ov[g].x = pkh(o[db][4 * g] * inv, o[db][4 * g + 1] * inv); ov[g].y = pkh(o[db][4 * g + 2] * inv, o[db][4 * g + 3] * inv); }
        store_row32(dst + 32 * db, ov, hh); }
    }
    {
    const float lt = ls2 + __shfl_xor(ls2, 32);
    const float inv = 1.0f / lt;
    h16* dst = Y + (size_t)(tok0 + q0w + 32 + qi) * DM + 256 + h * 64;
#pragma unroll
    for (int db = 0; db < 2; ++db) { u32x2 ov[4];
#pragma unroll
        for (int g = 0; g < 4; ++g) { ov[g].x = pkh(o2[db][4 * g] * inv, o2[db][4 * g + 1] * inv); ov[g].y = pkh(o2[db][4 * g + 2] * inv, o2[db][4 * g + 3] * inv); }
        store_row32(dst + 32 * db, ov, hh); }
    }
}

template <int MODE>
__device__ __forceinline__ void mla_unit2(const Core& C, const Frame& F, int unit, h16* Yout) {
    const int bh = unit >> 1, p = unit & 1;
    mla_qblock2<MODE>(C, F, bh >> 2, bh & 3, 3 - p, Yout);
    mla_qblock2<MODE>(C, F, bh >> 2, bh & 3, p, Yout);
}
template <int MODE>
__device__ __forceinline__ void mla_unit(const Core& C, const Frame& F, int unit, h16* Yout) {
    const int b = unit >> 4, h = (unit >> 2) & 3, p = unit & 3;
    mla_qblock<MODE>(C, F, b, h, 7 - p, Yout);
    mla_qblock<MODE>(C, F, b, h, p, Yout);
}


constexpr int ML_QP = 72, ML_VP = 96;
constexpr int ML_Q = 0, ML_K = ML_Q + 128 * ML_QP * 2, ML_KW = ML_K + 128 * ML_QP * 2, ML_V = ML_KW + 128 * ML_VP * 2, ML_C = ML_V + 128 * ML_VP * 2, ML_F = ML_C + 64 * ML_VP * 2;
constexpr float LOG2E = 1.4426950408889634f;
constexpr int MLG_STRIDE = 400;
__device__ __forceinline__ void ml_conv_load(const h16* Z, const float* cw, const float* cb, int b, int c, int h, const bool both, LAS h16* Qt, LAS h16* Kt, int tid) {
    const int isk = both ? (tid >> 8) : 1, rg = (tid & 255) >> 3, c8 = tid & 7, col = isk * 256 + h * 64 + 8 * c8;
    if (!both && tid >= 256) return;
    h16x8 xv[7];
#pragma unroll
    for (int j = 0; j < 7; ++j) { int pos = 128 * c + 4 * rg - 3 + j; if (pos < 0) pos = 0;
        xv[j] = *(const h16x8*)(Z + (size_t)(b * SEQ + pos) * ZP + ZC_D + col); }
    f32x4 w0[4], w1[4];
#pragma unroll
    for (int j = 0; j < 4; ++j) { w0[j] = *(const f32x4*)(cw + j * 512 + col); w1[j] = *(const f32x4*)(cw + j * 512 + col + 4); }
    const f32x4 b0 = *(const f32x4*)(cb + col), b1 = *(const f32x4*)(cb + col + 4);
    const float sc = isk ? 0.125f : 1.0f;
    LAS h16* dst = isk ? Kt : Qt;
#pragma unroll
    for (int i = 0; i < 4; ++i) {
        float acc[8];
#pragma unroll
        for (int e = 0; e < 4; ++e) { acc[e] = b0[e]; acc[4 + e] = b1[e]; }
#pragma unroll
        for (int j = 0; j < 4; ++j) { const float on = (128 * c + 4 * rg + i - 3 + j >= 0) ? 1.0f : 0.0f;
#pragma unroll
            for (int e = 0; e < 4; ++e) { acc[e] += on * w0[j][e] * (float)xv[i + j][e]; acc[4 + e] += on * w1[j][e] * (float)xv[i + j][4 + e]; } }
        h16x8 ov;
#pragma unroll
        for (int e = 0; e < 8; ++e) { const float y = acc[e]; ov[e] = (h16)(y * sc * __builtin_amdgcn_rcpf(1.0f + __builtin_amdgcn_exp2f(-y * LOG2E))); }
        *(LAS h16x8*)(dst + (4 * rg + i) * ML_QP + 8 * c8) = ov;
    }
}
__device__ __forceinline__ void ml_gate_load(const h16* Z, int tokc, int h, int lane, h16 (&gz)[4]) {
    const size_t z0 = (size_t)(tokc + 2 * lane) * ZP + ZC_GATE + h;
    gz[0] = Z[z0]; gz[1] = Z[z0 + ZP]; gz[2] = Z[z0 + 4]; gz[3] = Z[z0 + ZP + 4];
}
__device__ __forceinline__ void ml_gates(const h16 (&gz)[4], float igb, float fgb, LAS float* gk, LAS float* bc, LAS float* pm, int lane, float& bend, float& gmax) {
    const float i0 = (float)gz[0] + igb, i1 = (float)gz[1] + igb, f0 = (float)gz[2] + fgb, f1 = (float)gz[3] + fgb;
    const float fl0 = fminf(f0, 0.f) - log1pf(expf(-fabsf(f0))), fl1 = fminf(f1, 0.f) - log1pf(expf(-fabsf(f1)));
    float sc = fl0 + fl1;
#pragma unroll
    for (int o = 1; o < 64; o <<= 1) { const float t = __shfl_up(sc, o); if (lane >= o) sc += t; }
    const float bc1 = sc, bc0 = sc - fl1;
    const float g0 = i0 - bc0, g1 = i1 - bc1;
    float p = fmaxf(g0, g1);
#pragma unroll
    for (int o = 1; o < 64; o <<= 1) { const float t = __shfl_up(p, o); if (lane >= o) p = fmaxf(p, t); }
    float pprev = __shfl_up(p, 1); if (lane == 0) pprev = -INFINITY;
    gk[2 * lane] = g0; gk[2 * lane + 1] = g1; bc[2 * lane] = bc0; bc[2 * lane + 1] = bc1; pm[2 * lane] = fmaxf(pprev, g0); pm[2 * lane + 1] = p;
    bend = __shfl(bc1, 63); gmax = __shfl(p, 63);
}
template <int l>
__device__ __forceinline__ void mlstm_part1(const Core& C, const Frame& F0, int unit) {
    const Frame F = fresh_frame(F0);
    const h16* Z = (const h16*)(C.ws + WS_Z); const float* par = (const float*)(C.ws + WS_PAR);
    h16* DC = (h16*)(C.ws + WS_MLC); float* DN = (float*)(C.ws + WS_MLN);
    const int bh = unit >> 4, c = unit & 15, b = bh >> 2, h = bh & 3, lane = F.lane, w = F.wave, tid = F.tid, qi = lane & 31, hh = lane >> 5;
    const int u15 = bh * 15 + c;
    float* GA = (float*)(C.ws + WS_MLG) + (size_t)unit * MLG_STRIDE;
    LAS h16* Kt = (LAS h16*)(F.lds + ML_K); LAS h16* KWt = (LAS h16*)(F.lds + ML_KW); LAS h16* Vt = (LAS h16*)(F.lds + ML_V);
    LAS float* gk = (LAS float*)(F.lds + ML_F); LAS float* pm = gk + 128; LAS float* bc = gk + 256; LAS float* scal = gk + 448;
    const int tokc = b * SEQ + 128 * c;
    h16 gz[4];
    if (w == 7) ml_gate_load(Z, tokc, h, lane, gz);
    if (c < 15) {
    const int r0 = tid >> 3, c8 = tid & 7;
    const h16x8 va = *(const h16x8*)(Z + (size_t)(tokc + r0) * ZP + ZC_D + 512 + h * 64 + 8 * c8), vb = *(const h16x8*)(Z + (size_t)(tokc + r0 + 64) * ZP + ZC_D + 512 + h * 64 + 8 * c8);
    ml_conv_load(Z, par + PF_CONVW + l * 4 * 512, par + PF_CONVB + l * 512, b, c, h, false, Kt, Kt, tid);
    *(LAS h16x8*)(Vt + r0 * ML_VP + 8 * c8) = va; *(LAS h16x8*)(Vt + (r0 + 64) * ML_VP + 8 * c8) = vb;
    }
    if (w == 7) { float bend, gmax; ml_gates(gz, par[PF_IGB + l * 4 + h], par[PF_FGB + l * 4 + h], gk, bc, pm, lane, bend, gmax);
        if (lane == 0) { scal[0] = bend; scal[1] = gmax; GA[384] = bend; GA[385] = gmax; } }
    __syncthreads();
    if (tid < 384) GA[tid] = gk[tid];
    if (c == 15) { UNIT_END_BAR(); return; }
    { const float gmax = scal[1];
      for (int it = tid; it < 1024; it += 512) { const int r = it >> 3, c8 = it & 7; const float wk = __builtin_amdgcn_exp2f((gk[r] - gmax) * LOG2E);
        const h16x8 kv = *(const LAS h16x8*)(Kt + r * ML_QP + 8 * c8); h16x8 o;
#pragma unroll
        for (int e = 0; e < 8; ++e) o[e] = (h16)((float)kv[e] * wk);
        *(LAS h16x8*)(KWt + r * ML_VP + 8 * c8) = o; } }
    __syncthreads();
    if (w < 4) {
        const int dkb = w >> 1, dvb = w & 1;
        f32x16 acc;
#pragma unroll
        for (int i = 0; i < 16; ++i) acc[i] = 0.f;
#pragma unroll
        for (int ks = 0; ks < 8; ++ks) { const h16x8 a = tr_frag<true>(KWt, ML_VP, 16 * ks, 32 * dkb, lane), bq = tr_frag<true>(Vt, ML_VP, 16 * ks, 32 * dvb, lane); acc = mfma32(a, bq, acc); }
        u32x2 ov[4];
#pragma unroll
        for (int g = 0; g < 4; ++g) { ov[g].x = pkh(acc[4 * g], acc[4 * g + 1]); ov[g].y = pkh(acc[4 * g + 2], acc[4 * g + 3]); }
        store_row32(DC + (size_t)u15 * 4096 + (32 * dvb + qi) * 64 + 32 * dkb, ov, hh);
    } else if (w == 4) {
        float sacc = 0.f;
#pragma unroll 8
        for (int r = 0; r < 128; ++r) sacc += (float)KWt[r * ML_VP + lane];
        DN[(size_t)u15 * 128 + lane] = sacc;
    }
    UNIT_END_BAR();
}
template <int l>
__device__ __forceinline__ void mlstm_part2(const Core& C, const Frame& F0, int unit) {
    const Frame F = fresh_frame(F0);
    const h16* Z = (const h16*)(C.ws + WS_Z); h16* Y = (h16*)((unsigned char*)C.out + OUT_Y); const float* par = (const float*)(C.ws + WS_PAR);
    const h16* DC = (const h16*)(C.ws + WS_MLC); const float* DN = (const float*)(C.ws + WS_MLN);
    const int bh = unit >> 4, c = unit & 15, b = bh >> 2, h = bh & 3, lane = F.lane, w = F.wave, tid = F.tid, qi = lane & 31, hh = lane >> 5;
    LAS h16* Qt = (LAS h16*)(F.lds + ML_Q); LAS h16* Kt = (LAS h16*)(F.lds + ML_K); LAS h16* Vt = (LAS h16*)(F.lds + ML_V); LAS h16* Cs = (LAS h16*)(F.lds + ML_C);
    LAS float* gk = (LAS float*)(F.lds + ML_F); LAS float* pm = gk + 128; LAS float* bc = gk + 256; LAS float* nvec = gk + 384; LAS float* scal = gk + 448;
    const int tokc = b * SEQ + 128 * c;
    const float* cw = par + PF_CONVW + l * 4 * 512; const float* cb = par + PF_CONVB + l * 512;
    h16x8 dvv[15]; float dnn[15]; h16x4 ogv[4];
    { const int dk = tid >> 3, d8 = tid & 7;
#pragma unroll
      for (int j0 = 0; j0 < 15; j0 += 5) {
          if (j0 < c) {
#pragma unroll
              for (int j = j0; j < j0 + 5; ++j) { const int jj = j < c ? j : c - 1;
                  dvv[j] = *(const h16x8*)(DC + (size_t)(bh * 15 + jj) * 4096 + dk * 64 + 8 * d8); dnn[j] = DN[(size_t)(bh * 15 + jj) * 128 + (tid & 63)]; }
          } else {
#pragma unroll
              for (int j = j0; j < j0 + 5; ++j) { dvv[j] = (h16x8){(h16)0.f, (h16)0.f, (h16)0.f, (h16)0.f, (h16)0.f, (h16)0.f, (h16)0.f, (h16)0.f}; dnn[j] = 0.f; }
          }
      }
      const size_t zo = (size_t)(tokc + 32 * (w >> 1) + qi) * ZP + ZC_D + 768 + h * 64 + 32 * (w & 1) + 4 * hh;
#pragma unroll
      for (int g = 0; g < 4; ++g) ogv[g] = *(const h16x4*)(Z + zo + 8 * g); }
    const int r0v = tid >> 3, c8v = tid & 7;
    const h16x8 va = *(const h16x8*)(Z + (size_t)(tokc + r0v) * ZP + ZC_D + 512 + h * 64 + 8 * c8v), vb = *(const h16x8*)(Z + (size_t)(tokc + r0v + 64) * ZP + ZC_D + 512 + h * 64 + 8 * c8v);
    const float* GAu = (const float*)(C.ws + WS_MLG) + (size_t)unit * MLG_STRIDE;
    const float gav = GAu[tid < 384 ? tid : 383];
    const float* GAb = (const float*)(C.ws + WS_MLG) + (size_t)(bh * 16) * MLG_STRIDE;
    const int jl = lane < 15 ? lane : 14;
    const float be_l = GAb[(size_t)jl * MLG_STRIDE + 384], gm_l = GAb[(size_t)jl * MLG_STRIDE + 385];
    ml_conv_load(Z, cw, cb, b, c, h, true, Qt, Kt, tid);
    *(LAS h16x8*)(Vt + r0v * ML_VP + 8 * c8v) = va; *(LAS h16x8*)(Vt + (r0v + 64) * ML_VP + 8 * c8v) = vb;
    if (tid < 384) gk[tid] = gav;
    if (w == 0) {
        const bool act = lane < c;
        float Bs = act ? be_l : 0.f;
#pragma unroll
        for (int o = 1; o < 16; o <<= 1) { const float t = __shfl_down(Bs, o); if (lane + o < 64) Bs += t; }
        const float cand = act ? gm_l + Bs : -INFINITY;
        float mc = cand;
#pragma unroll
        for (int o = 1; o < 16; o <<= 1) mc = fmaxf(mc, __shfl_xor(mc, o));
        mc = fmaxf(__shfl(mc, 0), __shfl(Bs, 0));
        if (lane < 16) scal[16 + lane] = act ? __builtin_amdgcn_exp2f((cand - mc) * LOG2E) : 0.f;
        if (lane == 0) scal[0] = mc;
    }
    __syncthreads();
    {
        const int dk = tid >> 3, d8 = tid & 7;
        float a8[8];
#pragma unroll
        for (int e = 0; e < 8; ++e) a8[e] = 0.f;
        float nn = 0.f;
#pragma unroll
        for (int j = 0; j < 15; ++j) { const float cf = scal[16 + j];
#pragma unroll
            for (int e = 0; e < 8; ++e) a8[e] += cf * (float)dvv[j][e];
            nn += cf * dnn[j]; }
        h16x8 o;
#pragma unroll
        for (int e = 0; e < 8; ++e) o[e] = (h16)a8[e];
        *(LAS h16x8*)(Cs + dk * ML_QP + 8 * d8) = o;
        if (tid < 64) nvec[tid] = nn;
    }
    __syncthreads();
    {
        const int tb = w >> 1, dvb = w & 1, t = 32 * tb + qi;
        const float mr = scal[0], Mtt = fmaxf(mr, pm[t]), bct = bc[t];
        h16x8 qf[4];
#pragma unroll
        for (int ds = 0; ds < 4; ++ds) qf[ds] = *(const LAS h16x8*)(Qt + t * ML_QP + 16 * ds + 8 * hh);
        f32x16 num, inter; float den = 0.f;
#pragma unroll
        for (int i = 0; i < 16; ++i) { num[i] = 0.f; inter[i] = 0.f; }
#pragma unroll 1
        for (int sb = 0; sb <= tb; ++sb) {
            f32x16 sc;
#pragma unroll
            for (int i = 0; i < 16; ++i) sc[i] = 0.f;
#pragma unroll
            for (int ds = 0; ds < 4; ++ds) { const h16x8 a = *(const LAS h16x8*)(Kt + (32 * sb + qi) * ML_QP + 16 * ds + 8 * hh); sc = mfma32(a, qf[ds], sc); }
            float ps = 0.f;
#pragma unroll
            for (int i = 0; i < 16; ++i) { const int kk = crow(i, hh); const float wgt = __builtin_amdgcn_exp2f((gk[32 * sb + kk] - Mtt) * LOG2E);
                float p = sc[i] * wgt; if (sb == tb && kk > qi) p = 0.f; sc[i] = p; ps += p; }
            den += ps;
            h16x8 pf[2];
#pragma unroll
            for (int s2 = 0; s2 < 2; ++s2)
#pragma unroll
                for (int j = 0; j < 8; ++j) pf[s2][j] = (h16)sc[8 * s2 + j];
#pragma unroll
            for (int s2 = 0; s2 < 2; ++s2) { const h16x8 a = tr_frag<false>(Vt + 32 * sb * ML_VP, ML_VP, 16 * s2, 32 * dvb, lane); num = mfma32(a, pf[s2], num); }
        }
        float dq = 0.f;
#pragma unroll
        for (int ks = 0; ks < 4; ++ks) { const h16x8 a = *(const LAS h16x8*)(Cs + (32 * dvb + qi) * ML_QP + 16 * ks + 8 * hh); inter = mfma32(a, qf[ks], inter);
#pragma unroll
            for (int j = 0; j < 8; ++j) dq += (float)qf[ks][j] * nvec[16 * ks + 8 * hh + j]; }
        den += __shfl_xor(den, 32); dq += __shfl_xor(dq, 32);
        const float scl = __builtin_amdgcn_exp2f((mr - Mtt) * LOG2E);
        const float dtot = den + scl * dq;
        const float dnm = fmaxf(fabsf(dtot), __builtin_amdgcn_exp2f(-(bct + Mtt) * LOG2E));
        const float inv = 1.0f / dnm;
        u32x2 ov[4];
#pragma unroll
        for (int g = 0; g < 4; ++g) { const h16x4 og = ogv[g]; float r4[4];
#pragma unroll
            for (int j = 0; j < 4; ++j) { const float hv = (num[4 * g + j] + scl * inter[4 * g + j]) * inv; r4[j] = hv * __builtin_amdgcn_rcpf(1.0f + __builtin_amdgcn_exp2f(-(float)og[j] * LOG2E)); }
            ov[g].x = pkh(r4[0], r4[1]); ov[g].y = pkh(r4[2], r4[3]); }
        store_row32(Y + (size_t)(tokc + t) * DM + 768 + h * 64 + 32 * dvb, ov, hh);
    }
    UNIT_END_BAR();
}


constexpr int UP_PITCH = 200;
constexpr int UP_BUF = 32 * UP_PITCH * 2;
template <int l>
__device__ __forceinline__ void mla_upproj_unit(const Core& C, const Frame& F0, int panel) {
    const Frame F = fresh_frame(F0);
    const h16* Z = (const h16*)(C.ws + WS_Z); const float* rb = (const float*)(C.ws + WS_ROPEB); const float* ssq = (const float*)(C.ws + WS_SSQ);
    const h16* Wq = (const h16*)(C.ws + WS_WUQ) + (size_t)l * 512 * 256; const h16* Wkv = (const h16*)(C.ws + WS_WUKV) + (size_t)l * 512 * 256;
    h16* Qm = (h16*)(C.ws + WS_Q); h16* Kf = (h16*)(C.ws + WS_KF); h16* Vm = (h16*)(C.ws + WS_VM);
    const int lane = F.lane, w = F.wave, tid = F.tid, qi = lane & 31, hh = lane >> 5;
    const size_t row = (size_t)panel * 256 + 32 * w + qi;
    h16x8 aq[12], akv[8];
    { const h16* zr = Z + row * ZP + 8 * hh;
#pragma unroll
      for (int ks = 0; ks < 12; ++ks) aq[ks] = *(const h16x8*)(zr + ZC_CQ + 16 * ks);
#pragma unroll
      for (int ks = 0; ks < 8; ++ks) akv[ks] = *(const h16x8*)(zr + ZC_CKV + 16 * ks); }
    const float rsq = rsqrtf(ssq[(size_t)(2 * l) * M + row] * (1.0f / 192.0f) + RMS_EPS) * pg8::QSCALE96;
    const float rskv = rsqrtf(ssq[(size_t)(2 * l + 1) * M + row] * (1.0f / 128.0f) + RMS_EPS);
    const f32x4 cl = *(const f32x4*)(rb + row * 32 + 4 * hh), ch = *(const f32x4*)(rb + row * 32 + 8 + 4 * hh);
    const f32x4 sl = *(const f32x4*)(rb + row * 32 + 16 + 4 * hh), sh = *(const f32x4*)(rb + row * 32 + 24 + 4 * hh);
    { const h16x8 x1 = *(const h16x8*)(Z + row * ZP + ZC_KR + 8 * hh), x2 = *(const h16x8*)(Z + row * ZP + ZC_KR + 16 + 8 * hh);
      const f32x4 c0 = *(const f32x4*)(rb + row * 32 + 8 * hh), c1 = *(const f32x4*)(rb + row * 32 + 8 * hh + 4), s0 = *(const f32x4*)(rb + row * 32 + 16 + 8 * hh), s1 = *(const f32x4*)(rb + row * 32 + 16 + 8 * hh + 4);
      h16x8 o1, o2;
#pragma unroll
      for (int j = 0; j < 8; ++j) { const float cc = j < 4 ? c0[j & 3] : c1[j & 3], ss = j < 4 ? s0[j & 3] : s1[j & 3], a = (float)x1[j], b = (float)x2[j]; o1[j] = (h16)(a * cc - b * ss); o2[j] = (h16)(a * ss + b * cc); }
#pragma unroll
      for (int hd = 0; hd < 4; ++hd) { *(h16x8*)(Kf + row * 384 + hd * 96 + 64 + 8 * hh) = o1; *(h16x8*)(Kf + row * 384 + hd * 96 + 80 + 8 * hh) = o2; } }
    h16x8 wr[6];
#define UP_LOAD(S_) do { if ((S_) < 3) { _Pragma("unroll") for (int e = 0; e < 6; ++e) { const int ch = tid + 512 * e, rr = ch / 24, cc = ch % 24; wr[e] = *(const h16x8*)(Wq + (size_t)(128 * (S_) + rr) * 256 + 8 * cc); } } \
        else { _Pragma("unroll") for (int e = 0; e < 4; ++e) { const int ch = tid + 512 * e, rr = ch >> 4, cc = ch & 15; wr[e] = *(const h16x8*)(Wkv + (size_t)(128 * ((S_) - 3) + rr) * 256 + 8 * cc); } } } while (0)
#define UP_STORE(S_, buf) do { LAS h16* Wt = (LAS h16*)(F.lds + (buf) * (4 * UP_BUF)); if ((S_) < 3) { _Pragma("unroll") for (int e = 0; e < 6; ++e) { const int ch = tid + 512 * e, rr = ch / 24, cc = ch % 24; *(LAS h16x8*)(Wt + rr * UP_PITCH + 8 * cc) = wr[e]; } } \
        else { _Pragma("unroll") for (int e = 0; e < 4; ++e) { const int ch = tid + 512 * e, rr = ch >> 4, cc = ch & 15; *(LAS h16x8*)(Wt + rr * UP_PITCH + 8 * cc) = wr[e]; } } } while (0)
#define UP_BAR() do { asm volatile("s_waitcnt lgkmcnt(0)" ::: "memory"); __builtin_amdgcn_s_barrier(); asm volatile("" ::: "memory"); } while (0)
    UP_LOAD(0); UP_STORE(0, 0); UP_BAR();
#pragma unroll 1
    for (int S = 0; S < 7; ++S) {
        const int buf = S & 1;
        if (S + 1 < 7) UP_LOAD(S + 1);
#pragma unroll
        for (int sub = 0; sub < 4; ++sub) {
            const int s = (S < 3) ? 4 * S + sub : 12 + 4 * (S - 3) + sub;
            const LAS h16* Wt = (const LAS h16*)(F.lds + buf * (4 * UP_BUF)) + (32 * sub + qi) * UP_PITCH + 8 * hh;
            f32x16 acc;
#pragma unroll
            for (int i = 0; i < 16; ++i) acc[i] = 0.f;
            if (S < 3) {
#pragma unroll
                for (int ks = 0; ks < 12; ++ks) acc = mfma32(*(const LAS h16x8*)(Wt + 16 * ks), aq[ks], acc);
#pragma unroll
                for (int i = 0; i < 16; ++i) acc[i] *= rsq;
                if (s % 3 == 2) {
#pragma unroll
                    for (int i = 0; i < 8; ++i) { const float cc = i < 4 ? cl[i & 3] : ch[i & 3], ss = i < 4 ? sl[i & 3] : sh[i & 3], x1 = acc[i], x2 = acc[i + 8]; acc[i] = x1 * cc - x2 * ss; acc[i + 8] = x1 * ss + x2 * cc; }
                }
            } else {
#pragma unroll
                for (int ks = 0; ks < 8; ++ks) acc = mfma32(*(const LAS h16x8*)(Wt + 16 * ks), akv[ks], acc);
#pragma unroll
                for (int i = 0; i < 16; ++i) acc[i] *= rskv;
            }
            u32x2 ov[4];
#pragma unroll
            for (int g = 0; g < 4; ++g) { ov[g].x = pkh(acc[4 * g], acc[4 * g + 1]); ov[g].y = pkh(acc[4 * g + 2], acc[4 * g + 3]); }
            h16* dst;
            if (S < 3) dst = Qm + row * 384 + 32 * s;
            else { const int nb = s - 12, hd = nb >> 2, part = nb & 3; dst = part < 2 ? Kf + row * 384 + hd * 96 + 32 * part : Vm + row * 256 + hd * 64 + 32 * (part - 2); }
            store_row32(dst, ov, hh);
        }
        if (S + 1 < 7) UP_STORE(S + 1, buf ^ 1);
        UP_BAR();
    }
#undef UP_LOAD
#undef UP_STORE
#undef UP_BAR
}

#ifndef STAGGER_TICKS
#define STAGGER_TICKS 0
#endif
__device__ __forceinline__ void stagger_start() {
    if (STAGGER_TICKS > 0) { const unsigned long long t0 = __builtin_amdgcn_s_memrealtime(); const unsigned long long d = (unsigned long long)blockIdx.x * STAGGER_TICKS / gridDim.x;
        while (__builtin_amdgcn_s_memrealtime() - t0 < d) __builtin_amdgcn_s_sleep(8); }
}

template <int l>
__device__ __forceinline__ void layer_body(const Core& C, const Frame& F, const XcdBarrier& bar, const int lo, const int hi, const int use_bar) {
#define IN(k) (lo <= (k) && (k) < hi)
#define SEAM(k) do { if (use_bar && IN(k) && IN((k) + 1)) { xcd_barrier(bar); if (DUP_MASK & 4194304) xcd_barrier(bar); } } while (0)
    h16* V16 = (h16*)(C.ws + WS_V16); h16* Z = (h16*)(C.ws + WS_Z); h16* Hb = (h16*)(C.ws + WS_Z); h16* Y = (h16*)((unsigned char*)C.out + OUT_Y);
    float* c12 = (float*)(C.ws + WS_C12); float* stats = (float*)(C.ws + WS_STATS); float* ssq = (float*)(C.ws + WS_SSQ); const float* par = (const float*)(C.ws + WS_PAR);
    {
        const int pb = 1 + 6 * l;
        float* st_ln1 = stats + (size_t)(2 * l) * 2 * M; float* st_ln2 = stats + (size_t)(2 * l + 1) * 2 * M;
        const float* st_prev = l ? stats + (size_t)(2 * l - 1) * 2 * M : nullptr;
        if (IN(pb) && EN_P1) {
            pg8::Gemm g{V16, (const h16*)(C.ws + WS_WIN) + (size_t)l * ZP * DM, DM, DM, M, ZP, DM};
            pg8::StaticOrder S; S.init(M, ZP, F.G, (int)blockIdx.x);
            stagger_start();
            pg8::EpiIn E{Z, c12 + C1IN + l * ZP, c12 + C2IN + l * ZP, pg8::RowStats{st_prev, st_prev ? st_prev + M : nullptr}, l == 0 ? 1 : 0, ssq + (size_t)(2 * l) * M, ssq + (size_t)(2 * l + 1) * M, -1, (const h16*)(C.ws + WS_ROPEC)};
            pg8::gemm_phase(F.lds, F.wave, g, S, E);
            if (DUP_MASK & 1) { float* dums = (float*)(C.ws + WS_DUMS); pg8::EpiIn E2{(DUP_MASK & 65536) ? (h16*)(C.ws + WS_DUMV) : Z, c12 + C1IN + l * ZP, c12 + C2IN + l * ZP, pg8::RowStats{st_prev, st_prev ? st_prev + M : nullptr}, (DUP_MASK & 262144) ? 1 : (l == 0 ? 1 : 0), dums, dums + M, (DUP_MASK & 65536) ? 255 : -1, (const h16*)(C.ws + WS_ROPEC)};
                __syncthreads(); pg8::gemm_phase(F.lds, F.wave, g, S, E2); }
            if (DUP_MASK & 16384) { pg8::EpiNull EN; __syncthreads(); pg8::gemm_phase(F.lds, F.wave, g, S, EN); }
            if (DUP_MASK & 8388608) { pg8::EpiNull EN; pg8::FixedOrder SF{S}; __syncthreads(); pg8::gemm_phase(F.lds, F.wave, g, SF, EN); }
        }
        SEAM(pb);
        if (IN(pb + 1)) for (int rep = 0; rep < ((DUP_MASK & 2) ? 2 : 1); ++rep) {
            if (ZERO_FROM < DM) { const Frame Fz = fresh_frame(F); const size_t gt = (size_t)blockIdx.x * 512 + Fz.tid, NT = (size_t)F.G * 512; constexpr int ZW = (DM - ZERO_FROM) / 8 > 0 ? (DM - ZERO_FROM) / 8 : 1;
            for (size_t i = gt; i < (size_t)M * (DM - ZERO_FROM) / 8; i += NT) { const size_t r = i / ZW, c = i % ZW; *(u32x4*)(Y + r * DM + ZERO_FROM + c * 8) = (u32x4){0u, 0u, 0u, 0u}; } }
            const int alt = ((int)blockIdx.x >> 3) & 1;
#pragma unroll 1
            for (int step = 0; step < 4; ++step) {
                const int which = alt ? 3 - step : step;
                if (which == 0) { if (EN_D) for (int r2 = 0; r2 < ((DUP_MASK & 64) ? 2 : 1); ++r2) { int bh, r; for (int it = 0; bh_unit(it, 16, F.G, bh, r); ++it) mlstm_part1<l>(C, F, bh * 16 + r); } }
                else if (which == 1) { if (EN_A) for (int r2 = 0; r2 < ((DUP_MASK & 128) ? 2 : 1); ++r2) for (int u = blockIdx.x; u < NB * 16; u += F.G) gmlp_unit<l>(C, F, u); }
                else if (which == 2) { if (EN_C) dilated_phase<l>(C, F); }
                else { if (EN_B && EN_B1) for (int r2 = 0; r2 < ((DUP_MASK & 512) ? 2 : 1); ++r2) {
                    for (int u = blockIdx.x; u < M / 256; u += F.G) mla_upproj_unit<l>(C, F, u);
                    __syncthreads(); } }
            }
        }
        SEAM(pb + 1);
        if (IN(pb + 2)) for (int rep = 0; rep < ((DUP_MASK & 4) ? 2 : 1); ++rep) { if (EN_C) for (int r2 = 0; r2 < ((DUP_MASK & 1024) ? 2 : 1); ++r2) dil_combine(C, F); if (EN_B && EN_B2) { { int bh, r; for (int it = 0; bh_unit(it, 2, F.G, bh, r); ++it) mla_unit2<0>(C, F, bh * 2 + r, Y); }
                if (DUP_MASK & 2048) for (int u = blockIdx.x; u < 512; u += F.G) mla_unit<0>(C, F, u, (h16*)(C.ws + WS_DUMV));
                if (DUP_MASK & 131072) for (int u = blockIdx.x; u < 512; u += F.G) mla_unit<1>(C, F, u, (h16*)(C.ws + WS_DUMV)); }
            if (EN_D) for (int r2 = 0; r2 < ((DUP_MASK & 4096) ? 2 : 1); ++r2) { int bh, r; for (int it = 0; bh_unit(it, 16, F.G, bh, r); ++it) mlstm_part2<l>(C, F, bh * 16 + r); } }
        SEAM(pb + 2);
        if (IN(pb + 3) && EN_P3) {
            { const Frame Fs = fresh_frame(F); LAS float* gl = (LAS float*)(F.lds + RING_BYTES); for (int i = Fs.tid; i < DM; i += 512) { gl[i] = (par + PF_LN2G + (l ? l - 1 : 0) * DM)[i]; gl[DM + i] = (par + PF_LN2B + (l ? l - 1 : 0) * DM)[i]; } __syncthreads(); }
            pg8::Gemm g{Y, (const h16*)(C.ws + WS_WOUT) + (size_t)l * DM * DM, DM, DM, M, DM, DM};
            pg8::StaticOrder S; S.init(M, DM, F.G, (int)blockIdx.x);
            if (DUP_MASK & 8) { float* dums = (float*)(C.ws + WS_DUMS); pg8::EpiRes E2{V16, (h16*)(C.ws + WS_DUMV), l == 0 ? 1 : 0, pg8::RowStats{st_prev, st_prev ? st_prev + M : nullptr}, (const LAS float*)(F.lds + RING_BYTES), (const LAS float*)(F.lds + RING_BYTES) + DM, dums, dums + M};
                pg8::gemm_phase(F.lds, F.wave, g, S, E2); __syncthreads(); }
            stagger_start();
            if (DUP_MASK & 32768) { pg8::EpiNull EN; pg8::gemm_phase(F.lds, F.wave, g, S, EN); __syncthreads(); }
            pg8::EpiRes E{V16, V16, l == 0 ? 1 : 0, pg8::RowStats{st_prev, st_prev ? st_prev + M : nullptr}, (const LAS float*)(F.lds + RING_BYTES), (const LAS float*)(F.lds + RING_BYTES) + DM, st_ln1, st_ln1 + M};
            pg8::gemm_phase(F.lds, F.wave, g, S, E);
        }
        SEAM(pb + 3);
        if (IN(pb + 4) && EN_P4) {
            pg8::Gemm g{V16, (const h16*)(C.ws + WS_WGU) + (size_t)l * GU * DM, DM, DM, M, GU, DM};
            pg8::StaticOrder S; S.init(M, GU, F.G, (int)blockIdx.x);
            stagger_start();
            pg8::EpiGU E{Hb, c12 + C1GU + l * GU, c12 + C2GU + l * GU, pg8::RowStats{st_ln1, st_ln1 + M}};
            pg8::gemm_phase(F.lds, F.wave, g, S, E);
            if (DUP_MASK & 16) { __syncthreads(); pg8::gemm_phase(F.lds, F.wave, g, S, E); }
        }
        SEAM(pb + 4);
        if (IN(pb + 5) && EN_P5) {
            { const Frame Fs = fresh_frame(F); LAS float* gl = (LAS float*)(F.lds + RING_BYTES); for (int i = Fs.tid; i < DM; i += 512) { gl[i] = (par + PF_LN1G + l * DM)[i]; gl[DM + i] = (par + PF_LN1B + l * DM)[i]; } __syncthreads(); }
            pg8::Gemm g{Hb, (const h16*)(C.ws + WS_WDOWN) + (size_t)l * DM * FF, FF, FF, M, DM, FF};
            pg8::StaticOrder S; S.init(M, DM, F.G, (int)blockIdx.x);
            stagger_start();
            if (DUP_MASK & 32) { float* dums = (float*)(C.ws + WS_DUMS); pg8::EpiRes E2{V16, (h16*)(C.ws + WS_DUMV), 0, pg8::RowStats{st_ln1, st_ln1 + M}, (const LAS float*)(F.lds + RING_BYTES), (const LAS float*)(F.lds + RING_BYTES) + DM, dums, dums + M};
                pg8::gemm_phase(F.lds, F.wave, g, S, E2); __syncthreads(); }
            pg8::EpiRes E{V16, V16, 0, pg8::RowStats{st_ln1, st_ln1 + M}, (const LAS float*)(F.lds + RING_BYTES), (const LAS float*)(F.lds + RING_BYTES) + DM, st_ln2, st_ln2 + M};
            pg8::gemm_phase(F.lds, F.wave, g, S, E);
        }
        SEAM(pb + 5);
        }
#undef IN
#undef SEAM
}
constexpr int N_PHASES = 2 + 6 * DEPTH;
__global__ void __launch_bounds__(512, 2) fwd_kernel(Args a) {
    extern __shared__ __attribute__((aligned(16))) unsigned char lds_raw[];
    Frame F; F.lds = (LAS unsigned char*)lds_raw; F.tid = threadIdx.x; F.lane = F.tid & 63; F.wave = __builtin_amdgcn_readfirstlane(F.tid >> 6); F.G = gridDim.x;
    volatile LAS unsigned* MISC = (volatile LAS unsigned*)(F.lds + MISC_OFF);
    if (F.tid < 64) MISC[F.tid] = 0u;
    __syncthreads();
    unsigned* ctl = (unsigned*)(a.ws + WS_ZERO);
    XcdBarrier bar; bar.bar = ctl + CW_BAR; bar.x = 0; bar.st = nullptr; bar.wave = F.wave;
    if (a.use_bar) bar = xcd_barrier_post(ctl + CW_BAR, MISC + 8, F.wave);
    const int lo = a.ph_lo, hi = a.ph_hi;
#define IN(k) (lo <= (k) && (k) < hi)
#define SEAM(k) do { if (a.use_bar && IN(k) && IN((k) + 1)) xcd_barrier(bar); } while (0)
    const Core C{a.out, a.ws};

    if (IN(0) && EN_P0) { if (DUP_MASK & 8192) { p0_prologue(a, F, (float*)(a.ws + WS_DUMS)); __syncthreads(); } p0_prologue(a, F, (float*)(a.ws + WS_C12)); }
    SEAM(0);
    if (LOOP_START <= 0 && 0 < LOOP_DEPTH) layer_body<0>(C, F, bar, lo, hi, a.use_bar);
    if (LOOP_START <= 1 && 1 < LOOP_DEPTH) layer_body<1>(C, F, bar, lo, hi, a.use_bar);
    if (LOOP_START <= 2 && 2 < LOOP_DEPTH) layer_body<2>(C, F, bar, lo, hi, a.use_bar);
    if (LOOP_START <= 3 && 3 < LOOP_DEPTH) layer_body<3>(C, F, bar, lo, hi, a.use_bar);
    if (IN(N_PHASES - 1) && EN_PF) final_ln(C, F);
#undef IN
#undef SEAM
}

#ifndef MK_PER_PHASE
#define MK_PER_PHASE 0
#endif
extern "C" void kernel_launch(void* const* d_in, const int* in_sizes, int n_in, void* d_out, int out_size, void* d_ws, size_t ws_size, hipStream_t stream) {
    static int grid = 0;
    if (grid == 0) {
        if (n_in != 23 || out_size != M * DM || ws_size < WS_END) { fprintf(stderr, "kernel_launch: unexpected shapes n_in %d out %d ws %zu\n", n_in, out_size, ws_size); grid = -1; return; }
        int dev = 0, cus = 0;
        if (hipGetDevice(&dev) != hipSuccess || hipDeviceGetAttribute(&cus, hipDeviceAttributeMultiprocessorCount, dev) != hipSuccess) { grid = -1; return; }
        if (hipFuncSetAttribute((const void*)fwd_kernel, hipFuncAttributeMaxDynamicSharedMemorySize, LDS_BYTES) != hipSuccess) { fprintf(stderr, "kernel_launch: hipFuncSetAttribute failed\n"); grid = -1; return; }
        int per_cu = 0;
        if (hipOccupancyMaxActiveBlocksPerMultiprocessor(&per_cu, (const void*)fwd_kernel, 512, LDS_BYTES) != hipSuccess || per_cu < 1) fprintf(stderr, "kernel_launch: occupancy query says %d\n", per_cu);
        (void)hipGetLastError();
        grid = cus;
    }
    if (grid < 0) return;
    (void)hipMemsetAsync((char*)d_ws + WS_ZERO, 0, ZERO_BYTES, stream);
    Args a{};
    a.x = (const float*)d_in[0]; a.pos = (const int*)d_in[1]; a.w_in = (const float*)d_in[2]; a.a_ln_g = (const float*)d_in[3]; a.a_ln_b = (const float*)d_in[4];
    a.a_ws = (const float*)d_in[5]; a.a_bs = (const float*)d_in[6]; a.b_q_norm = (const float*)d_in[7]; a.b_kv_norm = (const float*)d_in[8];
    a.b_w_uq = (const float*)d_in[9]; a.b_w_ukv = (const float*)d_in[10]; a.d_conv_w = (const float*)d_in[11]; a.d_conv_b = (const float*)d_in[12];
    a.d_igate_b = (const float*)d_in[13]; a.d_fgate_b = (const float*)d_in[14]; a.w_out = (const float*)d_in[15]; a.ln1_g = (const float*)d_in[16]; a.ln1_b = (const float*)d_in[17];
    a.w_gate = (const float*)d_in[18]; a.w_up = (const float*)d_in[19]; a.w_down = (const float*)d_in[20]; a.ln2_g = (const float*)d_in[21]; a.ln2_b = (const float*)d_in[22];
    a.out = (float*)d_out; a.ws = (unsigned char*)d_ws; a.pad = 0;
#if MK_PER_PHASE
    a.use_bar = 0;
    for (int p = 0; p < N_PHASES; ++p) { a.ph_lo = p; a.ph_hi = p + 1; hipLaunchKernelGGL(fwd_kernel, dim3(grid), dim3(512), LDS_BYTES, stream, a); }
#else
    a.use_bar = 1; a.ph_lo = 0; a.ph_hi = N_PHASES;
    hipLaunchKernelGGL(fwd_kernel, dim3(grid), dim3(512), LDS_BYTES, stream, a);
#endif
}
```

```cpp
#include <hip/hip_runtime.h>
#include <cstdio>
#include <cstdint>

#ifndef DUP_MASK
#define DUP_MASK 0
#endif
#define LAS __attribute__((address_space(3)))
#define GAS __attribute__((address_space(1)))
typedef _Float16 h16;
typedef _Float16 h16x8 __attribute__((ext_vector_type(8)));
typedef _Float16 h16x4 __attribute__((ext_vector_type(4)));
typedef _Float16 h16x2 __attribute__((ext_vector_type(2)));
typedef float f32x2 __attribute__((ext_vector_type(2)));
typedef float f32x4 __attribute__((ext_vector_type(4)));
typedef float f32x16 __attribute__((ext_vector_type(16)));
typedef unsigned u32x2 __attribute__((ext_vector_type(2)));
typedef unsigned u32x4 __attribute__((ext_vector_type(4)));

constexpr int NB = 32, SEQ = 2048, DM = 1024, DEPTH = 4;
constexpr int M = NB * SEQ;
constexpr int IN_COLS = 2664, ZP = 2816;
constexpr int FF = 2816, GU = 2 * FF;
constexpr int GW = 256;
constexpr float LN_EPS = 1e-5f, RMS_EPS = 1e-6f;
constexpr float ALPHA = 1.681792830507429f;
constexpr int ZC_A = 0;
constexpr int ZC_CQ = 512;
constexpr int ZC_CKV = 768;
constexpr int ZC_KR = 896;
constexpr int ZC_GATE = 928;
constexpr int ZC_C = 1024;
constexpr int ZC_D = 1792;
__host__ __device__ __forceinline__ int in_src(int n) {
    if (n < 704) return n;
    if (n < 768) return -1;
    if (n < 928) return n - 768 + 704;
    if (n < 936) return n - 928 + 2656;
    if (n < 1024) return -1;
    if (n < 1536) {
        const int t = (n - 1024) >> 8, c = (n - 1024) & 255, cc = c & 127;
        return 864 + t * 256 + (cc >> 5) * 64 + (c >> 7) * 32 + (cc & 31); }
    if (n < 1792) return n - 1024 + 864;
    return n - 1792 + 1632;
}

constexpr size_t MiB = 1u << 20;
constexpr size_t WS_ZERO = 0, ZERO_BYTES = 8 * MiB;
constexpr size_t WS_C12 = 1 * MiB;
constexpr size_t WS_STATS = 2 * MiB;
constexpr size_t WS_SSQ = 6 * MiB;
constexpr size_t WS_WIN = 8 * MiB, WS_WOUT = 30 * MiB, WS_WGU = 38 * MiB, WS_WDOWN = 82 * MiB, WS_WUQ = 104 * MiB, WS_WUKV = 105 * MiB;
constexpr size_t WS_ROPEB = 106 * MiB, WS_ROPEC = 114 * MiB;
constexpr size_t WS_V16 = 130 * MiB, WS_Z = 258 * MiB, WS_Q = 610 * MiB, WS_KF = 658 * MiB, WS_KR = 698 * MiB, WS_VM = 706 * MiB, WS_PAR = 738 * MiB, WS_AWS = 739 * MiB, WS_MLC = 740 * MiB, WS_MLN = 756 * MiB, WS_MLG = 758 * MiB, WS_DUMV = 762 * MiB, WS_DUMS = 890 * MiB, WS_END = (DUP_MASK ? 892 : 762) * MiB;
constexpr int PF_LN1G = 0, PF_LN1B = 4096, PF_LN2G = 8192, PF_LN2B = 12288, PF_ALNG = 16384, PF_ALNB = 17408, PF_ABS = 18432, PF_CONVW = 20480, PF_CONVB = 28672, PF_IGB = 30720, PF_FGB = 30736, PF_END = 30752;
constexpr size_t OUT_Y = 0, OUT_DP = 128 * MiB, OUT_DL = 224 * MiB;
constexpr int C1IN = 0, C2IN = 4 * ZP, C1GU = 8 * ZP, C2GU = 8 * ZP + 4 * GU;
constexpr int CW_TMO = 0, CW_CODE = 1, CW_BAR = 4096, CW_QUEUE = 8192;

constexpr int RING_BYTES = 131072;
constexpr int LDS_BYTES = 163840;
constexpr int MISC_OFF = LDS_BYTES - 256;

__device__ __forceinline__ unsigned pkh(float lo, float hi) { h16x2 v = {(h16)lo, (h16)hi}; return __builtin_bit_cast(unsigned, v); }
__device__ __forceinline__ float wave_sum(float v) {
    v += __builtin_bit_cast(float, __builtin_amdgcn_update_dpp(0, __builtin_bit_cast(int, v), 0xB1, 0xF, 0xF, true));
    v += __builtin_bit_cast(float, __builtin_amdgcn_update_dpp(0, __builtin_bit_cast(int, v), 0x4E, 0xF, 0xF, true));
    v += __builtin_bit_cast(float, __builtin_amdgcn_update_dpp(0, __builtin_bit_cast(int, v), 0x141, 0xF, 0xF, true));
    v += __builtin_bit_cast(float, __builtin_amdgcn_update_dpp(0, __builtin_bit_cast(int, v), 0x140, 0xF, 0xF, true));
    const int vi = __builtin_bit_cast(int, v);
    return (__builtin_bit_cast(float, __builtin_amdgcn_readlane(vi, 0)) + __builtin_bit_cast(float, __builtin_amdgcn_readlane(vi, 16)))
         + (__builtin_bit_cast(float, __builtin_amdgcn_readlane(vi, 32)) + __builtin_bit_cast(float, __builtin_amdgcn_readlane(vi, 48)));
}
__device__ __forceinline__ void atomic_addf(float* p, float v) { __hip_atomic_fetch_add(p, v, __ATOMIC_RELAXED, __HIP_MEMORY_SCOPE_AGENT); }

namespace pg8 {
constexpr float DIL_QSCALE = 0.125f * 1.4426950408889634f;
constexpr int BM = 256, BK = 64, HALF = 128, HTB = HALF * BK * 2, STAGE_BYTES = 8 * HTB, NXCD = 8, WGM = 8;
__host__ __device__ __forceinline__ int lds_byte(int r, int c) { const int st = (r >> 4) * 2 + (c >> 5), rr = r & 15, cc = c & 31, ob = rr * 64 + cc * 2; return st * 1024 + (ob ^ (((ob >> 9) & 1) << 5)); }
__host__ __device__ __forceinline__ void stage_rc(int b, int& R, int& C) { const int st = b / 1024, sb = b % 1024, swz = sb ^ (((sb >> 9) & 1) << 5); R = (st >> 1) * 16 + swz / 64; C = (st & 1) * 32 + (swz % 64) / 2; }
__host__ __device__ __forceinline__ int perm32(int rho) { const int n = rho >> 4, i = rho & 15; return 8 * (i >> 2) + 4 * n + (i & 3); }

struct Unit { int pm, pn; };
struct Gemm { const h16* A; const h16* Bt; int lda, ldb, M, N, K; };

struct StaticOrder {
    int nM, nN, nwg, G, c;
    __host__ __device__ void init(int M_, int N_, int G_, int c_) { nM = M_ / BM; nN = N_ / BM; nwg = nM * nN; G = G_; c = c_; }
    __host__ __device__ bool next(int i, Unit& u) const {
        const long L = (long)i * G + c; if (L >= nwg) return false;
        int wgid = (int)L; { const int q = nwg / NXCD, r = nwg % NXCD, xcd = wgid % NXCD, off = wgid / NXCD; wgid = (xcd < r ? xcd * (q + 1) : r * (q + 1) + (xcd - r) * q) + off; }
        const int nig = WGM * nN, gid = wgid / nig, fm = gid * WGM, gsz = (nM - fm) < WGM ? (nM - fm) : WGM;
        u.pm = fm + ((wgid % nig) % gsz); u.pn = (wgid % nig) / gsz; return true;
    }
};

struct FixedOrder { StaticOrder S; __host__ __device__ bool next(int i, Unit& u) const { const bool ok = S.next(i, u); u.pm = (int)(blockIdx.x & 7); u.pn = (int)((blockIdx.x >> 3) & 3); return ok; } };
template <class Epi, class Sched>
__device__ __forceinline__ void gemm_phase(LAS unsigned char* lds, const int wid, const Gemm g, const Sched& S, const Epi& E) {
    int lane = __builtin_amdgcn_mbcnt_hi(~0u, __builtin_amdgcn_mbcnt_lo(~0u, 0u)); asm volatile("" : "+v"(lane));
    const int tid = wid * 64 + lane, wr = wid >> 2, wc = wid & 3, fr = lane & 15, fq = lane >> 4;
    const int K = g.K, nt = K / BK;
    unsigned voffA[2], voffB[2];
#pragma unroll
    for (int i = 0; i < 2; ++i) { int R, C; stage_rc(tid * 16 + i * 8192, R, C); const int Rb = Epi::PERM ? ((R & ~31) + perm32(R & 31)) : R;
        voffA[i] = (unsigned)(R * g.lda + C) * 2u; voffB[i] = (unsigned)(Rb * g.ldb + C) * 2u; }
    const size_t kstep = (size_t)(BK * 2);
    const size_t hstepA = (size_t)HALF * g.lda * 2, hstepB = (size_t)HALF * g.ldb * 2;
    const size_t tstepA = 2 * hstepA, tstepB = 2 * hstepB;
    const unsigned ldsw = (unsigned)wid * 1024u;
    const int aoff = lds_byte(wr * 64 + fr, fq * 8), boff = lds_byte(wc * 32 + fr, fq * 8);
#define PG8_SA(b, h) (((b) * 2 + (h)) * HTB)
#define PG8_SB(b, h) ((4 + (b) * 2 + (h)) * HTB)
#define PG8_STAGE(bufoff, gbase, voff) do { _Pragma("unroll") for (int _i = 0; _i < 2; ++_i) \
        __builtin_amdgcn_global_load_lds((const unsigned*)((const char*)(gbase) + (voff)[_i]), (LAS unsigned*)(lds + (bufoff) + ldsw + _i * 8192), 16, 0, 0); } while (0)
#define PG8_LDA(dst, b, h) do { _Pragma("unroll") for (int m = 0; m < 4; ++m) _Pragma("unroll") for (int k = 0; k < 2; ++k) dst[m][k] = *(const LAS h16x8*)(lds + PG8_SA(b, h) + aoff + m * 2048 + k * 1024); } while (0)
#define PG8_LDB(dst, b, h) do { _Pragma("unroll") for (int n = 0; n < 2; ++n) _Pragma("unroll") for (int k = 0; k < 2; ++k) dst[n][k] = *(const LAS h16x8*)(lds + PG8_SB(b, h) + boff + n * 2048 + k * 1024); } while (0)
#define PG8_MMA(ai, bj, At, Bt) do { __builtin_amdgcn_s_setprio(1); _Pragma("unroll") for (int m = 0; m < 4; ++m) _Pragma("unroll") for (int n = 0; n < 2; ++n) _Pragma("unroll") for (int k = 0; k < 2; ++k) \
        acc[ai][bj][m][n] = __builtin_amdgcn_mfma_f32_16x16x32_f16(Bt[n][k], At[m][k], acc[ai][bj][m][n], 0, 0, 0); __builtin_amdgcn_s_setprio(0); } while (0)
#define PG8_WAIT_V(n) asm volatile("s_waitcnt vmcnt(" #n ")" ::: "memory")
#define PG8_WAIT_L(n) asm volatile("s_waitcnt lgkmcnt(" #n ")" ::: "memory")
#define PG8_BAR __builtin_amdgcn_s_barrier()
#define PG8_SCHED __builtin_amdgcn_sched_barrier(0)
    Unit cur, nxt; int ui = 0;
    if (!S.next(0, cur)) return;
    f32x4 acc[2][2][4][2];
#pragma unroll
    for (int a = 0; a < 2; ++a)
#pragma unroll
        for (int b = 0; b < 2; ++b)
#pragma unroll
            for (int m = 0; m < 4; ++m)
#pragma unroll
                for (int n = 0; n < 2; ++n) acc[a][b][m][n] = (f32x4){0.f, 0.f, 0.f, 0.f};
    h16x8 At[4][2], B0[2][2], B1[2][2];
    const char* cA = (const char*)g.A + (size_t)cur.pm * tstepA; const char* cB = (const char*)g.Bt + (size_t)cur.pn * tstepB;
    PG8_STAGE(PG8_SB(0, 0), cB, voffB); PG8_STAGE(PG8_SB(0, 1), cB + hstepB, voffB); PG8_STAGE(PG8_SA(0, 0), cA, voffA); PG8_STAGE(PG8_SA(0, 1), cA + hstepA, voffA);
    if (wr == 1) PG8_BAR;
    PG8_WAIT_V(2); PG8_BAR;
    PG8_STAGE(PG8_SB(1, 0), cB + kstep, voffB); PG8_STAGE(PG8_SA(1, 0), cA + kstep, voffA); PG8_STAGE(PG8_SB(1, 1), cB + hstepB + kstep, voffB);
    PG8_WAIT_V(6); PG8_BAR;
    for (;;) {
        const bool has_next = S.next(ui + 1, nxt);
        const char* nA = has_next ? (const char*)g.A + (size_t)nxt.pm * tstepA : cA; const char* nB = has_next ? (const char*)g.Bt + (size_t)nxt.pn * tstepB : cB;
#pragma unroll 1
        for (int t = 0; t < nt; t += 2) {
            const bool last = (t == nt - 2);
            const char* a1 = cA + (size_t)(t + 1) * kstep;
            const char* a2 = last ? nA : cA + (size_t)(t + 2) * kstep; const char* b2 = last ? nB : cB + (size_t)(t + 2) * kstep;
            const char* a3 = a2 + kstep; const char* b3 = b2 + kstep;
            PG8_LDB(B0, 0, 0); PG8_LDB(B1, 0, 1); PG8_SCHED; PG8_LDA(At, 0, 0); PG8_STAGE(PG8_SA(1, 1), a1 + hstepA, voffA);
            PG8_WAIT_V(8); PG8_WAIT_L(0); PG8_BAR; PG8_MMA(0, 0, At, B0); PG8_MMA(0, 1, At, B1); PG8_BAR; PG8_SCHED;
            PG8_LDA(At, 0, 1); PG8_STAGE(PG8_SB(0, 0), b2, voffB); PG8_STAGE(PG8_SB(0, 1), b2 + hstepB, voffB); PG8_STAGE(PG8_SA(0, 0), a2, voffA);
            PG8_WAIT_V(8); PG8_WAIT_L(0); PG8_BAR; PG8_MMA(1, 0, At, B0); PG8_MMA(1, 1, At, B1); PG8_BAR; PG8_SCHED;
            PG8_LDB(B0, 1, 0); PG8_LDB(B1, 1, 1); PG8_SCHED; PG8_LDA(At, 1, 0); PG8_STAGE(PG8_SA(0, 1), a2 + hstepA, voffA);
            PG8_WAIT_V(8); PG8_WAIT_L(0); PG8_BAR; PG8_MMA(0, 0, At, B0); PG8_MMA(0, 1, At, B1); PG8_BAR; PG8_SCHED;
            PG8_LDA(At, 1, 1); PG8_STAGE(PG8_SB(1, 0), b3, voffB); PG8_STAGE(PG8_SB(1, 1), b3 + hstepB, voffB); PG8_STAGE(PG8_SA(1, 0), a3, voffA);
            PG8_WAIT_V(8); PG8_WAIT_L(0); PG8_BAR; PG8_MMA(1, 0, At, B0); PG8_MMA(1, 1, At, B1); PG8_BAR; PG8_SCHED;
        }
        if (wr == 0) PG8_BAR;
        E(acc, cur, wr, wc, fr, fq);
        if (!has_next) break;
#pragma unroll
        for (int a = 0; a < 2; ++a)
#pragma unroll
            for (int b = 0; b < 2; ++b)
#pragma unroll
                for (int m = 0; m < 4; ++m)
#pragma unroll
                    for (int n = 0; n < 2; ++n) acc[a][b][m][n] = (f32x4){0.f, 0.f, 0.f, 0.f};
        cur = nxt; cA = nA; cB = nB; ++ui;
        if (wr == 1) PG8_BAR;
    }
    PG8_WAIT_V(0);
    PG8_BAR;
#undef PG8_SA
#undef PG8_SB
#undef PG8_STAGE
#undef PG8_LDA
#undef PG8_LDB
#undef PG8_MMA
#undef PG8_WAIT_V
#undef PG8_WAIT_L
#undef PG8_BAR
#undef PG8_SCHED
}

struct RowStats { const float* s1; const float* s2; };
__device__ __forceinline__ void row_mu_rs(const RowStats& st, int r, float& mu, float& rs) {
    const float a = st.s1[r], b = st.s2[r];
    mu = a * (1.0f / DM); const float var = fmaxf(b * (1.0f / DM) - mu * mu, 0.f); rs = rsqrtf(var + LN_EPS);
}

struct EpiIn {
    static constexpr bool PERM = true;
    h16* Z; const float* c1; const float* c2; RowStats st; int ident; float* ssq_q; float* ssq_kv; int rmask; const h16* rope;
    __device__ __forceinline__ void operator()(const f32x4 (&acc)[2][2][4][2], const Unit& u, int wr, int wc, int fr, int fq) const {
        const int row0 = u.pm * BM + wr * 64 + fr, col0 = u.pn * BM + wc * 32 + 8 * fq;
        f32x4 c1v[2][2], c2v[2][2];
#pragma unroll
        for (int bj = 0; bj < 2; ++bj)
#pragma unroll
            for (int n = 0; n < 2; ++n) { c1v[bj][n] = *(const f32x4*)(c1 + col0 + bj * HALF + 4 * n); c2v[bj][n] = *(const f32x4*)(c2 + col0 + bj * HALF + 4 * n); }
        const bool do_ssq = (u.pn == 2) || (u.pn == 3);
        float sq[2][4];
        float mus[2][4], rss[2][4];
#pragma unroll
        for (int ai = 0; ai < 2; ++ai)
#pragma unroll
            for (int m = 0; m < 4; ++m) { mus[ai][m] = 0.f; rss[ai][m] = 1.f; if (!ident) row_mu_rs(st, row0 + ai * HALF + m * 16, mus[ai][m], rss[ai][m]); }
        const bool rp = (u.pn == 4) || (u.pn == 5);
        const float qsc = (u.pn == 4) ? DIL_QSCALE : 1.0f;
#pragma unroll
        for (int ai = 0; ai < 2; ++ai) {
#pragma unroll
            for (int m = 0; m < 4; ++m) {
                const int r = row0 + ai * HALF + m * 16;
                const float mu = mus[ai][m], rs = rss[ai][m];
                float q = 0.f;
                if (rp) {
                    const h16x8 rcm = *(const h16x8*)(rope + (size_t)r * 64 + 8 * fq), rsm = *(const h16x8*)(rope + (size_t)r * 64 + 32 + 8 * fq);
                    f32x4 a0 = acc[ai][0][m][0], a1 = acc[ai][0][m][1], b0 = acc[ai][1][m][0], b1 = acc[ai][1][m][1];
                    if (!ident) { a0 = (a0 - c1v[0][0] * mu) * rs + c2v[0][0]; a1 = (a1 - c1v[0][1] * mu) * rs + c2v[0][1]; b0 = (b0 - c1v[1][0] * mu) * rs + c2v[1][0]; b1 = (b1 - c1v[1][1] * mu) * rs + c2v[1][1]; }
                    float o1[8], o2[8];
#pragma unroll
                    for (int j = 0; j < 8; ++j) { const float x1 = j < 4 ? a0[j & 3] : a1[j & 3], x2 = j < 4 ? b0[j & 3] : b1[j & 3], cc = (float)rcm[j] * qsc, ss = (float)rsm[j] * qsc;
                        o1[j] = x1 * cc - x2 * ss; o2[j] = x1 * ss + x2 * cc; }
                    u32x4 w1, w2; w1.x = pkh(o1[0], o1[1]); w1.y = pkh(o1[2], o1[3]); w1.z = pkh(o1[4], o1[5]); w1.w = pkh(o1[6], o1[7]);
                    w2.x = pkh(o2[0], o2[1]); w2.y = pkh(o2[2], o2[3]); w2.z = pkh(o2[4], o2[5]); w2.w = pkh(o2[6], o2[7]);
                    h16* zd = Z + (size_t)(r & rmask) * ZP + u.pn * BM + wc * 64 + 8 * fq;
                    *(u32x4*)zd = w1; *(u32x4*)(zd + 32) = w2;
                } else {
#pragma unroll
                for (int bj = 0; bj < 2; ++bj) {
                    f32x4 v0 = acc[ai][bj][m][0], v1 = acc[ai][bj][m][1];
                    if (!ident) { v0 = (v0 - c1v[bj][0] * mu) * rs + c2v[bj][0]; v1 = (v1 - c1v[bj][1] * mu) * rs + c2v[bj][1]; }
                    u32x4 w; w.x = pkh(v0[0], v0[1]); w.y = pkh(v0[2], v0[3]); w.z = pkh(v1[0], v1[1]); w.w = pkh(v1[2], v1[3]);
                    *(u32x4*)(Z + (size_t)(r & rmask) * ZP + col0 + bj * HALF) = w;
                    const bool valid = (u.pn == 2) ? (bj == 0 || wc < 2) : (bj == 0);
                    if (valid) q += (v0[0] * v0[0] + v0[1] * v0[1]) + (v0[2] * v0[2] + v0[3] * v0[3]) + (v1[0] * v1[0] + v1[1] * v1[1]) + (v1[2] * v1[2] + v1[3] * v1[3]);
                }
                }
                sq[ai][m] = q;
            }
        }
        if (do_ssq) {
            float* dst = (u.pn == 2) ? ssq_q : ssq_kv;
#pragma unroll
            for (int ai = 0; ai < 2; ++ai) {
                float t[4];
#pragma unroll
                for (int m = 0; m < 4; ++m) { float q = sq[ai][m]; q += __shfl_xor(q, 16); q += __shfl_xor(q, 32); t[m] = q; }
                const float mine = fq == 0 ? t[0] : fq == 1 ? t[1] : fq == 2 ? t[2] : t[3];
                atomic_addf(dst + u.pm * BM + ai * HALF + wr * 64 + fq * 16 + fr, mine);
            }
        }
    }
};

struct EpiRes {
    static constexpr bool PERM = true;
    h16* V; h16* Vo; int ident; RowStats st; const LAS float* g; const LAS float* b; float* o1; float* o2;
    __device__ __forceinline__ void operator()(const f32x4 (&acc)[2][2][4][2], const Unit& u, int wr, int wc, int fr, int fq) const {
        const int row0 = u.pm * BM + wr * 64 + fr, col0 = u.pn * BM + wc * 32 + 8 * fq;
        float s1[2][4], s2[2][4];
#pragma unroll
        for (int ai = 0; ai < 2; ++ai) {
            h16x8 hv[4][2]; float mus[4], rss[4];
#pragma unroll
            for (int m = 0; m < 4; ++m) {
                const int r = row0 + ai * HALF + m * 16;
#pragma unroll
                for (int bj = 0; bj < 2; ++bj) hv[m][bj] = *(const h16x8*)(V + (size_t)r * DM + col0 + bj * HALF);
                mus[m] = 0.f; rss[m] = 1.f; if (!ident) row_mu_rs(st, r, mus[m], rss[m]);
            }
#pragma unroll
            for (int m = 0; m < 4; ++m) {
                const int r = row0 + ai * HALF + m * 16;
                const float mu = mus[m], rs = rss[m];
                float a1 = 0.f, a2 = 0.f;
#pragma unroll
                for (int bj = 0; bj < 2; ++bj) {
                    const size_t off = (size_t)r * DM + col0 + bj * HALF;
                    const h16x8 hx = hv[m][bj];
                    f32x4 x0 = (f32x4){(float)hx[0], (float)hx[1], (float)hx[2], (float)hx[3]}, x1 = (f32x4){(float)hx[4], (float)hx[5], (float)hx[6], (float)hx[7]};
                    if (!ident) { const LAS float* gp = g + col0 + bj * HALF; const LAS float* bp = b + col0 + bj * HALF;
                        x0 = (x0 - mu) * rs * *(const LAS f32x4*)gp + *(const LAS f32x4*)bp; x1 = (x1 - mu) * rs * *(const LAS f32x4*)(gp + 4) + *(const LAS f32x4*)(bp + 4); }
                    const f32x4 v0 = x0 * ALPHA + acc[ai][bj][m][0], v1 = x1 * ALPHA + acc[ai][bj][m][1];
                    h16x8 ho = {(h16)v0[0], (h16)v0[1], (h16)v0[2], (h16)v0[3], (h16)v1[0], (h16)v1[1], (h16)v1[2], (h16)v1[3]};
                    *(h16x8*)(Vo + off) = ho;
#pragma unroll
                    for (int j = 0; j < 8; ++j) { const float f = (float)ho[j]; a1 += f; a2 += f * f; }
                }
                a1 += __shfl_xor(a1, 16); a1 += __shfl_xor(a1, 32); a2 += __shfl_xor(a2, 16); a2 += __shfl_xor(a2, 32);
                s1[ai][m] = a1; s2[ai][m] = a2;
            }
        }
#pragma unroll
        for (int ai = 0; ai < 2; ++ai) {
            const float m1 = fq == 0 ? s1[ai][0] : fq == 1 ? s1[ai][1] : fq == 2 ? s1[ai][2] : s1[ai][3];
            const float m2 = fq == 0 ? s2[ai][0] : fq == 1 ? s2[ai][1] : fq == 2 ? s2[ai][2] : s2[ai][3];
            const int r = u.pm * BM + ai * HALF + wr * 64 + fq * 16 + fr;
            atomic_addf(o1 + r, m1); atomic_addf(o2 + r, m2);
        }
    }
};

struct EpiGU {
    static constexpr bool PERM = true;
    h16* H; const float* c1; const float* c2; RowStats st;
    __device__ __forceinline__ void operator()(const f32x4 (&acc)[2][2][4][2], const Unit& u, int wr, int wc, int fr, int fq) const {
        const int row0 = u.pm * BM + wr * 64 + fr, cin = wc * 32 + 8 * fq, col0 = u.pn * BM + cin;
        f32x4 c1v[2][2], c2v[2][2];
#pragma unroll
        for (int bj = 0; bj < 2; ++bj)
#pragma unroll
            for (int n = 0; n < 2; ++n) { c1v[bj][n] = *(const f32x4*)(c1 + col0 + bj * HALF + 4 * n); c2v[bj][n] = *(const f32x4*)(c2 + col0 + bj * HALF + 4 * n); }
        float mus[2][4], rss[2][4];
#pragma unroll
        for (int ai = 0; ai < 2; ++ai)
#pragma unroll
            for (int m = 0; m < 4; ++m) row_mu_rs(st, row0 + ai * HALF + m * 16, mus[ai][m], rss[ai][m]);
#pragma unroll
        for (int ai = 0; ai < 2; ++ai)
#pragma unroll
            for (int m = 0; m < 4; ++m) {
                const int r = row0 + ai * HALF + m * 16;
                const float mu = mus[ai][m], rs = rss[ai][m];
                float hv[8];
#pragma unroll
                for (int n = 0; n < 2; ++n) {
                    const f32x4 gg = (acc[ai][0][m][n] - c1v[0][n] * mu) * rs + c2v[0][n];
                    const f32x4 uu = (acc[ai][1][m][n] - c1v[1][n] * mu) * rs + c2v[1][n];
#pragma unroll
                    for (int j = 0; j < 4; ++j) { const float e = __builtin_amdgcn_exp2f(gg[j] * -1.4426950408889634f); hv[4 * n + j] = gg[j] * uu[j] * __builtin_amdgcn_rcpf(1.0f + e); }
                }
                u32x4 w; w.x = pkh(hv[0], hv[1]); w.y = pkh(hv[2], hv[3]); w.z = pkh(hv[4], hv[5]); w.w = pkh(hv[6], hv[7]);
                *(u32x4*)(H + (size_t)r * FF + u.pn * HALF + cin) = w;
            }
    }
};


struct EpiNull {
    static constexpr bool PERM = true;
    __device__ __forceinline__ void operator()(const f32x4 (&acc)[2][2][4][2], const Unit& u, int wr, int wc, int fr, int fq) const {
#pragma unroll
        for (int ai = 0; ai < 2; ++ai)
#pragma unroll
            for (int bj = 0; bj < 2; ++bj)
#pragma unroll
                for (int m = 0; m < 4; ++m)
#pragma unroll
                    for (int n = 0; n < 2; ++n) asm volatile("" :: "v"(acc[ai][bj][m][n]));
    }
};
constexpr float QSCALE96 = 0.10206207261596577f * 1.4426950408889634f;
struct EpiQ {
    static constexpr bool PERM = false;
    h16* Q; const float* ssq; const float* rb;
    __device__ __forceinline__ void operator()(const f32x4 (&acc)[2][2][4][2], const Unit& u, int wr, int wc, int fr, int fq) const {
        const int row0 = u.pm * BM + wr * 64 + fr;
#pragma unroll
        for (int ai = 0; ai < 2; ++ai)
#pragma unroll
            for (int m = 0; m < 4; ++m) {
                const int r = row0 + ai * HALF + m * 16;
                const float rs = rsqrtf(ssq[r] * (1.0f / 192.0f) + RMS_EPS) * QSCALE96;
#pragma unroll
                for (int bj = 0; bj < 2; ++bj) {
                    const int g32 = 8 * u.pn + 4 * bj + wc;
                    if (g32 >= 12) continue;
                    f32x4 v0 = acc[ai][bj][m][0] * rs, v1 = acc[ai][bj][m][1] * rs;
                    if (g32 % 3 == 2) {
                        const f32x4 cc = *(const f32x4*)(rb + (size_t)r * 32 + 4 * fq), ss = *(const f32x4*)(rb + (size_t)r * 32 + 16 + 4 * fq);
                        const f32x4 a = v0 * cc - v1 * ss, b = v0 * ss + v1 * cc; v0 = a; v1 = b;
                    }
                    u32x2 w0, w1; w0.x = pkh(v0[0], v0[1]); w0.y = pkh(v0[2], v0[3]); w1.x = pkh(v1[0], v1[1]); w1.y = pkh(v1[2], v1[3]);
                    h16* dst = Q + (size_t)r * 384 + 32 * g32 + 4 * fq;
                    *(u32x2*)dst = w0; *(u32x2*)(dst + 16) = w1;
                }
                asm volatile("" ::: "memory");
            }
    }
};
struct EpiKV {
    static constexpr bool PERM = true;
    h16* Kf; h16* Vm; const float* ssq;
    __device__ __forceinline__ void operator()(const f32x4 (&acc)[2][2][4][2], const Unit& u, int wr, int wc, int fr, int fq) const {
        const int row0 = u.pm * BM + wr * 64 + fr;
#pragma unroll
        for (int ai = 0; ai < 2; ++ai)
#pragma unroll
            for (int m = 0; m < 4; ++m) {
                const int r = row0 + ai * HALF + m * 16;
                const float rs = rsqrtf(ssq[r] * (1.0f / 128.0f) + RMS_EPS);
#pragma unroll
                for (int bj = 0; bj < 2; ++bj) {
                    const int hd = 2 * u.pn + bj, within = 32 * wc + 8 * fq;
                    const f32x4 v0 = acc[ai][bj][m][0] * rs, v1 = acc[ai][bj][m][1] * rs;
                    u32x4 w; w.x = pkh(v0[0], v0[1]); w.y = pkh(v0[2], v0[3]); w.z = pkh(v1[0], v1[1]); w.w = pkh(v1[2], v1[3]);
                    if (wc < 2) *(u32x4*)(Kf + (size_t)r * 384 + hd * 96 + within) = w;
                    else *(u32x4*)(Vm + (size_t)r * 256 + hd * 64 + within - 64) = w;
                }
                asm volatile("" ::: "memory");
            }
    }
};
}

#define XB_TMO      128
#define XB_XCNT(j)  (256  + 64 * (j))
#define XB_XSUB(j)  (1280 + 64 * (j))
#define XB_XGEN(j)  (2304 + 64 * (j))
#define XB_TOP      3328
#define XB_TOPGEN   3392
#define XCD_BAR_WORDS 3456
#define XB_SPIN_CAP (1u << 18)
__device__ __forceinline__ unsigned xb_ld(unsigned* p)              { return __hip_atomic_load(p, __ATOMIC_RELAXED, __HIP_MEMORY_SCOPE_AGENT); }
__device__ __forceinline__ unsigned xb_add(unsigned* p, unsigned v) { return __hip_atomic_fetch_add(p, v, __ATOMIC_RELAXED, __HIP_MEMORY_SCOPE_AGENT); }
__device__ __forceinline__ unsigned xb_xcc_id() { return (unsigned)__builtin_amdgcn_s_getreg((3 << 11) | 20) & 0xFu; }
#define XB_SPIN(cond, bar) do { unsigned _sp = 0; while (cond) { __builtin_amdgcn_s_sleep(1); \
    if ((++_sp & 255u) == 0u) { if (xb_ld(&(bar)[XB_TMO])) break; if (_sp > XB_SPIN_CAP) { atomicAdd(&(bar)[XB_TMO], 1u); break; } } } } while (0)
struct XcdBarrier { unsigned* bar; unsigned x; volatile LAS unsigned* st; int wave; };
__device__ __forceinline__ bool xb_thread0(int wave) { return wave == 0 && __builtin_amdgcn_mbcnt_hi(~0u, __builtin_amdgcn_mbcnt_lo(~0u, 0u)) == 0; }
__device__ __forceinline__ XcdBarrier xcd_barrier_post(unsigned* bar, volatile LAS unsigned* st, int wave) {
    XcdBarrier b; b.bar = bar; b.x = xb_xcc_id(); b.st = st; b.wave = wave;
    if (xb_thread0(wave)) (void)xb_add(&bar[XB_XCNT(b.x)], 1u);
    return b;
}
__device__ __forceinline__ void xcd_barrier_complete(unsigned* bar, unsigned x, unsigned& nloc, unsigned& nx) {
    const unsigned G = gridDim.x * gridDim.y * gridDim.z;
    unsigned sum, cnt, mine, sp = 0u;
    for (;;) {
        sum = 0u; cnt = 0u; mine = 0u;
#pragma unroll
        for (unsigned j = 0; j < 16; ++j) { const unsigned c = xb_ld(&bar[XB_XCNT(j)]); sum += c; cnt += (c > 0u) ? 1u : 0u; mine = (j == x) ? c : mine; }
        if (sum == G) break;
        __builtin_amdgcn_s_sleep(1);
        if ((++sp & 255u) == 0u) { if (xb_ld(&bar[XB_TMO])) break; if (sp > XB_SPIN_CAP) { atomicAdd(&bar[XB_TMO], 1u); break; } }
    }
    nloc = mine > 0u ? mine : 1u; nx = cnt > 0u ? cnt : 1u;
}
__device__ __forceinline__ void xcd_barrier(const XcdBarrier& b) {
    asm volatile("s_waitcnt vmcnt(0)" ::: "memory");
    __syncthreads();
    if (xb_thread0(b.wave)) {
        unsigned* bar = b.bar;
        __builtin_amdgcn_s_waitcnt(0);
        unsigned nloc = b.st[0], nx = b.st[1];
        if (nloc == 0u) { xcd_barrier_complete(bar, b.x, nloc, nx); b.st[0] = nloc; b.st[1] = nx; }
        const unsigned old = xb_add(&bar[XB_XSUB(b.x)], 1u);
        const unsigned gen = old / nloc;
        if (old + 1u == (gen + 1u) * nloc) {
            __builtin_amdgcn_fence(__ATOMIC_RELEASE, "agent");
            asm volatile("s_waitcnt vmcnt(0)" ::: "memory");
            const unsigned og = xb_add(&bar[XB_TOP], 1u);
            const unsigned tg = og / nx;
            if (og + 1u == (tg + 1u) * nx) xb_add(&bar[XB_TOPGEN], 1u);
            else XB_SPIN(xb_ld(&bar[XB_TOPGEN]) == tg, bar);
            __builtin_amdgcn_fence(__ATOMIC_ACQUIRE, "agent");
            xb_add(&bar[XB_XGEN(b.x)], 1u);
            asm volatile("s_waitcnt vmcnt(0)" ::: "memory");
        } else {
            XB_SPIN(xb_ld(&bar[XB_XGEN(b.x)]) == gen, bar);
            __builtin_amdgcn_fence(__ATOMIC_ACQUIRE, "agent");
            asm volatile("s_waitcnt vmcnt(0)" ::: "memory");
        }
    }
    __syncthreads();
}

struct Args {
    const float* x; const int* pos; const float* w_in; const float* a_ln_g; const float* a_ln_b; const float* a_ws; const float* a_bs;
    const float* b_q_norm; const float* b_kv_norm; const float* b_w_uq; const float* b_w_ukv;
    const float* d_conv_w; const float* d_conv_b; const float* d_igate_b; const float* d_fgate_b;
    const float* w_out; const float* ln1_g; const float* ln1_b; const float* w_gate; const float* w_up; const float* w_down; const float* ln2_g; const float* ln2_b;
    float* out; unsigned char* ws; int ph_lo, ph_hi; int use_bar, pad;
};

template <int MAP>
__device__ __forceinline__ void transpose_item(const float* W, int Ksrc, int Nsrc, const float* g, const float* b, h16* Wt, int Kdst, int Ndst_valid,
                                               float* c1, float* c2, int kb, int nb, LAS float* scr, int lane) {
    const int k0 = 64 * kb, n0 = 32 * nb, nn = lane & 31, kh = lane >> 5;
    int ns, nd;
    if (MAP == 0) { nd = n0 + nn; ns = (nd < Ndst_valid && nd < Nsrc) ? nd : -1; }
    else if (MAP == 1) { nd = n0 + nn; ns = in_src(nd); }
    else { const int j = n0 + nn; ns = j; nd = 256 * (j >> 7) + (j & 127) + (MAP == 3 ? 128 : 0); }
    float s1 = 0.f, s2 = 0.f;
    const bool okn = ns >= 0; const int nsc = okn ? ns : 0;
    float wv[32], gv[32], bv[32];
#pragma unroll
    for (int i = 0; i < 32; ++i) { int k = k0 + 2 * i + kh; if (k >= Ksrc) k = Ksrc - 1; wv[i] = W[(size_t)k * Nsrc + nsc]; gv[i] = g ? g[k] : 1.0f; bv[i] = b ? b[k] : 0.0f; }
#pragma unroll
    for (int i = 0; i < 32; ++i) {
        const int kk = 2 * i + kh, k = k0 + kk;
        const float w = (okn && k < Ksrc) ? wv[i] : 0.f;
        const float hf = (float)(h16)(w * gv[i]);
        scr[kk * 33 + nn] = hf; s1 += hf; s2 += bv[i] * w;
    }
    if (c1) { s1 += __shfl_xor(s1, 32); s2 += __shfl_xor(s2, 32); if (lane < 32) { atomic_addf(c1 + nd, s1); atomic_addf(c2 + nd, s2); } }
    asm volatile("s_waitcnt lgkmcnt(0)" ::: "memory");
    const int c = lane & 7;
    int nd0; if (MAP <= 1) nd0 = n0; else nd0 = 256 * (n0 >> 7) + (n0 & 127) + (MAP == 3 ? 128 : 0);
#pragma unroll
    for (int j = 0; j < 4; ++j) { const int n = (lane >> 3) + 8 * j; const LAS float* s = scr + (8 * c) * 33 + n;
        u32x4 o; o.x = pkh(s[0 * 33], s[1 * 33]); o.y = pkh(s[2 * 33], s[3 * 33]); o.z = pkh(s[4 * 33], s[5 * 33]); o.w = pkh(s[6 * 33], s[7 * 33]);
        *(u32x4*)(Wt + (size_t)(nd0 + n) * Kdst + k0 + 8 * c) = o; }
    asm volatile("s_waitcnt lgkmcnt(0)" ::: "memory");
}

struct Frame { LAS unsigned char* lds; int tid, lane, wave, G; };
#define UNIT_END_BAR() do { asm volatile("s_waitcnt lgkmcnt(0)" ::: "memory"); __builtin_amdgcn_s_barrier(); asm volatile("" ::: "memory"); } while (0)
__device__ __forceinline__ Frame fresh_frame(const Frame& F0) {
    Frame F; int ln = __builtin_amdgcn_mbcnt_hi(~0u, __builtin_amdgcn_mbcnt_lo(~0u, 0u)); asm volatile("" : "+v"(ln));
    F.lds = F0.lds; F.G = F0.G; F.wave = F0.wave; F.lane = ln; F.tid = F0.wave * 64 + ln; return F;
}

__device__ __forceinline__ void p0_prologue(const Args& a, const Frame& F0, float* c12) {
    const Frame F = fresh_frame(F0);
    LAS float* scr = (LAS float*)(F.lds + F.wave * 16384);
    const int gw = blockIdx.x * 8 + F.wave, NGW = F.G * 8;
    constexpr int I_IN = 16 * (ZP / 32), I_OUT = 16 * 32, I_G = 16 * (FF / 32), I_DN = (FF / 64) * 32, I_UQ = 4 * 16, I_UKV = 4 * 16;
    constexpr int PER_LAYER = I_IN + I_OUT + 2 * I_G + I_DN + I_UQ + I_UKV;
    for (int it = gw; it < DEPTH * PER_LAYER; it += NGW) {
        const int l = it / PER_LAYER; int r = it % PER_LAYER;
        if (r < I_IN) { const int kb = r / (ZP / 32), nb = r % (ZP / 32);
            transpose_item<1>(a.w_in + (size_t)l * DM * IN_COLS, DM, IN_COLS, l ? a.ln2_g + (l - 1) * DM : nullptr, l ? a.ln2_b + (l - 1) * DM : nullptr,
                              (h16*)(a.ws + WS_WIN) + (size_t)l * ZP * DM, DM, ZP, c12 + C1IN + l * ZP, c12 + C2IN + l * ZP, kb, nb, scr, F.lane); continue; } r -= I_IN;
        if (r < I_OUT) { const int kb = r / 32, nb = r % 32;
            transpose_item<0>(a.w_out + (size_t)l * DM * DM, DM, DM, nullptr, nullptr, (h16*)(a.ws + WS_WOUT) + (size_t)l * DM * DM, DM, DM, nullptr, nullptr, kb, nb, scr, F.lane); continue; } r -= I_OUT;
        if (r < I_G) { const int kb = r / (FF / 32), nb = r % (FF / 32);
            transpose_item<2>(a.w_gate + (size_t)l * DM * FF, DM, FF, a.ln1_g + l * DM, a.ln1_b + l * DM, (h16*)(a.ws + WS_WGU) + (size_t)l * GU * DM, DM, GU, c12 + C1GU + l * GU, c12 + C2GU + l * GU, kb, nb, scr, F.lane); continue; } r -= I_G;
        if (r < I_G) { const int kb = r / (FF / 32), nb = r % (FF / 32);
            transpose_item<3>(a.w_up + (size_t)l * DM * FF, DM, FF, a.ln1_g + l * DM, a.ln1_b + l * DM, (h16*)(a.ws + WS_WGU) + (size_t)l * GU * DM, DM, GU, c12 + C1GU + l * GU, c12 + C2GU + l * GU, kb, nb, scr, F.lane); continue; } r -= I_G;
        if (r < I_DN) { const int kb = r / 32, nb = r % 32;
            transpose_item<0>(a.w_down + (size_t)l * FF * DM, FF, DM, nullptr, nullptr, (h16*)(a.ws + WS_WDOWN) + (size_t)l * DM * FF, FF, DM, nullptr, nullptr, kb, nb, scr, F.lane); continue; } r -= I_DN;
        if (r < I_UQ) { const int kb = r / 16, nb = r % 16;
            transpose_item<0>(a.b_w_uq + (size_t)l * 192 * 384, 192, 384, a.b_q_norm + l * 192, nullptr, (h16*)(a.ws + WS_WUQ) + (size_t)l * 512 * 256, 256, 384, nullptr, nullptr, kb, nb, scr, F.lane); continue; } r -= I_UQ;
        { const int kb = r / 16, nb = r % 16;
            transpose_item<0>(a.b_w_ukv + (size_t)l * 128 * 512, 128, 512, a.b_kv_norm + l * 128, nullptr, (h16*)(a.ws + WS_WUKV) + (size_t)l * 512 * 256, 256, 512, nullptr, nullptr, kb, nb, scr, F.lane); }
    }
    const size_t gt = (size_t)blockIdx.x * 512 + F.tid, NT = (size_t)F.G * 512;
    h16* V = (h16*)(a.ws + WS_V16);
    for (size_t i0 = gt; i0 < (size_t)M * DM / 8; i0 += 8 * NT) {
        f32x4 p[8], q[8];
#pragma unroll
        for (int k = 0; k < 8; ++k) { size_t i = i0 + k * NT; if (i >= (size_t)M * DM / 8) i = (size_t)M * DM / 8 - 1; p[k] = *(const f32x4*)(a.x + i * 8); q[k] = *(const f32x4*)(a.x + i * 8 + 4); }
#pragma unroll
        for (int k = 0; k < 8; ++k) { const size_t i = i0 + k * NT; if (i >= (size_t)M * DM / 8) continue;
            u32x4 w; w.x = pkh(p[k][0], p[k][1]); w.y = pkh(p[k][2], p[k][3]); w.z = pkh(q[k][0], q[k][1]); w.w = pkh(q[k][2], q[k][3]);
            *(u32x4*)(V + i * 8) = w; }
    }
    float* rb = (float*)(a.ws + WS_ROPEB); h16* rc = (h16*)(a.ws + WS_ROPEC);
    for (size_t i = gt; i < (size_t)M * 48; i += NT) {
        const int row = (int)(i / 48), j = (int)(i % 48);
        const float p = (float)a.pos[row];
        if (j < 16) { const float inv = powf(10000.0f, -(float)j / 16.0f); float s, c; sincosf(p * inv, &s, &c); rb[(size_t)row * 32 + j] = c; rb[(size_t)row * 32 + 16 + j] = s; }
        else { const int jj = j - 16; const float inv = powf(10000.0f, -(float)jj / 32.0f); float s, c; sincosf(p * inv, &s, &c); rc[(size_t)row * 64 + jj] = (h16)c; rc[(size_t)row * 64 + 32 + jj] = (h16)s; }
    }
    float* par = (float*)(a.ws + WS_PAR);
    for (size_t i = gt; i < (size_t)PF_END; i += NT) {
        const int k = (int)i; float v;
        if (k < PF_LN1B) v = a.ln1_g[k - PF_LN1G]; else if (k < PF_LN2G) v = a.ln1_b[k - PF_LN1B]; else if (k < PF_LN2B) v = a.ln2_g[k - PF_LN2G]; else if (k < PF_ALNG) v = a.ln2_b[k - PF_LN2B];
        else if (k < PF_ALNB) v = a.a_ln_g[k - PF_ALNG]; else if (k < PF_ABS) v = a.a_ln_b[k - PF_ALNB]; else if (k < PF_CONVW) v = a.a_bs[k - PF_ABS]; else if (k < PF_CONVB) v = a.d_conv_w[k - PF_CONVW];
        else if (k < PF_IGB) v = a.d_conv_b[k - PF_CONVB]; else if (k < PF_FGB) v = (k - PF_IGB < 16) ? a.d_igate_b[k - PF_IGB] : 0.f; else v = a.d_fgate_b[k - PF_FGB];
        par[k] = v;
    }
    h16* aws = (h16*)(a.ws + WS_AWS);
    for (size_t i = gt; i < (size_t)DEPTH * 4 * 128 * 128; i += NT) aws[i] = (h16)a.a_ws[i];
}

struct Core { float* out; unsigned char* ws; };
__device__ __forceinline__ void final_ln(const Core& a, const Frame& F0) {
    const Frame F = fresh_frame(F0);
    const int gw = blockIdx.x * 8 + F.wave, NGW = F.G * 8;
    const h16* V = (const h16*)(a.ws + WS_V16);
    const float* par = (const float*)(a.ws + WS_PAR); const float* g = par + PF_LN2G + (DEPTH - 1) * DM; const float* b = par + PF_LN2B + (DEPTH - 1) * DM;
    f32x4 gg[4], bb[4];
#pragma unroll
    for (int j = 0; j < 2; ++j)
#pragma unroll
        for (int k4 = 0; k4 < 2; ++k4) { const int c = j * 512 + F.lane * 8 + k4 * 4; gg[j * 2 + k4] = *(const f32x4*)(g + c); bb[j * 2 + k4] = *(const f32x4*)(b + c); }
    for (int r0 = gw; r0 < M; r0 += 4 * NGW) {
        h16x8 hv[4][2];
#pragma unroll
        for (int k = 0; k < 4; ++k) { int r = r0 + k * NGW; if (r >= M) r = M - 1;
#pragma unroll
            for (int j = 0; j < 2; ++j) hv[k][j] = *(const h16x8*)(V + (size_t)r * DM + j * 512 + F.lane * 8); }
#pragma unroll
        for (int k = 0; k < 4; ++k) { const int r = r0 + k * NGW; if (r >= M) continue;
            float v[16];
#pragma unroll
            for (int j = 0; j < 2; ++j)
#pragma unroll
                for (int e = 0; e < 8; ++e) v[j * 8 + e] = (float)hv[k][j][e];
            float s = 0.f;
#pragma unroll
            for (int e = 0; e < 16; ++e) s += v[e];
            const float mean = wave_sum(s) * (1.0f / DM); float q = 0.f;
#pragma unroll
            for (int e = 0; e < 16; ++e) { v[e] -= mean; q += v[e] * v[e]; }
            const float rs = rsqrtf(wave_sum(q) * (1.0f / DM) + LN_EPS);
#pragma unroll
            for (int j = 0; j < 2; ++j)
#pragma unroll
                for (int k4 = 0; k4 < 2; ++k4) { const int c = j * 512 + F.lane * 8 + k4 * 4; const f32x4 G4 = gg[j * 2 + k4], B4 = bb[j * 2 + k4];
                    f32x4 o; o[0] = v[j * 8 + k4 * 4 + 0] * rs * G4[0] + B4[0]; o[1] = v[j * 8 + k4 * 4 + 1] * rs * G4[1] + B4[1]; o[2] = v[j * 8 + k4 * 4 + 2] * rs * G4[2] + B4[2]; o[3] = v[j * 8 + k4 * 4 + 3] * rs * G4[3] + B4[3];
                    *(f32x4*)(a.out + (size_t)r * DM + c) = o; }
        }
    }
}

#ifndef EN_C
#define EN_C 1
#endif
#ifndef EN_B
#define EN_B 1
#endif
#ifndef EN_D
#define EN_D 1
#endif
#ifndef EN_B1
#define EN_B1 1
#endif
#ifndef EN_B2
#define EN_B2 1
#endif
#ifndef DUP_MASK
#define DUP_MASK 0
#endif
#ifndef EN_A
#define EN_A 1
#endif
#ifndef ZERO_FROM
#define ZERO_FROM 1024
#endif
#ifndef LOOP_START
#define LOOP_START 0
#endif
#ifndef LOOP_DEPTH
#define LOOP_DEPTH DEPTH
#endif
#ifndef EN_P0
#define EN_P0 1
#endif
#ifndef EN_P1
#define EN_P1 1
#endif
#ifndef EN_P3
#define EN_P3 1
#endif
#ifndef EN_P4
#define EN_P4 1
#endif
#ifndef EN_P5
#define EN_P5 1
#endif
#ifndef EN_PF
#define EN_PF 1
#endif

typedef short v4i16_t __attribute__((ext_vector_type(4)));
__device__ __forceinline__ f32x16 mfma32(h16x8 a, h16x8 b, f32x16 c) { return __builtin_amdgcn_mfma_f32_32x32x16_f16(a, b, c, 0, 0, 0); }
__device__ __forceinline__ int crow(int i, int hh) { return (i & 3) + 8 * (i >> 2) + 4 * hh; }
template <bool NAT>
__device__ __forceinline__ h16x8 tr_frag(const LAS h16* T, int pitch, int k0, int c0, int lane) {
    const int i = lane & 15, g4 = lane >> 4, hh = g4 >> 1;
    const int ra = k0 + (NAT ? 8 * hh : 4 * hh) + (i >> 2), rb = ra + (NAT ? 4 : 8);
    const int cc = c0 + 16 * (g4 & 1) + 4 * (i & 3);
    const v4i16_t x = __builtin_amdgcn_ds_read_tr16_b64_v4i16((LAS v4i16_t*)(T + ra * pitch + cc));
    const v4i16_t y = __builtin_amdgcn_ds_read_tr16_b64_v4i16((LAS v4i16_t*)(T + rb * pitch + cc));
    typedef short s16x8 __attribute__((ext_vector_type(8)));
    const s16x8 r = {x[0], x[1], x[2], x[3], y[0], y[1], y[2], y[3]};
    return __builtin_bit_cast(h16x8, r);
}
__device__ __forceinline__ float gelu_erf(float v) {
    const float av = fabsf(v), t = __builtin_amdgcn_rcpf(av * 0.2316418882f + 1.0f);
    float q = t * 0.5307027145f + (-0.7265760135f); q = q * t + 0.7107068705f; q = q * t + (-0.142248368f); q = q * t + 0.127414796f; q = q * t;
    const float e = __builtin_amdgcn_exp2f((v * v) * (-0.72134752044f));
    const float m = v * (q * e);
    return v < 0.f ? m : v - m;
}


__device__ __forceinline__ void store_row32(h16* rowp, const u32x2 (&v)[4], int hh) {
#pragma unroll
    for (int p = 0; p < 2; ++p) {
        const auto r0 = __builtin_amdgcn_permlane32_swap(v[2 * p].x, v[2 * p + 1].x, false, false);
        const auto r1 = __builtin_amdgcn_permlane32_swap(v[2 * p].y, v[2 * p + 1].y, false, false);
        const u32x4 w = {r0[0], r1[0], r0[1], r1[1]};
        *(u32x4*)(rowp + 16 * p + 8 * hh) = w;
    }
}
constexpr int GM_PITCH = 288;
template <int l>
__device__ __forceinline__ void gmlp_unit(const Core& C, const Frame& F0, int unit) {
    const Frame F = fresh_frame(F0);
    const h16* Z = (const h16*)(C.ws + WS_Z); h16* Y = (h16*)((unsigned char*)C.out + OUT_Y);
    const float* par = (const float*)(C.ws + WS_PAR);
    const h16* W = (const h16*)(C.ws + WS_AWS) + (size_t)l * 4 * 128 * 128;
    LAS h16* Vt = (LAS h16*)F.lds;
    const int row0 = (unit >> 4) * SEQ + (unit & 15) * 128;
    const int lane = F.lane, w = F.wave;
    {
        const f32x4 gg = *(const f32x4*)(par + PF_ALNG + l * GW + 4 * lane), bb = *(const f32x4*)(par + PF_ALNB + l * GW + 4 * lane);
        h16x4 hvv[16];
#pragma unroll
        for (int i = 0; i < 16; ++i) hvv[i] = *(const h16x4*)(Z + (size_t)(row0 + w * 16 + i) * ZP + ZC_A + 256 + 4 * lane);
#pragma unroll
        for (int i = 0; i < 16; ++i) {
            const int t = w * 16 + i;
            const h16x4 hv = hvv[i];
            float x[4]; float s = 0.f;
#pragma unroll
            for (int j = 0; j < 4; ++j) { x[j] = gelu_erf((float)hv[j]); s += x[j]; }
            const float mean = wave_sum(s) * (1.0f / 256.0f); float q = 0.f;
#pragma unroll
            for (int j = 0; j < 4; ++j) { x[j] -= mean; q += x[j] * x[j]; }
            const float rs = rsqrtf(wave_sum(q) * (1.0f / 256.0f) + LN_EPS);
            u32x2 o; o.x = pkh(x[0] * rs * gg[0] + bb[0], x[1] * rs * gg[1] + bb[1]); o.y = pkh(x[2] * rs * gg[2] + bb[2], x[3] * rs * gg[3] + bb[3]);
            *(LAS u32x2*)(Vt + t * GM_PITCH + 4 * lane) = o;
        }
    }
    __syncthreads();
    {
        const int h = w >> 1, db = w & 1, tl = lane & 31, hh = lane >> 5;
        const float* bs = par + PF_ABS + (l * 4 + h) * 128;
#pragma unroll 1
        for (int tb = 0; tb < 4; ++tb) {
            const int t = 32 * tb + tl;
            f32x16 acc;
#pragma unroll
            for (int i = 0; i < 16; ++i) acc[i] = 0.f;
            const h16* wrow = W + ((size_t)h * 128 + t) * 128 + 8 * hh;
            h16x4 uv[4];
            { const size_t zoff = (size_t)(row0 + t) * ZP + ZC_A + h * 64 + 32 * db + 4 * hh;
#pragma unroll
              for (int g = 0; g < 4; ++g) uv[g] = *(const h16x4*)(Z + zoff + 8 * g); }
            for (int ks = 0; ks < 2 * (tb + 1); ++ks) {
                const h16x8 a = tr_frag<true>(Vt, GM_PITCH, 16 * ks, h * 64 + 32 * db, lane);
                h16x8 bw = *(const h16x8*)(wrow + 16 * ks);
                const int s0 = 16 * ks + 8 * hh;
#pragma unroll
                for (int j = 0; j < 8; ++j) if (s0 + j > t) bw[j] = (h16)0.f;
                acc = mfma32(a, bw, acc);
            }
            const float bias = bs[t];
            u32x2 ov[4];
#pragma unroll
            for (int g = 0; g < 4; ++g) {
                const h16x4 uu = uv[g];
                ov[g].x = pkh(gelu_erf((float)uu[0]) * (acc[4 * g + 0] + bias), gelu_erf((float)uu[1]) * (acc[4 * g + 1] + bias));
                ov[g].y = pkh(gelu_erf((float)uu[2]) * (acc[4 * g + 2] + bias), gelu_erf((float)uu[3]) * (acc[4 * g + 3] + bias));
            }
            store_row32(Y + (size_t)(row0 + t) * DM + h * 64 + 32 * db, ov, hh);
        }
    }
    UNIT_END_BAR();
}


__device__ __forceinline__ bool bh_unit(int it, int n_per, int G, int& bh, int& r) {
    if (G != 256) { const int L = it * G + (int)blockIdx.x; if (L >= 128 * n_per) return false; bh = L / n_per; r = L % n_per; return true; }
    const int xcd = blockIdx.x & 7, s = blockIdx.x >> 3, j = it * 32 + s;
    if (j >= 16 * n_per) return false;
    bh = (j / n_per) * 8 + xcd; r = j % n_per; return true;
}
template <int DQ, int NT>
__device__ __forceinline__ void attn_tile(const LAS h16* Kt, int kpitch, const LAS h16* Vt, int vpitch, const h16x8 (&qf)[DQ / 16], float& m, float& ls, f32x16 (&o)[2],
                                          bool masked, int lo, int hi, int lane) {
    const int kr = lane & 31, hh = lane >> 5;
    f32x16 sc[NT];
#pragma unroll
    for (int t = 0; t < NT; ++t) {
#pragma unroll
        for (int i = 0; i < 16; ++i) sc[t][i] = 0.f;
#pragma unroll
        for (int ds = 0; ds < DQ / 16; ++ds) { const h16x8 a = *(const LAS h16x8*)(Kt + (32 * t + kr) * kpitch + 16 * ds + 8 * hh); sc[t] = mfma32(a, qf[ds], sc[t]); }
    }
    if (masked) {
#pragma unroll
        for (int t = 0; t < NT; ++t)
#pragma unroll
            for (int i = 0; i < 16; ++i) { const int kk = 32 * t + crow(i, hh); if (kk < lo || kk > hi) sc[t][i] = -INFINITY; }
    }
    float mx = sc[0][0];
#pragma unroll
    for (int t = 0; t < NT; ++t)
#pragma unroll
        for (int i = 0; i < 16; ++i) mx = fmaxf(mx, sc[t][i]);
    mx = fmaxf(mx, __shfl_xor(mx, 32));
    if (__any(mx > m)) {
        const float mn = fmaxf(m, mx);
        const float alpha = __builtin_amdgcn_exp2f(m - mn);
        ls *= alpha; m = mn;
#pragma unroll
        for (int i = 0; i < 16; ++i) { o[0][i] *= alpha; o[1][i] *= alpha; }
    }
    float ps = 0.f;
#pragma unroll
    for (int t = 0; t < NT; ++t)
#pragma unroll
        for (int i = 0; i < 16; ++i) { sc[t][i] = __builtin_amdgcn_exp2f(sc[t][i] - m); ps += sc[t][i]; }
    ls += ps;
#pragma unroll
    for (int t = 0; t < NT; ++t) {
        h16x8 pf[2];
#pragma unroll
        for (int s2 = 0; s2 < 2; ++s2)
#pragma unroll
            for (int j = 0; j < 8; ++j) pf[s2][j] = (h16)sc[t][8 * s2 + j];
#pragma unroll
        for (int db = 0; db < 2; ++db)
#pragma unroll
            for (int s2 = 0; s2 < 2; ++s2) { const h16x8 a = tr_frag<false>(Vt + 32 * t * vpitch, vpitch, 16 * s2, 32 * db, lane); o[db] = mfma32(a, pf[s2], o[db]); }
    }
}


template <int DQ>
__device__ __forceinline__ void attn_tile_dual(const LAS h16* Kt, int kpitch, const LAS h16* Vt, int vpitch, const h16x8 (&qA)[DQ / 16], const h16x8 (&qB)[DQ / 16],
                                               float& mA, float& lsA, f32x16 (&oA)[2], float& mB, float& lsB, f32x16 (&oB)[2], bool maskA, int hiA, bool maskB, int hiB, int lane) {
    const int kr = lane & 31, hh = lane >> 5;
    f32x16 sA, sB;
#pragma unroll
    for (int i = 0; i < 16; ++i) { sA[i] = 0.f; sB[i] = 0.f; }
#pragma unroll
    for (int ds = 0; ds < DQ / 16; ++ds) { const h16x8 a = *(const LAS h16x8*)(Kt + kr * kpitch + 16 * ds + 8 * hh); sA = mfma32(a, qA[ds], sA); sB = mfma32(a, qB[ds], sB); }
    if (maskA) {
#pragma unroll
        for (int i = 0; i < 16; ++i) if (crow(i, hh) > hiA) sA[i] = -INFINITY;
    }
    if (maskB) {
#pragma unroll
        for (int i = 0; i < 16; ++i) if (crow(i, hh) > hiB) sB[i] = -INFINITY;
    }
    float xa = sA[0], xb = sB[0];
#pragma unroll
    for (int i = 1; i < 16; ++i) { xa = fmaxf(xa, sA[i]); xb = fmaxf(xb, sB[i]); }
    xa = fmaxf(xa, __shfl_xor(xa, 32)); xb = fmaxf(xb, __shfl_xor(xb, 32));
    if (__any(xa > mA)) { const float mn = fmaxf(mA, xa), al = __builtin_amdgcn_exp2f(mA - mn); lsA *= al; mA = mn;
#pragma unroll
        for (int i = 0; i < 16; ++i) { oA[0][i] *= al; oA[1][i] *= al; } }
    if (__any(xb > mB)) { const float mn = fmaxf(mB, xb), al = __builtin_amdgcn_exp2f(mB - mn); lsB *= al; mB = mn;
#pragma unroll
        for (int i = 0; i < 16; ++i) { oB[0][i] *= al; oB[1][i] *= al; } }
    float pa = 0.f, pb = 0.f;
#pragma unroll
    for (int i = 0; i < 16; ++i) { sA[i] = __builtin_amdgcn_exp2f(sA[i] - mA); pa += sA[i]; sB[i] = __builtin_amdgcn_exp2f(sB[i] - mB); pb += sB[i]; }
    lsA += pa; lsB += pb;
    h16x8 fA[2], fB[2];
#pragma unroll
    for (int s2 = 0; s2 < 2; ++s2)
#pragma unroll
        for (int j = 0; j < 8; ++j) { fA[s2][j] = (h16)sA[8 * s2 + j]; fB[s2][j] = (h16)sB[8 * s2 + j]; }
#pragma unroll
    for (int db = 0; db < 2; ++db)
#pragma unroll
        for (int s2 = 0; s2 < 2; ++s2) { const h16x8 a = tr_frag<false>(Vt, vpitch, 16 * s2, 32 * db, lane); oA[db] = mfma32(a, fA[s2], oA[db]); oB[db] = mfma32(a, fB[s2], oB[db]); }
}
constexpr int DK_PITCH = 72, DV_PITCH = 96;
constexpr int DIL_V_OFF = 384 * DK_PITCH * 2;
constexpr float QK_SCALE64 = 0.125f * 1.4426950408889634f;
struct DilGeo { int br, b, h, d, tok0, res0, U0, nrows, segbase; };
struct DilPre { h16x8 vreg[6], kreg[6], qa[4]; };
__device__ __forceinline__ DilGeo dil_geo(int bh, int rr) {
    DilGeo g; const int x = rr & 7; g.br = rr >> 3; g.b = bh >> 2; g.h = bh & 3; g.d = g.br == 0 ? 1 : g.br == 1 ? 4 : 16; g.tok0 = g.b * SEQ;
    if (g.br == 0) { g.res0 = 0; g.U0 = 256 * x; g.nrows = 384; } else if (g.br == 1) { g.res0 = x >> 1; g.U0 = 256 * (x & 1); g.nrows = 384; } else { g.res0 = 2 * x; g.U0 = 128; g.nrows = 256; }
    g.segbase = g.U0 - 128;
    return g;
}
__device__ __forceinline__ void dil_qgeo(const DilGeo& g, int w, int& res, int& jblk, int& rowoff) {
    if (g.br == 2) { res = g.res0 + (w >> 2); jblk = w & 3; rowoff = 128 * (w >> 2); } else { res = g.res0; jblk = (g.U0 >> 5) + w; rowoff = -g.segbase; }
}
__device__ __forceinline__ void dil_issue(const Core& C, const Frame& F, const DilGeo& g, DilPre& P) {
    const h16* Z = (const h16*)(C.ws + WS_Z);
    const int tid = F.tid, lane = F.lane, br = g.br, d = g.d, h = g.h;
#pragma unroll
    for (int i = 0; i < 6; ++i) {
        int it = tid + 512 * i; if (it >= g.nrows * 8) it = g.nrows * 8 - 1;
        const int ri = it >> 3, c8 = it & 7;
        int up, res; if (br == 2) { up = ri & 127; res = g.res0 + (ri >> 7); } else { up = g.segbase + ri; res = g.res0; }
        if (up < 0) up = 0;
        const h16* src = Z + (size_t)(g.tok0 + up * d + res) * ZP + ZC_C + h * 64 + 8 * c8;
        P.vreg[i] = *(const h16x8*)(src + 512); P.kreg[i] = *(const h16x8*)(src + 256);
    }
    int res, jblk, rowoff; dil_qgeo(g, F.wave, res, jblk, rowoff);
    const int qi = lane & 31, hh = lane >> 5;
    const int qtok = g.tok0 + (32 * jblk + qi) * d + res;
    const h16* qsrc = Z + (size_t)qtok * ZP + ZC_C + h * 64 + 8 * hh;
#pragma unroll
    for (int ds = 0; ds < 4; ++ds) P.qa[ds] = *(const h16x8*)(qsrc + 16 * ds);
}
__device__ __forceinline__ void dil_stage(const Frame& F, const DilGeo& g, const DilPre& P, h16x8 (&qf)[4]) {
    LAS h16* Kt = (LAS h16*)F.lds; LAS h16* Vt = (LAS h16*)(F.lds + DIL_V_OFF);
    const int tid = F.tid, br = g.br;
#pragma unroll
    for (int i = 0; i < 6; ++i) {
        const int it = tid + 512 * i; const int ri = it >> 3, c8 = it & 7;
        int up; if (br == 2) up = ri & 127; else up = g.segbase + ri;
        if (it < g.nrows * 8 && up >= 0) { *(LAS h16x8*)(Vt + ri * DV_PITCH + 8 * c8) = P.vreg[i]; *(LAS h16x8*)(Kt + ri * DK_PITCH + 8 * c8) = P.kreg[i]; }
    }
#pragma unroll
    for (int ds = 0; ds < 4; ++ds) qf[ds] = P.qa[ds];
}
__device__ __forceinline__ void dil_compute(const Core& C, const Frame& F, const DilGeo& g, const h16x8 (&qf)[4]) {
    h16* DP = (h16*)((unsigned char*)C.out + OUT_DP); float* DL = (float*)((unsigned char*)C.out + OUT_DL);
    const LAS h16* Kt = (const LAS h16*)F.lds; const LAS h16* Vt = (const LAS h16*)(F.lds + DIL_V_OFF);
    const int lane = F.lane, br = g.br, h = g.h;
    int res, jblk, rowoff; dil_qgeo(g, F.wave, res, jblk, rowoff);
    const int qi = lane & 31, hh = lane >> 5;
    const int qtok = g.tok0 + (32 * jblk + qi) * g.d + res;
    float m = -INFINITY, ls = 0.f; f32x16 o[2];
#pragma unroll
    for (int i = 0; i < 16; ++i) { o[0][i] = 0.f; o[1][i] = 0.f; }
    {
        const int ub0 = 32 * (jblk - 4);
        if (ub0 >= 0) { const int rowb = ub0 + rowoff; attn_tile<64, 1>(Kt + rowb * DK_PITCH, DK_PITCH, Vt + rowb * DV_PITCH, DV_PITCH, qf, m, ls, o, true, qi, 64, lane); }
        if (ub0 + 32 >= 0) { const int rowb = ub0 + 32 + rowoff; attn_tile<64, 2>(Kt + rowb * DK_PITCH, DK_PITCH, Vt + rowb * DV_PITCH, DV_PITCH, qf, m, ls, o, false, -1, 64, lane); }
        else if (ub0 + 64 >= 0) { const int rowb = ub0 + 64 + rowoff; attn_tile<64, 1>(Kt + rowb * DK_PITCH, DK_PITCH, Vt + rowb * DV_PITCH, DV_PITCH, qf, m, ls, o, false, -1, 64, lane); }
        if (ub0 + 96 >= 0) { const int rowb = ub0 + 96 + rowoff; attn_tile<64, 2>(Kt + rowb * DK_PITCH, DK_PITCH, Vt + rowb * DV_PITCH, DV_PITCH, qf, m, ls, o, true, -1, 32 + qi, lane); }
        else { const int rowb = ub0 + 128 + rowoff; attn_tile<64, 1>(Kt + rowb * DK_PITCH, DK_PITCH, Vt + rowb * DV_PITCH, DV_PITCH, qf, m, ls, o, true, -1, qi, lane); }
    }
    const float lt = ls + __shfl_xor(ls, 32);
    const float inv = 1.0f / lt;
    unsigned char* dst8 = (unsigned char*)DP + ((size_t)qtok * 3 + br) * 256 + h * 64 + 16 * hh;
#pragma unroll
    for (int db = 0; db < 2; ++db) { u32x4 w;
#pragma unroll
        for (int gq = 0; gq < 4; ++gq) { int p = __builtin_amdgcn_cvt_pk_fp8_f32(o[db][4 * gq] * inv, o[db][4 * gq + 1] * inv, 0, false); p = __builtin_amdgcn_cvt_pk_fp8_f32(o[db][4 * gq + 2] * inv, o[db][4 * gq + 3] * inv, p, true); w[gq] = (unsigned)p; }
        *(u32x4*)(dst8 + 32 * db) = w; }
    if (hh == 0) DL[((size_t)qtok * 3 + br) * 4 + h] = m + __builtin_amdgcn_logf(lt);
}
template <int l>
__device__ __forceinline__ void dilated_phase(const Core& C, const Frame& F0) {
    const Frame F = fresh_frame(F0);
    int bh, rr;
    if (!bh_unit(0, 24, F.G, bh, rr)) return;
    DilGeo g = dil_geo(bh, rr); DilPre P;
    dil_issue(C, F, g, P);
    int it = 0;
#pragma unroll 1
    for (;;) {
        h16x8 qf[4];
        dil_stage(F, g, P, qf);
        __syncthreads();
        int bh2, rr2; const bool hn = bh_unit(it + 1, 24, F.G, bh2, rr2);
        DilGeo g2 = g;
        if (hn) { g2 = dil_geo(bh2, rr2); dil_issue(C, F, g2, P); }
        dil_compute(C, F, g, qf);
        asm volatile("s_waitcnt lgkmcnt(0)" ::: "memory"); __builtin_amdgcn_s_barrier(); asm volatile("" ::: "memory");
        if (!hn) break;
        g = g2; ++it;
    }
}
__device__ __forceinline__ void dil_combine(const Core& C, const Frame& F0) {
    const Frame F = fresh_frame(F0);
    const h16* DP = (const h16*)((unsigned char*)C.out + OUT_DP); const float* DL = (const float*)((unsigned char*)C.out + OUT_DL); h16* Y = (h16*)((unsigned char*)C.out + OUT_Y);
    const size_t gt = (size_t)blockIdx.x * 512 + F.tid, NT = (size_t)F.G * 512;
    const unsigned char* DP8 = (const unsigned char*)DP;
    for (size_t it0 = gt; it0 < (size_t)M * 8; it0 += 2 * NT) {
        float l0[2], l1[2], l2[2]; u32x4 av[2][3][2];
#pragma unroll
        for (int k = 0; k < 2; ++k) { size_t it = it0 + k * NT; if (it >= (size_t)M * 8) it = (size_t)M * 8 - 1; const size_t tok = it >> 3; const int hd = (int)(it & 7), h = hd >> 1, db = hd & 1;
            const size_t off = (size_t)h * 64 + 32 * db;
            l0[k] = DL[(tok * 3 + 0) * 4 + h]; l1[k] = DL[(tok * 3 + 1) * 4 + h]; l2[k] = DL[(tok * 3 + 2) * 4 + h];
#pragma unroll
            for (int br = 0; br < 3; ++br) { av[k][br][0] = *(const u32x4*)(DP8 + (tok * 3 + br) * 256 + off); av[k][br][1] = *(const u32x4*)(DP8 + (tok * 3 + br) * 256 + off + 16); } }
#pragma unroll
        for (int k = 0; k < 2; ++k) { const size_t it = it0 + k * NT; if (it >= (size_t)M * 8) continue; const size_t tok = it >> 3; const int hd = (int)(it & 7);
            const float mx = fmaxf(l0[k], fmaxf(l1[k], l2[k]));
            float w0 = __builtin_amdgcn_exp2f(l0[k] - mx), w1 = __builtin_amdgcn_exp2f(l1[k] - mx), w2 = __builtin_amdgcn_exp2f(l2[k] - mx);
            const float inv = 1.0f / (w0 + w1 + w2); w0 *= inv; w1 *= inv; w2 *= inv;
#pragma unroll
            for (int g = 0; g < 4; ++g) {
                float r[8];
#pragma unroll
                for (int half = 0; half < 2; ++half) {
                    const unsigned x0 = av[k][0][half][g], x1 = av[k][1][half][g], x2 = av[k][2][half][g];
                    const f32x2 p0 = __builtin_amdgcn_cvt_pk_f32_fp8((int)x0, false), q0 = __builtin_amdgcn_cvt_pk_f32_fp8((int)x0, true);
                    const f32x2 p1 = __builtin_amdgcn_cvt_pk_f32_fp8((int)x1, false), q1 = __builtin_amdgcn_cvt_pk_f32_fp8((int)x1, true);
                    const f32x2 p2 = __builtin_amdgcn_cvt_pk_f32_fp8((int)x2, false), q2 = __builtin_amdgcn_cvt_pk_f32_fp8((int)x2, true);
                    r[4 * half + 0] = p0[0] * w0 + p1[0] * w1 + p2[0] * w2; r[4 * half + 1] = p0[1] * w0 + p1[1] * w1 + p2[1] * w2;
                    r[4 * half + 2] = q0[0] * w0 + q1[0] * w1 + q2[0] * w2; r[4 * half + 3] = q0[1] * w0 + q1[1] * w1 + q2[1] * w2;
                }
                h16x8 rr;
#pragma unroll
                for (int j = 0; j < 8; ++j) rr[j] = (h16)r[j];
                *(h16x8*)(Y + tok * DM + 512 + 32 * hd + 8 * g) = rr; }
        }
    }
}
__device__ __forceinline__ void mla_krope(const Core& C, const Frame& F0) {
    const Frame F = fresh_frame(F0);
    const h16* Z = (const h16*)(C.ws + WS_Z); const float* rb = (const float*)(C.ws + WS_ROPEB); h16* Kf = (h16*)(C.ws + WS_KF);
    const size_t gt = (size_t)blockIdx.x * 512 + F.tid, NT = (size_t)F.G * 512;
    for (size_t it = gt; it < (size_t)M * 2; it += NT) {
        const size_t tok = it >> 1; const int c = (int)(it & 1);
        const h16x8 x1 = *(const h16x8*)(Z + tok * ZP + ZC_KR + 8 * c), x2 = *(const h16x8*)(Z + tok * ZP + ZC_KR + 16 + 8 * c);
        const float* cs = rb + tok * 32 + 8 * c;
        h16x8 o1, o2;
#pragma unroll
        for (int j = 0; j < 8; ++j) { const float cc = cs[j], ss = cs[16 + j], a = (float)x1[j], b = (float)x2[j]; o1[j] = (h16)(a * cc - b * ss); o2[j] = (h16)(a * ss + b * cc); }
#pragma unroll
        for (int hd = 0; hd < 4; ++hd) { *(h16x8*)(Kf + tok * 384 + hd * 96 + 64 + 8 * c) = o1; *(h16x8*)(Kf + tok * 384 + hd * 96 + 80 + 8 * c) = o2; }
    }
}
constexpr int MK_PITCH = 104, MV_PITCH = 96;
constexpr int MLA_KB = 64 * MK_PITCH * 2, MLA_VB = 64 * MV_PITCH * 2;
template <int MODE>
__device__ __forceinline__ void mla_qblock(const Core& C, const Frame& F0, int b, int h, int qblk, h16* Yout) {
    const Frame F = fresh_frame(F0);
    const h16* Qm = (const h16*)(C.ws + WS_Q); const h16* Kf = (const h16*)(C.ws + WS_KF); const h16* Vm = (const h16*)(C.ws + WS_VM); h16* Y = Yout;
    const int lane = F.lane, w = F.wave, tid = F.tid, qi = lane & 31, hh = lane >> 5;
    const int tok0 = b * SEQ, q0w = 256 * qblk + 32 * w;
    h16x8 qf[6];
    { const h16* qsrc = Qm + (size_t)(tok0 + q0w + qi) * 384 + h * 96 + 8 * hh;
#pragma unroll
      for (int ds = 0; ds < 6; ++ds) qf[ds] = *(const h16x8*)(qsrc + 16 * ds); }
    float m = -INFINITY, ls = 0.f; f32x16 o[2];
#pragma unroll
    for (int i = 0; i < 16; ++i) { o[0][i] = 0.f; o[1][i] = 0.f; }
    const int nkt = 4 * (qblk + 1);
    const int kr0 = tid / 12, kc0 = tid % 12, kr1 = (tid + 512) / 12, kc1 = (tid + 512) % 12, vr = tid >> 3, vc = tid & 7;
    const bool has2 = tid < 256;
    const h16* kp0 = Kf + (size_t)(tok0 + kr0) * 384 + h * 96 + 8 * kc0; const h16* kp1 = Kf + (size_t)(tok0 + (has2 ? kr1 : kr0)) * 384 + h * 96 + 8 * (has2 ? kc1 : kc0);
    const h16* vp = Vm + (size_t)(tok0 + vr) * 256 + h * 64 + 8 * vc;
    const int ko0 = kr0 * MK_PITCH + 8 * kc0, ko1 = kr1 * MK_PITCH + 8 * kc1, vo = vr * MV_PITCH + 8 * vc;
#define MLA_LOAD(KA, KB, VA, t) do { const size_t o_ = (MODE & 1) ? 0 : (size_t)64 * (t); KA = *(const h16x8*)(kp0 + o_ * 384); KB = *(const h16x8*)(kp1 + o_ * 384); VA = *(const h16x8*)(vp + o_ * 256); } while (0)
#define MLA_STORE(KA, KB, VA, buf) do { LAS h16* Kn = (LAS h16*)(F.lds + (buf) * MLA_KB); LAS h16* Vn = (LAS h16*)(F.lds + 3 * MLA_KB + (buf) * MLA_VB); \
        *(LAS h16x8*)(Kn + ko0) = KA; if (has2) *(LAS h16x8*)(Kn + ko1) = KB; *(LAS h16x8*)(Vn + vo) = VA; } while (0)
#define MLA_BAR() do { asm volatile("s_waitcnt lgkmcnt(0)" ::: "memory"); __builtin_amdgcn_s_barrier(); asm volatile("" ::: "memory"); } while (0)
#define MLA_COMPUTE(kt_, buf) do { const LAS h16* Kt = (const LAS h16*)(F.lds + (buf) * MLA_KB); const LAS h16* Vt = (const LAS h16*)(F.lds + 3 * MLA_KB + (buf) * MLA_VB); \
        const int kbase = 64 * (kt_); \
        if (kbase + 32 <= q0w + 31) { attn_tile<96, 2>(Kt, MK_PITCH, Vt, MV_PITCH, qf, m, ls, o, kbase + 63 > q0w, -1, q0w + qi - kbase, lane); } \
        else if (kbase <= q0w + 31) { attn_tile<96, 1>(Kt, MK_PITCH, Vt, MV_PITCH, qf, m, ls, o, true, -1, q0w + qi - kbase, lane); } } while (0)
    h16x8 kaA, kbA, vaA, kaB, kbB, vaB;
    MLA_LOAD(kaA, kbA, vaA, 0);
    MLA_LOAD(kaB, kbB, vaB, 1);
    MLA_STORE(kaA, kbA, vaA, 0);
    MLA_BAR();
    int buf = 0;
#pragma unroll 1
    for (int kt = 0; kt < nkt; kt += 2) {
        const int b1 = buf == 2 ? 0 : buf + 1, b2 = b1 == 2 ? 0 : b1 + 1;
        if (kt + 2 < nkt) MLA_LOAD(kaA, kbA, vaA, kt + 2);
        MLA_COMPUTE(kt, buf);
        MLA_STORE(kaB, kbB, vaB, b1);
        MLA_BAR();
        if (kt + 3 < nkt) MLA_LOAD(kaB, kbB, vaB, kt + 3);
        MLA_COMPUTE(kt + 1, b1);
        if (kt + 2 < nkt) MLA_STORE(kaA, kbA, vaA, b2);
        MLA_BAR();
        buf = b2;
    }
#undef MLA_LOAD
#undef MLA_STORE
#undef MLA_BAR
#undef MLA_COMPUTE
    const float lt = ls + __shfl_xor(ls, 32);
    const float inv = 1.0f / lt;
    h16* dst = Y + (size_t)(tok0 + q0w + qi) * DM + 256 + h * 64;
#pragma unroll
    for (int db = 0; db < 2; ++db) { u32x2 ov[4];
#pragma unroll
        for (int g = 0; g < 4; ++g) { ov[g].x = pkh(o[db][4 * g] * inv, o[db][4 * g + 1] * inv); ov[g].y = pkh(o[db][4 * g + 2] * inv, o[db][4 * g + 3] * inv); }
        store_row32(dst + 32 * db, ov, hh); }
}
template <int MODE>
__device__ __forceinline__ void mla_qblock2(const Core& C, const Frame& F0, int b, int h, int qblk, h16* Yout) {
    const Frame F = fresh_frame(F0);
    const h16* Qm = (const h16*)(C.ws + WS_Q); const h16* Kf = (const h16*)(C.ws + WS_KF); const h16* Vm = (const h16*)(C.ws + WS_VM); h16* Y = Yout;
    const int lane = F.lane, w = F.wave, tid = F.tid, qi = lane & 31, hh = lane >> 5;
    const int tok0 = b * SEQ, q0w = 512 * qblk + 64 * w;
    h16x8 qf[6], qg[6];
    { const h16* qsrc = Qm + (size_t)(tok0 + q0w + qi) * 384 + h * 96 + 8 * hh;
#pragma unroll
      for (int ds = 0; ds < 6; ++ds) { qf[ds] = *(const h16x8*)(qsrc + 16 * ds); qg[ds] = *(const h16x8*)(qsrc + (size_t)32 * 384 + 16 * ds); } }
    float m = -INFINITY, ls = 0.f, m2 = -INFINITY, ls2 = 0.f; f32x16 o[2], o2[2];
#pragma unroll
    for (int i = 0; i < 16; ++i) { o[0][i] = 0.f; o[1][i] = 0.f; o2[0][i] = 0.f; o2[1][i] = 0.f; }
    const int nkt = 8 * (qblk + 1);
    const int kr0 = tid / 12, kc0 = tid % 12, kr1 = (tid + 512) / 12, kc1 = (tid + 512) % 12, vr = tid >> 3, vc = tid & 7;
    const bool has2 = tid < 256;
    const h16* Kr = (const h16*)(C.ws + WS_KR);
    const int kr1c = has2 ? kr1 : kr0, kc1c = has2 ? kc1 : kc0;
    const h16* kp0 = kc0 < 8 ? Kf + (size_t)(tok0 + kr0) * 256 + h * 64 + 8 * kc0 : Kr + (size_t)(tok0 + kr0) * 32 + 8 * (kc0 - 8);
    const h16* kp1 = kc1c < 8 ? Kf + (size_t)(tok0 + kr1c) * 256 + h * 64 + 8 * kc1c : Kr + (size_t)(tok0 + kr1c) * 32 + 8 * (kc1c - 8);
    const size_t ks0 = kc0 < 8 ? 256 : 32, ks1 = kc1c < 8 ? 256 : 32;
    const h16* vp = Vm + (size_t)(tok0 + vr) * 256 + h * 64 + 8 * vc;
    const int ko0 = kr0 * MK_PITCH + 8 * kc0, ko1 = kr1 * MK_PITCH + 8 * kc1, vo = vr * MV_PITCH + 8 * vc;
#define MLA_LOAD(KA, KB, VA, t) do { const size_t o_ = (MODE & 1) ? 0 : (size_t)64 * (t); KA = *(const h16x8*)(kp0 + o_ * ks0); KB = *(const h16x8*)(kp1 + o_ * ks1); VA = *(const h16x8*)(vp + o_ * 256); } while (0)
#define MLA_STORE(KA, KB, VA, buf) do { LAS h16* Kn = (LAS h16*)(F.lds + (buf) * MLA_KB); LAS h16* Vn = (LAS h16*)(F.lds + 3 * MLA_KB + (buf) * MLA_VB); \
        *(LAS h16x8*)(Kn + ko0) = KA; if (has2) *(LAS h16x8*)(Kn + ko1) = KB; *(LAS h16x8*)(Vn + vo) = VA; } while (0)
#define MLA_BAR() do { asm volatile("s_waitcnt lgkmcnt(0)" ::: "memory"); __builtin_amdgcn_s_barrier(); asm volatile("" ::: "memory"); } while (0)
#define MLA_COMPUTE(kt_, buf) do { const LAS h16* Kt = (const LAS h16*)(F.lds + (buf) * MLA_KB); const LAS h16* Vt = (const LAS h16*)(F.lds + 3 * MLA_KB + (buf) * MLA_VB); \
        _Pragma("unroll") for (int sub_ = 0; sub_ < 2; ++sub_) { const int kbase = 64 * (kt_) + 32 * sub_; \
            const LAS h16* Ks = Kt + 32 * sub_ * MK_PITCH; const LAS h16* Vs = Vt + 32 * sub_ * MV_PITCH; \
              \
            if (kbase <= q0w + 63) attn_tile_dual<96>(Ks, MK_PITCH, Vs, MV_PITCH, qf, qg, m, ls, o, m2, ls2, o2, kbase + 31 > q0w, q0w + qi - kbase, kbase + 31 > q0w + 32, q0w + 32 + qi - kbase, lane); } } while (0)
    h16x8 kaA, kbA, vaA, kaB, kbB, vaB;
    MLA_LOAD(kaA, kbA, vaA, 0);
    MLA_LOAD(kaB, kbB, vaB, 1);
    MLA_STORE(kaA, kbA, vaA, 0);
    MLA_BAR();
    int buf = 0;
#pragma unroll 1
    for (int kt = 0; kt < nkt; kt += 2) {
        const int b1 = buf == 2 ? 0 : buf + 1, b2 = b1 == 2 ? 0 : b1 + 1;
        if (kt + 2 < nkt) MLA_LOAD(kaA, kbA, vaA, kt + 2);
        MLA_COMPUTE(kt, buf);
        MLA_STORE(kaB, kbB, vaB, b1);
        MLA_BAR();
        if (kt + 3 < nkt) MLA_LOAD(kaB, kbB, vaB, kt + 3);
        MLA_COMPUTE(kt + 1, b1);
        if (kt + 2 < nkt) MLA_STORE(kaA, kbA, vaA, b2);
        MLA_BAR();
        buf = b2;
    }
#undef MLA_LOAD
#undef MLA_STORE
#undef MLA_BAR
#undef MLA_COMPUTE
    {
    const float lt = ls + __shfl_xor(ls, 32);
    const float inv = 1.0f / lt;
    h16* dst = Y + (size_t)(tok0 + q0w + qi) * DM + 256 + h * 64;
#pragma unroll
    for (int db = 0; db < 2; ++db) { u32x2 ov[4];
#pragma unroll
        for (int g = 0; g < 4; ++g) { ov[g].x = pkh(o[db][4 * g] * inv, o[db][4 * g + 1] * inv); ov[g].y = pkh(o[db][4 * g + 2] * inv, o[db][4 * g + 3] * inv); }
        store_row32(dst + 32 * db, ov, hh); }
    }
    {
    const float lt = ls2 + __shfl_xor(ls2, 32);
    const float inv = 1.0f / lt;
    h16* dst = Y + (size_t)(tok0 + q0w + 32 + qi) * DM + 256 + h * 64;
#pragma unroll
    for (int db = 0; db < 2; ++db) { u32x2 ov[4];
#pragma unroll
        for (int g = 0; g < 4; ++g) { ov[g].x = pkh(o2[db][4 * g] * inv, o2[db][4 * g + 1] * inv); ov[g].y = pkh(o2[db][4 * g + 2] * inv, o2[db][4 * g + 3] * inv); }
        store_row32(dst + 32 * db, ov, hh); }
    }
}

template <int MODE>
__device__ __forceinline__ void mla_unit2(const Core& C, const Frame& F, int unit, h16* Yout) {
    const int bh = unit >> 1, p = unit & 1;
    mla_qblock2<MODE>(C, F, bh >> 2, bh & 3, 3 - p, Yout);
    mla_qblock2<MODE>(C, F, bh >> 2, bh & 3, p, Yout);
}
template <int MODE>
__device__ __forceinline__ void mla_unit(const Core& C, const Frame& F, int unit, h16* Yout) {
    const int b = unit >> 4, h = (unit >> 2) & 3, p = unit & 3;
    mla_qblock<MODE>(C, F, b, h, 7 - p, Yout);
    mla_qblock<MODE>(C, F, b, h, p, Yout);
}


constexpr int ML_QP = 72, ML_VP = 96;
constexpr int ML_Q = 0, ML_K = ML_Q + 128 * ML_QP * 2, ML_KW = ML_K + 128 * ML_QP * 2, ML_V = ML_KW + 128 * ML_VP * 2, ML_C = ML_V + 128 * ML_VP * 2, ML_F = ML_C + 64 * ML_VP * 2;
constexpr float LOG2E = 1.4426950408889634f;
constexpr int MLG_STRIDE = 400;
__device__ __forceinline__ void ml_conv_load(const h16* Z, const float* cw, const float* cb, int b, int c, int h, const bool both, LAS h16* Qt, LAS h16* Kt, int tid) {
    const int isk = both ? (tid >> 8) : 1, rg = (tid & 255) >> 3, c8 = tid & 7, col = isk * 256 + h * 64 + 8 * c8;
    if (!both && tid >= 256) return;
    h16x8 xv[7];
#pragma unroll
    for (int j = 0; j < 7; ++j) { int pos = 128 * c + 4 * rg - 3 + j; if (pos < 0) pos = 0;
        xv[j] = *(const h16x8*)(Z + (size_t)(b * SEQ + pos) * ZP + ZC_D + col); }
    f32x4 w0[4], w1[4];
#pragma unroll
    for (int j = 0; j < 4; ++j) { w0[j] = *(const f32x4*)(cw + j * 512 + col); w1[j] = *(const f32x4*)(cw + j * 512 + col + 4); }
    const f32x4 b0 = *(const f32x4*)(cb + col), b1 = *(const f32x4*)(cb + col + 4);
    const float sc = isk ? 0.125f : 1.0f;
    LAS h16* dst = isk ? Kt : Qt;
#pragma unroll
    for (int i = 0; i < 4; ++i) {
        float acc[8];
#pragma unroll
        for (int e = 0; e < 4; ++e) { acc[e] = b0[e]; acc[4 + e] = b1[e]; }
#pragma unroll
        for (int j = 0; j < 4; ++j) { const float on = (128 * c + 4 * rg + i - 3 + j >= 0) ? 1.0f : 0.0f;
#pragma unroll
            for (int e = 0; e < 4; ++e) { acc[e] += on * w0[j][e] * (float)xv[i + j][e]; acc[4 + e] += on * w1[j][e] * (float)xv[i + j][4 + e]; } }
        h16x8 ov;
#pragma unroll
        for (int e = 0; e < 8; ++e) { const float y = acc[e]; ov[e] = (h16)(y * sc * __builtin_amdgcn_rcpf(1.0f + __builtin_amdgcn_exp2f(-y * LOG2E))); }
        *(LAS h16x8*)(dst + (4 * rg + i) * ML_QP + 8 * c8) = ov;
    }
}
__device__ __forceinline__ void ml_gate_load(const h16* Z, int tokc, int h, int lane, h16 (&gz)[4]) {
    const size_t z0 = (size_t)(tokc + 2 * lane) * ZP + ZC_GATE + h;
    gz[0] = Z[z0]; gz[1] = Z[z0 + ZP]; gz[2] = Z[z0 + 4]; gz[3] = Z[z0 + ZP + 4];
}
__device__ __forceinline__ void ml_gates(const h16 (&gz)[4], float igb, float fgb, LAS float* gk, LAS float* bc, LAS float* pm, int lane, float& bend, float& gmax) {
    const float i0 = (float)gz[0] + igb, i1 = (float)gz[1] + igb, f0 = (float)gz[2] + fgb, f1 = (float)gz[3] + fgb;
    const float fl0 = fminf(f0, 0.f) - log1pf(expf(-fabsf(f0))), fl1 = fminf(f1, 0.f) - log1pf(expf(-fabsf(f1)));
    float sc = fl0 + fl1;
#pragma unroll
    for (int o = 1; o < 64; o <<= 1) { const float t = __shfl_up(sc, o); if (lane >= o) sc += t; }
    const float bc1 = sc, bc0 = sc - fl1;
    const float g0 = i0 - bc0, g1 = i1 - bc1;
    float p = fmaxf(g0, g1);
#pragma unroll
    for (int o = 1; o < 64; o <<= 1) { const float t = __shfl_up(p, o); if (lane >= o) p = fmaxf(p, t); }
    float pprev = __shfl_up(p, 1); if (lane == 0) pprev = -INFINITY;
    gk[2 * lane] = g0; gk[2 * lane + 1] = g1; bc[2 * lane] = bc0; bc[2 * lane + 1] = bc1; pm[2 * lane] = fmaxf(pprev, g0); pm[2 * lane + 1] = p;
    bend = __shfl(bc1, 63); gmax = __shfl(p, 63);
}
template <int l>
__device__ __forceinline__ void mlstm_part1(const Core& C, const Frame& F0, int unit) {
    const Frame F = fresh_frame(F0);
    const h16* Z = (const h16*)(C.ws + WS_Z); const float* par = (const float*)(C.ws + WS_PAR);
    h16* DC = (h16*)(C.ws + WS_MLC); float* DN = (float*)(C.ws + WS_MLN);
    const int bh = unit >> 4, c = unit & 15, b = bh >> 2, h = bh & 3, lane = F.lane, w = F.wave, tid = F.tid, qi = lane & 31, hh = lane >> 5;
    const int u15 = bh * 15 + c;
    float* GA = (float*)(C.ws + WS_MLG) + (size_t)unit * MLG_STRIDE;
    LAS h16* Kt = (LAS h16*)(F.lds + ML_K); LAS h16* KWt = (LAS h16*)(F.lds + ML_KW); LAS h16* Vt = (LAS h16*)(F.lds + ML_V);
    LAS float* gk = (LAS float*)(F.lds + ML_F); LAS float* pm = gk + 128; LAS float* bc = gk + 256; LAS float* scal = gk + 448;
    const int tokc = b * SEQ + 128 * c;
    h16 gz[4];
    if (w == 7) ml_gate_load(Z, tokc, h, lane, gz);
    if (c < 15) {
    const int r0 = tid >> 3, c8 = tid & 7;
    const h16x8 va = *(const h16x8*)(Z + (size_t)(tokc + r0) * ZP + ZC_D + 512 + h * 64 + 8 * c8), vb = *(const h16x8*)(Z + (size_t)(tokc + r0 + 64) * ZP + ZC_D + 512 + h * 64 + 8 * c8);
    ml_conv_load(Z, par + PF_CONVW + l * 4 * 512, par + PF_CONVB + l * 512, b, c, h, false, Kt, Kt, tid);
    *(LAS h16x8*)(Vt + r0 * ML_VP + 8 * c8) = va; *(LAS h16x8*)(Vt + (r0 + 64) * ML_VP + 8 * c8) = vb;
    }
    if (w == 7) { float bend, gmax; ml_gates(gz, par[PF_IGB + l * 4 + h], par[PF_FGB + l * 4 + h], gk, bc, pm, lane, bend, gmax);
        if (lane == 0) { scal[0] = bend; scal[1] = gmax; GA[384] = bend; GA[385] = gmax; } }
    __syncthreads();
    if (tid < 384) GA[tid] = gk[tid];
    if (c == 15) { UNIT_END_BAR(); return; }
    { const float gmax = scal[1];
      for (int it = tid; it < 1024; it += 512) { const int r = it >> 3, c8 = it & 7; const float wk = __builtin_amdgcn_exp2f((gk[r] - gmax) * LOG2E);
        const h16x8 kv = *(const LAS h16x8*)(Kt + r * ML_QP + 8 * c8); h16x8 o;
#pragma unroll
        for (int e = 0; e < 8; ++e) o[e] = (h16)((float)kv[e] * wk);
        *(LAS h16x8*)(KWt + r * ML_VP + 8 * c8) = o; } }
    __syncthreads();
    if (w < 4) {
        const int dkb = w >> 1, dvb = w & 1;
        f32x16 acc;
#pragma unroll
        for (int i = 0; i < 16; ++i) acc[i] = 0.f;
#pragma unroll
        for (int ks = 0; ks < 8; ++ks) { const h16x8 a = tr_frag<true>(KWt, ML_VP, 16 * ks, 32 * dkb, lane), bq = tr_frag<true>(Vt, ML_VP, 16 * ks, 32 * dvb, lane); acc = mfma32(a, bq, acc); }
        u32x2 ov[4];
#pragma unroll
        for (int g = 0; g < 4; ++g) { ov[g].x = pkh(acc[4 * g], acc[4 * g + 1]); ov[g].y = pkh(acc[4 * g + 2], acc[4 * g + 3]); }
        store_row32(DC + (size_t)u15 * 4096 + (32 * dvb + qi) * 64 + 32 * dkb, ov, hh);
    } else if (w == 4) {
        float sacc = 0.f;
#pragma unroll 8
        for (int r = 0; r < 128; ++r) sacc += (float)KWt[r * ML_VP + lane];
        DN[(size_t)u15 * 128 + lane] = sacc;
    }
    UNIT_END_BAR();
}
template <int l>
__device__ __forceinline__ void mlstm_part2(const Core& C, const Frame& F0, int unit) {
    const Frame F = fresh_frame(F0);
    const h16* Z = (const h16*)(C.ws + WS_Z); h16* Y = (h16*)((unsigned char*)C.out + OUT_Y); const float* par = (const float*)(C.ws + WS_PAR);
    const h16* DC = (const h16*)(C.ws + WS_MLC); const float* DN = (const float*)(C.ws + WS_MLN);
    const int bh = unit >> 4, c = unit & 15, b = bh >> 2, h = bh & 3, lane = F.lane, w = F.wave, tid = F.tid, qi = lane & 31, hh = lane >> 5;
    LAS h16* Qt = (LAS h16*)(F.lds + ML_Q); LAS h16* Kt = (LAS h16*)(F.lds + ML_K); LAS h16* Vt = (LAS h16*)(F.lds + ML_V); LAS h16* Cs = (LAS h16*)(F.lds + ML_C);
    LAS float* gk = (LAS float*)(F.lds + ML_F); LAS float* pm = gk + 128; LAS float* bc = gk + 256; LAS float* nvec = gk + 384; LAS float* scal = gk + 448;
    const int tokc = b * SEQ + 128 * c;
    const float* cw = par + PF_CONVW + l * 4 * 512; const float* cb = par + PF_CONVB + l * 512;
    h16x8 dvv[15]; float dnn[15]; h16x4 ogv[4];
    { const int dk = tid >> 3, d8 = tid & 7;
#pragma unroll
      for (int j0 = 0; j0 < 15; j0 += 5) {
          if (j0 < c) {
#pragma unroll
              for (int j = j0; j < j0 + 5; ++j) { const int jj = j < c ? j : c - 1;
                  dvv[j] = *(const h16x8*)(DC + (size_t)(bh * 15 + jj) * 4096 + dk * 64 + 8 * d8); dnn[j] = DN[(size_t)(bh * 15 + jj) * 128 + (tid & 63)]; }
          } else {
#pragma unroll
              for (int j = j0; j < j0 + 5; ++j) { dvv[j] = (h16x8){(h16)0.f, (h16)0.f, (h16)0.f, (h16)0.f, (h16)0.f, (h16)0.f, (h16)0.f, (h16)0.f}; dnn[j] = 0.f; }
          }
      }
      const size_t zo = (size_t)(tokc + 32 * (w >> 1) + qi) * ZP + ZC_D + 768 + h * 64 + 32 * (w & 1) + 4 * hh;
#pragma unroll
      for (int g = 0; g < 4; ++g) ogv[g] = *(const h16x4*)(Z + zo + 8 * g); }
    const int r0v = tid >> 3, c8v = tid & 7;
    const h16x8 va = *(const h16x8*)(Z + (size_t)(tokc + r0v) * ZP + ZC_D + 512 + h * 64 + 8 * c8v), vb = *(const h16x8*)(Z + (size_t)(tokc + r0v + 64) * ZP + ZC_D + 512 + h * 64 + 8 * c8v);
    const float* GAu = (const float*)(C.ws + WS_MLG) + (size_t)unit * MLG_STRIDE;
    const float gav = GAu[tid < 384 ? tid : 383];
    const float* GAb = (const float*)(C.ws + WS_MLG) + (size_t)(bh * 16) * MLG_STRIDE;
    const int jl = lane < 15 ? lane : 14;
    const float be_l = GAb[(size_t)jl * MLG_STRIDE + 384], gm_l = GAb[(size_t)jl * MLG_STRIDE + 385];
    ml_conv_load(Z, cw, cb, b, c, h, true, Qt, Kt, tid);
    *(LAS h16x8*)(Vt + r0v * ML_VP + 8 * c8v) = va; *(LAS h16x8*)(Vt + (r0v + 64) * ML_VP + 8 * c8v) = vb;
    if (tid < 384) gk[tid] = gav;
    if (w == 0) {
        const bool act = lane < c;
        float Bs = act ? be_l : 0.f;
#pragma unroll
        for (int o = 1; o < 16; o <<= 1) { const float t = __shfl_down(Bs, o); if (lane + o < 64) Bs += t; }
        const float cand = act ? gm_l + Bs : -INFINITY;
        float mc = cand;
#pragma unroll
        for (int o = 1; o < 16; o <<= 1) mc = fmaxf(mc, __shfl_xor(mc, o));
        mc = fmaxf(__shfl(mc, 0), __shfl(Bs, 0));
        if (lane < 16) scal[16 + lane] = act ? __builtin_amdgcn_exp2f((cand - mc) * LOG2E) : 0.f;
        if (lane == 0) scal[0] = mc;
    }
    __syncthreads();
    {
        const int dk = tid >> 3, d8 = tid & 7;
        float a8[8];
#pragma unroll
        for (int e = 0; e < 8; ++e) a8[e] = 0.f;
        float nn = 0.f;
#pragma unroll
        for (int j = 0; j < 15; ++j) { const float cf = scal[16 + j];
#pragma unroll
            for (int e = 0; e < 8; ++e) a8[e] += cf * (float)dvv[j][e];
            nn += cf * dnn[j]; }
        h16x8 o;
#pragma unroll
        for (int e = 0; e < 8; ++e) o[e] = (h16)a8[e];
        *(LAS h16x8*)(Cs + dk * ML_QP + 8 * d8) = o;
        if (tid < 64) nvec[tid] = nn;
    }
    __syncthreads();
    {
        const int tb = w >> 1, dvb = w & 1, t = 32 * tb + qi;
        const float mr = scal[0], Mtt = fmaxf(mr, pm[t]), bct = bc[t];
        h16x8 qf[4];
#pragma unroll
        for (int ds = 0; ds < 4; ++ds) qf[ds] = *(const LAS h16x8*)(Qt + t * ML_QP + 16 * ds + 8 * hh);
        f32x16 num, inter; float den = 0.f;
#pragma unroll
        for (int i = 0; i < 16; ++i) { num[i] = 0.f; inter[i] = 0.f; }
#pragma unroll 1
        for (int sb = 0; sb <= tb; ++sb) {
            f32x16 sc;
#pragma unroll
            for (int i = 0; i < 16; ++i) sc[i] = 0.f;
#pragma unroll
            for (int ds = 0; ds < 4; ++ds) { const h16x8 a = *(const LAS h16x8*)(Kt + (32 * sb + qi) * ML_QP + 16 * ds + 8 * hh); sc = mfma32(a, qf[ds], sc); }
            float ps = 0.f;
#pragma unroll
            for (int i = 0; i < 16; ++i) { const int kk = crow(i, hh); const float wgt = __builtin_amdgcn_exp2f((gk[32 * sb + kk] - Mtt) * LOG2E);
                float p = sc[i] * wgt; if (sb == tb && kk > qi) p = 0.f; sc[i] = p; ps += p; }
            den += ps;
            h16x8 pf[2];
#pragma unroll
            for (int s2 = 0; s2 < 2; ++s2)
#pragma unroll
                for (int j = 0; j < 8; ++j) pf[s2][j] = (h16)sc[8 * s2 + j];
#pragma unroll
            for (int s2 = 0; s2 < 2; ++s2) { const h16x8 a = tr_frag<false>(Vt + 32 * sb * ML_VP, ML_VP, 16 * s2, 32 * dvb, lane); num = mfma32(a, pf[s2], num); }
        }
        float dq = 0.f;
#pragma unroll
        for (int ks = 0; ks < 4; ++ks) { const h16x8 a = *(const LAS h16x8*)(Cs + (32 * dvb + qi) * ML_QP + 16 * ks + 8 * hh); inter = mfma32(a, qf[ks], inter);
#pragma unroll
            for (int j = 0; j < 8; ++j) dq += (float)qf[ks][j] * nvec[16 * ks + 8 * hh + j]; }
        den += __shfl_xor(den, 32); dq += __shfl_xor(dq, 32);
        const float scl = __builtin_amdgcn_exp2f((mr - Mtt) * LOG2E);
        const float dtot = den + scl * dq;
        const float dnm = fmaxf(fabsf(dtot), __builtin_amdgcn_exp2f(-(bct + Mtt) * LOG2E));
        const float inv = 1.0f / dnm;
        u32x2 ov[4];
#pragma unroll
        for (int g = 0; g < 4; ++g) { const h16x4 og = ogv[g]; float r4[4];
#pragma unroll
            for (int j = 0; j < 4; ++j) { const float hv = (num[4 * g + j] + scl * inter[4 * g + j]) * inv; r4[j] = hv * __builtin_amdgcn_rcpf(1.0f + __builtin_amdgcn_exp2f(-(float)og[j] * LOG2E)); }
            ov[g].x = pkh(r4[0], r4[1]); ov[g].y = pkh(r4[2], r4[3]); }
        store_row32(Y + (size_t)(tokc + t) * DM + 768 + h * 64 + 32 * dvb, ov, hh);
    }
    UNIT_END_BAR();
}


constexpr int UP_PITCH = 200;
constexpr int UP_BUF = 32 * UP_PITCH * 2;
template <int l>
__device__ __forceinline__ void mla_upproj_unit(const Core& C, const Frame& F0, int panel) {
    const Frame F = fresh_frame(F0);
    const h16* Z = (const h16*)(C.ws + WS_Z); const float* rb = (const float*)(C.ws + WS_ROPEB); const float* ssq = (const float*)(C.ws + WS_SSQ);
    const h16* Wq = (const h16*)(C.ws + WS_WUQ) + (size_t)l * 512 * 256; const h16* Wkv = (const h16*)(C.ws + WS_WUKV) + (size_t)l * 512 * 256;
    h16* Qm = (h16*)(C.ws + WS_Q); h16* Kf = (h16*)(C.ws + WS_KF); h16* Kr = (h16*)(C.ws + WS_KR); h16* Vm = (h16*)(C.ws + WS_VM);
    const int lane = F.lane, w = F.wave, tid = F.tid, qi = lane & 31, hh = lane >> 5;
    const size_t row = (size_t)panel * 256 + 32 * w + qi;
    h16x8 aq[12], akv[8];
    { const h16* zr = Z + row * ZP + 8 * hh;
#pragma unroll
      for (int ks = 0; ks < 12; ++ks) aq[ks] = *(const h16x8*)(zr + ZC_CQ + 16 * ks);
#pragma unroll
      for (int ks = 0; ks < 8; ++ks) akv[ks] = *(const h16x8*)(zr + ZC_CKV + 16 * ks); }
    const float rsq = rsqrtf(ssq[(size_t)(2 * l) * M + row] * (1.0f / 192.0f) + RMS_EPS) * pg8::QSCALE96;
    const float rskv = rsqrtf(ssq[(size_t)(2 * l + 1) * M + row] * (1.0f / 128.0f) + RMS_EPS);
    const f32x4 cl = *(const f32x4*)(rb + row * 32 + 4 * hh), ch = *(const f32x4*)(rb + row * 32 + 8 + 4 * hh);
    const f32x4 sl = *(const f32x4*)(rb + row * 32 + 16 + 4 * hh), sh = *(const f32x4*)(rb + row * 32 + 24 + 4 * hh);
    { const h16x8 x1 = *(const h16x8*)(Z + row * ZP + ZC_KR + 8 * hh), x2 = *(const h16x8*)(Z + row * ZP + ZC_KR + 16 + 8 * hh);
      const f32x4 c0 = *(const f32x4*)(rb + row * 32 + 8 * hh), c1 = *(const f32x4*)(rb + row * 32 + 8 * hh + 4), s0 = *(const f32x4*)(rb + row * 32 + 16 + 8 * hh), s1 = *(const f32x4*)(rb + row * 32 + 16 + 8 * hh + 4);
      h16x8 o1, o2;
#pragma unroll
      for (int j = 0; j < 8; ++j) { const float cc = j < 4 ? c0[j & 3] : c1[j & 3], ss = j < 4 ? s0[j & 3] : s1[j & 3], a = (float)x1[j], b = (float)x2[j]; o1[j] = (h16)(a * cc - b * ss); o2[j] = (h16)(a * ss + b * cc); }
#pragma unroll
      for (int hd = 0; hd < 1; ++hd) { *(h16x8*)(Kr + row * 32 + 8 * hh) = o1; *(h16x8*)(Kr + row * 32 + 16 + 8 * hh) = o2; } }
    h16x8 wr[6];
#define UP_LOAD(S_) do { if ((S_) < 3) { _Pragma("unroll") for (int e = 0; e < 6; ++e) { const int ch = tid + 512 * e, rr = ch / 24, cc = ch % 24; wr[e] = *(const h16x8*)(Wq + (size_t)(128 * (S_) + rr) * 256 + 8 * cc); } } \
        else { _Pragma("unroll") for (int e = 0; e < 4; ++e) { const int ch = tid + 512 * e, rr = ch >> 4, cc = ch & 15; wr[e] = *(const h16x8*)(Wkv + (size_t)(128 * ((S_) - 3) + rr) * 256 + 8 * cc); } } } while (0)
#define UP_STORE(S_, buf) do { LAS h16* Wt = (LAS h16*)(F.lds + (buf) * (4 * UP_BUF)); if ((S_) < 3) { _Pragma("unroll") for (int e = 0; e < 6; ++e) { const int ch = tid + 512 * e, rr = ch / 24, cc = ch % 24; *(LAS h16x8*)(Wt + rr * UP_PITCH + 8 * cc) = wr[e]; } } \
        else { _Pragma("unroll") for (int e = 0; e < 4; ++e) { const int ch = tid + 512 * e, rr = ch >> 4, cc = ch & 15; *(LAS h16x8*)(Wt + rr * UP_PITCH + 8 * cc) = wr[e]; } } } while (0)
#define UP_BAR() do { asm volatile("s_waitcnt lgkmcnt(0)" ::: "memory"); __builtin_amdgcn_s_barrier(); asm volatile("" ::: "memory"); } while (0)
    UP_LOAD(0); UP_STORE(0, 0); UP_BAR();
#pragma unroll 1
    for (int S = 0; S < 7; ++S) {
        const int buf = S & 1;
        if (S + 1 < 7) UP_LOAD(S + 1);
#pragma unroll
        for (int sub = 0; sub < 4; ++sub) {
            const int s = (S < 3) ? 4 * S + sub : 12 + 4 * (S - 3) + sub;
            const LAS h16* Wt = (const LAS h16*)(F.lds + buf * (4 * UP_BUF)) + (32 * sub + qi) * UP_PITCH + 8 * hh;
            f32x16 acc;
#pragma unroll
            for (int i = 0; i < 16; ++i) acc[i] = 0.f;
            if (S < 3) {
#pragma unroll
                for (int ks = 0; ks < 12; ++ks) acc = mfma32(*(const LAS h16x8*)(Wt + 16 * ks), aq[ks], acc);
#pragma unroll
                for (int i = 0; i < 16; ++i) acc[i] *= rsq;
                if (s % 3 == 2) {
#pragma unroll
                    for (int i = 0; i < 8; ++i) { const float cc = i < 4 ? cl[i & 3] : ch[i & 3], ss = i < 4 ? sl[i & 3] : sh[i & 3], x1 = acc[i], x2 = acc[i + 8]; acc[i] = x1 * cc - x2 * ss; acc[i + 8] = x1 * ss + x2 * cc; }
                }
            } else {
#pragma unroll
                for (int ks = 0; ks < 8; ++ks) acc = mfma32(*(const LAS h16x8*)(Wt + 16 * ks), akv[ks], acc);
#pragma unroll
                for (int i = 0; i < 16; ++i) acc[i] *= rskv;
            }
            u32x2 ov[4];
#pragma unroll
            for (int g = 0; g < 4; ++g) { ov[g].x = pkh(acc[4 * g], acc[4 * g + 1]); ov[g].y = pkh(acc[4 * g + 2], acc[4 * g + 3]); }
            h16* dst;
            if (S < 3) dst = Qm + row * 384 + 32 * s;
            else { const int nb = s - 12, hd = nb >> 2, part = nb & 3; dst = part < 2 ? Kf + row * 256 + hd * 64 + 32 * part : Vm + row * 256 + hd * 64 + 32 * (part - 2); }
            store_row32(dst, ov, hh);
        }
        if (S + 1 < 7) UP_STORE(S + 1, buf ^ 1);
        UP_BAR();
    }
#undef UP_LOAD
#undef UP_STORE
#undef UP_BAR
}

#ifndef STAGGER_TICKS
#define STAGGER_TICKS 0
#endif
__device__ __forceinline__ void stagger_start() {
    if (STAGGER_TICKS > 0) { const unsigned long long t0 = __builtin_amdgcn_s_memrealtime(); const unsigned long long d = (unsigned long long)blockIdx.x * STAGGER_TICKS / gridDim.x;
        while (__builtin_amdgcn_s_memrealtime() - t0 < d) __builtin_amdgcn_s_sleep(8); }
}

template <int l>
__device__ __forceinline__ void layer_body(const Core& C, const Frame& F, const XcdBarrier& bar, const int lo, const int hi, const int use_bar) {
#define IN(k) (lo <= (k) && (k) < hi)
#define SEAM(k) do { if (use_bar && IN(k) && IN((k) + 1)) { xcd_barrier(bar); if (DUP_MASK & 4194304) xcd_barrier(bar); } } while (0)
    h16* V16 = (h16*)(C.ws + WS_V16); h16* Z = (h16*)(C.ws + WS_Z); h16* Hb = (h16*)(C.ws + WS_Z); h16* Y = (h16*)((unsigned char*)C.out + OUT_Y);
    float* c12 = (float*)(C.ws + WS_C12); float* stats = (float*)(C.ws + WS_STATS); float* ssq = (float*)(C.ws + WS_SSQ); const float* par = (const float*)(C.ws + WS_PAR);
    {
        const int pb = 1 + 6 * l;
        float* st_ln1 = stats + (size_t)(2 * l) * 2 * M; float* st_ln2 = stats + (size_t)(2 * l + 1) * 2 * M;
        const float* st_prev = l ? stats + (size_t)(2 * l - 1) * 2 * M : nullptr;
        if (IN(pb) && EN_P1) {
            pg8::Gemm g{V16, (const h16*)(C.ws + WS_WIN) + (size_t)l * ZP * DM, DM, DM, M, ZP, DM};
            pg8::StaticOrder S; S.init(M, ZP, F.G, (int)blockIdx.x);
            stagger_start();
            pg8::EpiIn E{Z, c12 + C1IN + l * ZP, c12 + C2IN + l * ZP, pg8::RowStats{st_prev, st_prev ? st_prev + M : nullptr}, l == 0 ? 1 : 0, ssq + (size_t)(2 * l) * M, ssq + (size_t)(2 * l + 1) * M, -1, (const h16*)(C.ws + WS_ROPEC)};
            pg8::gemm_phase(F.lds, F.wave, g, S, E);
            if (DUP_MASK & 1) { float* dums = (float*)(C.ws + WS_DUMS); pg8::EpiIn E2{(DUP_MASK & 65536) ? (h16*)(C.ws + WS_DUMV) : Z, c12 + C1IN + l * ZP, c12 + C2IN + l * ZP, pg8::RowStats{st_prev, st_prev ? st_prev + M : nullptr}, (DUP_MASK & 262144) ? 1 : (l == 0 ? 1 : 0), dums, dums + M, (DUP_MASK & 65536) ? 255 : -1, (const h16*)(C.ws + WS_ROPEC)};
                __syncthreads(); pg8::gemm_phase(F.lds, F.wave, g, S, E2); }
            if (DUP_MASK & 16384) { pg8::EpiNull EN; __syncthreads(); pg8::gemm_phase(F.lds, F.wave, g, S, EN); }
            if (DUP_MASK & 8388608) { pg8::EpiNull EN; pg8::FixedOrder SF{S}; __syncthreads(); pg8::gemm_phase(F.lds, F.wave, g, SF, EN); }
        }
        SEAM(pb);
        if (IN(pb + 1)) for (int rep = 0; rep < ((DUP_MASK & 2) ? 2 : 1); ++rep) {
            if (ZERO_FROM < DM) { const Frame Fz = fresh_frame(F); const size_t gt = (size_t)blockIdx.x * 512 + Fz.tid, NT = (size_t)F.G * 512; constexpr int ZW = (DM - ZERO_FROM) / 8 > 0 ? (DM - ZERO_FROM) / 8 : 1;
            for (size_t i = gt; i < (size_t)M * (DM - ZERO_FROM) / 8; i += NT) { const size_t r = i / ZW, c = i % ZW; *(u32x4*)(Y + r * DM + ZERO_FROM + c * 8) = (u32x4){0u, 0u, 0u, 0u}; } }
            if (EN_D) for (int r2 = 0; r2 < ((DUP_MASK & 64) ? 2 : 1); ++r2) { int bh, r; for (int it = 0; bh_unit(it, 16, F.G, bh, r); ++it) mlstm_part1<l>(C, F, bh * 16 + r); }
            if (EN_A) for (int r2 = 0; r2 < ((DUP_MASK & 128) ? 2 : 1); ++r2) for (int u = blockIdx.x; u < NB * 16; u += F.G) gmlp_unit<l>(C, F, u);
            if (EN_C) dilated_phase<l>(C, F);
            if (EN_B && EN_B1) for (int r2 = 0; r2 < ((DUP_MASK & 512) ? 2 : 1); ++r2) {
                for (int u = blockIdx.x; u < M / 256; u += F.G) mla_upproj_unit<l>(C, F, u);
                __syncthreads();
            }
        }
        SEAM(pb + 1);
        if (IN(pb + 2)) for (int rep = 0; rep < ((DUP_MASK & 4) ? 2 : 1); ++rep) { if (EN_C) for (int r2 = 0; r2 < ((DUP_MASK & 1024) ? 2 : 1); ++r2) dil_combine(C, F); if (EN_B && EN_B2) { { int bh, r; for (int it = 0; bh_unit(it, 2, F.G, bh, r); ++it) mla_unit2<0>(C, F, bh * 2 + r, Y); }
                if (DUP_MASK & 2048) for (int u = blockIdx.x; u < 512; u += F.G) mla_unit<0>(C, F, u, (h16*)(C.ws + WS_DUMV));
                if (DUP_MASK & 131072) for (int u = blockIdx.x; u < 512; u += F.G) mla_unit<1>(C, F, u, (h16*)(C.ws + WS_DUMV)); }
            if (EN_D) for (int r2 = 0; r2 < ((DUP_MASK & 4096) ? 2 : 1); ++r2) { int bh, r; for (int it = 0; bh_unit(it, 16, F.G, bh, r); ++it) mlstm_part2<l>(C, F, bh * 16 + r); } }
        SEAM(pb + 2);
        if (IN(pb + 3) && EN_P3) {
            { const Frame Fs = fresh_frame(F); LAS float* gl = (LAS float*)(F.lds + RING_BYTES); for (int i = Fs.tid; i < DM; i += 512) { gl[i] = (par + PF_LN2G + (l ? l - 1 : 0) * DM)[i]; gl[DM + i] = (par + PF_LN2B + (l ? l - 1 : 0) * DM)[i]; } __syncthreads(); }
            pg8::Gemm g{Y, (const h16*)(C.ws + WS_WOUT) + (size_t)l * DM * DM, DM, DM, M, DM, DM};
            pg8::StaticOrder S; S.init(M, DM, F.G, (int)blockIdx.x);
            if (DUP_MASK & 8) { float* dums = (float*)(C.ws + WS_DUMS); pg8::EpiRes E2{V16, (h16*)(C.ws + WS_DUMV), l == 0 ? 1 : 0, pg8::RowStats{st_prev, st_prev ? st_prev + M : nullptr}, (const LAS float*)(F.lds + RING_BYTES), (const LAS float*)(F.lds + RING_BYTES) + DM, dums, dums + M};
                pg8::gemm_phase(F.lds, F.wave, g, S, E2); __syncthreads(); }
            stagger_start();
            if (DUP_MASK & 32768) { pg8::EpiNull EN; pg8::gemm_phase(F.lds, F.wave, g, S, EN); __syncthreads(); }
            pg8::EpiRes E{V16, V16, l == 0 ? 1 : 0, pg8::RowStats{st_prev, st_prev ? st_prev + M : nullptr}, (const LAS float*)(F.lds + RING_BYTES), (const LAS float*)(F.lds + RING_BYTES) + DM, st_ln1, st_ln1 + M};
            pg8::gemm_phase(F.lds, F.wave, g, S, E);
        }
        SEAM(pb + 3);
        if (IN(pb + 4) && EN_P4) {
            pg8::Gemm g{V16, (const h16*)(C.ws + WS_WGU) + (size_t)l * GU * DM, DM, DM, M, GU, DM};
            pg8::StaticOrder S; S.init(M, GU, F.G, (int)blockIdx.x);
            stagger_start();
            pg8::EpiGU E{Hb, c12 + C1GU + l * GU, c12 + C2GU + l * GU, pg8::RowStats{st_ln1, st_ln1 + M}};
            pg8::gemm_phase(F.lds, F.wave, g, S, E);
            if (DUP_MASK & 16) { __syncthreads(); pg8::gemm_phase(F.lds, F.wave, g, S, E); }
        }
        SEAM(pb + 4);
        if (IN(pb + 5) && EN_P5) {
            { const Frame Fs = fresh_frame(F); LAS float* gl = (LAS float*)(F.lds + RING_BYTES); for (int i = Fs.tid; i < DM; i += 512) { gl[i] = (par + PF_LN1G + l * DM)[i]; gl[DM + i] = (par + PF_LN1B + l * DM)[i]; } __syncthreads(); }
            pg8::Gemm g{Hb, (const h16*)(C.ws + WS_WDOWN) + (size_t)l * DM * FF, FF, FF, M, DM, FF};
            pg8::StaticOrder S; S.init(M, DM, F.G, (int)blockIdx.x);
            stagger_start();
            if (DUP_MASK & 32) { float* dums = (float*)(C.ws + WS_DUMS); pg8::EpiRes E2{V16, (h16*)(C.ws + WS_DUMV), 0, pg8::RowStats{st_ln1, st_ln1 + M}, (const LAS float*)(F.lds + RING_BYTES), (const LAS float*)(F.lds + RING_BYTES) + DM, dums, dums + M};
                pg8::gemm_phase(F.lds, F.wave, g, S, E2); __syncthreads(); }
            pg8::EpiRes E{V16, V16, 0, pg8::RowStats{st_ln1, st_ln1 + M}, (const LAS float*)(F.lds + RING_BYTES), (const LAS float*)(F.lds + RING_BYTES) + DM, st_ln2, st_ln2 + M};
            pg8::gemm_phase(F.lds, F.wave, g, S, E);
        }
        SEAM(pb + 5);
        }
#undef IN
#undef SEAM
}
constexpr int N_PHASES = 2 + 6 * DEPTH;
__global__ void __launch_bounds__(512, 2) fwd_kernel(Args a) {
    extern __shared__ __attribute__((aligned(16))) unsigned char lds_raw[];
    Frame F; F.lds = (LAS unsigned char*)lds_raw; F.tid = threadIdx.x; F.lane = F.tid & 63; F.wave = __builtin_amdgcn_readfirstlane(F.tid >> 6); F.G = gridDim.x;
    volatile LAS unsigned* MISC = (volatile LAS unsigned*)(F.lds + MISC_OFF);
    if (F.tid < 64) MISC[F.tid] = 0u;
    __syncthreads();
    unsigned* ctl = (unsigned*)(a.ws + WS_ZERO);
    XcdBarrier bar; bar.bar = ctl + CW_BAR; bar.x = 0; bar.st = nullptr; bar.wave = F.wave;
    if (a.use_bar) bar = xcd_barrier_post(ctl + CW_BAR, MISC + 8, F.wave);
    const int lo = a.ph_lo, hi = a.ph_hi;
#define IN(k) (lo <= (k) && (k) < hi)
#define SEAM(k) do { if (a.use_bar && IN(k) && IN((k) + 1)) xcd_barrier(bar); } while (0)
    const Core C{a.out, a.ws};

    if (IN(0) && EN_P0) { if (DUP_MASK & 8192) { p0_prologue(a, F, (float*)(a.ws + WS_DUMS)); __syncthreads(); } p0_prologue(a, F, (float*)(a.ws + WS_C12)); }
    SEAM(0);
    if (LOOP_START <= 0 && 0 < LOOP_DEPTH) layer_body<0>(C, F, bar, lo, hi, a.use_bar);
    if (LOOP_START <= 1 && 1 < LOOP_DEPTH) layer_body<1>(C, F, bar, lo, hi, a.use_bar);
    if (LOOP_START <= 2 && 2 < LOOP_DEPTH) layer_body<2>(C, F, bar, lo, hi, a.use_bar);
    if (LOOP_START <= 3 && 3 < LOOP_DEPTH) layer_body<3>(C, F, bar, lo, hi, a.use_bar);
    if (IN(N_PHASES - 1) && EN_PF) final_ln(C, F);
#undef IN
#undef SEAM
}

#ifndef MK_PER_PHASE
#define MK_PER_PHASE 0
#endif
extern "C" void kernel_launch(void* const* d_in, const int* in_sizes, int n_in, void* d_out, int out_size, void* d_ws, size_t ws_size, hipStream_t stream) {
    static int grid = 0;
    if (grid == 0) {
        if (n_in != 23 || out_size != M * DM || ws_size < WS_END) { fprintf(stderr, "kernel_launch: unexpected shapes n_in %d out %d ws %zu\n", n_in, out_size, ws_size); grid = -1; return; }
        int dev = 0, cus = 0;
        if (hipGetDevice(&dev) != hipSuccess || hipDeviceGetAttribute(&cus, hipDeviceAttributeMultiprocessorCount, dev) != hipSuccess) { grid = -1; return; }
        if (hipFuncSetAttribute((const void*)fwd_kernel, hipFuncAttributeMaxDynamicSharedMemorySize, LDS_BYTES) != hipSuccess) { fprintf(stderr, "kernel_launch: hipFuncSetAttribute failed\n"); grid = -1; return; }
        int per_cu = 0;
        if (hipOccupancyMaxActiveBlocksPerMultiprocessor(&per_cu, (const void*)fwd_kernel, 512, LDS_BYTES) != hipSuccess || per_cu < 1) fprintf(stderr, "kernel_launch: occupancy query says %d\n", per_cu);
        (void)hipGetLastError();
        grid = cus;
    }
    if (grid < 0) return;
    (void)hipMemsetAsync((char*)d_ws + WS_ZERO, 0, ZERO_BYTES, stream);
    Args a{};
    a.x = (const float*)d_in[0]; a.pos = (const int*)d_in[1]; a.w_in = (const float*)d_in[2]; a.a_ln_g = (const float*)d_in[3]; a.a_ln_b = (const float*)d_in[4];
    a.a_ws = (const float*)d_in[5]; a.a_bs = (const float*)d_in[6]; a.b_q_norm = (const float*)d_in[7]; a.b_kv_norm = (const float*)d_in[8];
    a.b_w_uq = (const float*)d_in[9]; a.b_w_ukv = (const float*)d_in[10]; a.d_conv_w = (const float*)d_in[11]; a.d_conv_b = (const float*)d_in[12];
    a.d_igate_b = (const float*)d_in[13]; a.d_fgate_b = (const float*)d_in[14]; a.w_out = (const float*)d_in[15]; a.ln1_g = (const float*)d_in[16]; a.ln1_b = (const float*)d_in[17];
    a.w_gate = (const float*)d_in[18]; a.w_up = (const float*)d_in[19]; a.w_down = (const float*)d_in[20]; a.ln2_g = (const float*)d_in[21]; a.ln2_b = (const float*)d_in[22];
    a.out = (float*)d_out; a.ws = (unsigned char*)d_ws; a.pad = 0;
#if MK_PER_PHASE
    a.use_bar = 0;
    for (int p = 0; p < N_PHASES; ++p) { a.ph_lo = p; a.ph_hi = p + 1; hipLaunchKernelGGL(fwd_kernel, dim3(grid), dim3(512), LDS_BYTES, stream, a); }
#else
    a.use_bar = 1; a.ph_lo = 0; a.ph_hi = N_PHASES;
    hipLaunchKernelGGL(fwd_kernel, dim3(grid), dim3(512), LDS_BYTES, stream, a);
#endif
}
```

```cpp
#include <hip/hip_runtime.h>
#include <cstdio>
#include <cstdint>

#ifndef DUP_MASK
#define DUP_MASK 0
#endif
#define LAS __attribute__((address_space(3)))
#define GAS __attribute__((address_space(1)))
typedef _Float16 h16;
typedef _Float16 h16x8 __attribute__((ext_vector_type(8)));
typedef _Float16 h16x4 __attribute__((ext_vector_type(4)));
typedef _Float16 h16x2 __attribute__((ext_vector_type(2)));
typedef float f32x2 __attribute__((ext_vector_type(2)));
typedef float f32x4 __attribute__((ext_vector_type(4)));
typedef float f32x16 __attribute__((ext_vector_type(16)));
typedef unsigned u32x2 __attribute__((ext_vector_type(2)));
typedef unsigned u32x4 __attribute__((ext_vector_type(4)));

constexpr int NB = 32, SEQ = 2048, DM = 1024, DEPTH = 4;
constexpr int M = NB * SEQ;
constexpr int IN_COLS = 2664, ZP = 2816;
constexpr int FF = 2816, GU = 2 * FF;
constexpr int GW = 256;
constexpr float LN_EPS = 1e-5f, RMS_EPS = 1e-6f;
constexpr float ALPHA = 1.681792830507429f;
constexpr int ZC_A = 0;
constexpr int ZC_CQ = 512;
constexpr int ZC_CKV = 768;
constexpr int ZC_KR = 896;
constexpr int ZC_GATE = 928;
constexpr int ZC_C = 1024;
constexpr int ZC_D = 1792;
__host__ __device__ __forceinline__ int in_src(int n) {
    if (n < 704) return n;
    if (n < 768) return -1;
    if (n < 928) return n - 768 + 704;
    if (n < 936) return n - 928 + 2656;
    if (n < 1024) return -1;
    if (n < 1536) {
        const int t = (n - 1024) >> 8, c = (n - 1024) & 255, cc = c & 127;
        return 864 + t * 256 + (cc >> 5) * 64 + (c >> 7) * 32 + (cc & 31); }
    if (n < 1792) return n - 1024 + 864;
    return n - 1792 + 1632;
}

constexpr size_t MiB = 1u << 20;
constexpr size_t WS_ZERO = 0, ZERO_BYTES = 8 * MiB;
constexpr size_t WS_C12 = 1 * MiB;
constexpr size_t WS_STATS = 2 * MiB;
constexpr size_t WS_SSQ = 6 * MiB;
constexpr size_t WS_WIN = 8 * MiB, WS_WOUT = 30 * MiB, WS_WGU = 38 * MiB, WS_WDOWN = 82 * MiB, WS_WUQ = 104 * MiB, WS_WUKV = 105 * MiB;
constexpr size_t WS_ROPEB = 106 * MiB, WS_ROPEC = 114 * MiB;
constexpr size_t WS_V16 = 130 * MiB, WS_Z = 258 * MiB, WS_Q = 610 * MiB, WS_KF = 658 * MiB, WS_KR = 698 * MiB, WS_VM = 706 * MiB, WS_PAR = 738 * MiB, WS_AWS = 739 * MiB, WS_MLC = 740 * MiB, WS_MLN = 756 * MiB, WS_MLG = 758 * MiB, WS_DUMV = 762 * MiB, WS_DUMS = 890 * MiB, WS_END = (DUP_MASK ? 892 : 762) * MiB;
constexpr int PF_LN1G = 0, PF_LN1B = 4096, PF_LN2G = 8192, PF_LN2B = 12288, PF_ALNG = 16384, PF_ALNB = 17408, PF_ABS = 18432, PF_CONVW = 20480, PF_CONVB = 28672, PF_IGB = 30720, PF_FGB = 30736, PF_END = 30752;
constexpr size_t OUT_Y = 0, OUT_DP = 128 * MiB, OUT_DL = 224 * MiB;
constexpr int C1IN = 0, C2IN = 4 * ZP, C1GU = 8 * ZP, C2GU = 8 * ZP + 4 * GU;
constexpr int CW_TMO = 0, CW_CODE = 1, CW_BAR = 4096, CW_QUEUE = 8192;

constexpr int RING_BYTES = 131072;
constexpr int LDS_BYTES = 163840;
constexpr int MISC_OFF = LDS_BYTES - 256;

__device__ __forceinline__ unsigned pkh(float lo, float hi) { h16x2 v = {(h16)lo, (h16)hi}; return __builtin_bit_cast(unsigned, v); }
__device__ __forceinline__ float wave_sum(float v) {
    v += __builtin_bit_cast(float, __builtin_amdgcn_update_dpp(0, __builtin_bit_cast(int, v), 0xB1, 0xF, 0xF, true));
    v += __builtin_bit_cast(float, __builtin_amdgcn_update_dpp(0, __builtin_bit_cast(int, v), 0x4E, 0xF, 0xF, true));
    v += __builtin_bit_cast(float, __builtin_amdgcn_update_dpp(0, __builtin_bit_cast(int, v), 0x141, 0xF, 0xF, true));
    v += __builtin_bit_cast(float, __builtin_amdgcn_update_dpp(0, __builtin_bit_cast(int, v), 0x140, 0xF, 0xF, true));
    const int vi = __builtin_bit_cast(int, v);
    return (__builtin_bit_cast(float, __builtin_amdgcn_readlane(vi, 0)) + __builtin_bit_cast(float, __builtin_amdgcn_readlane(vi, 16)))
         + (__builtin_bit_cast(float, __builtin_amdgcn_readlane(vi, 32)) + __builtin_bit_cast(float, __builtin_amdgcn_readlane(vi, 48)));
}
__device__ __forceinline__ void atomic_addf(float* p, float v) { __hip_atomic_fetch_add(p, v, __ATOMIC_RELAXED, __HIP_MEMORY_SCOPE_AGENT); }

namespace pg8 {
constexpr float DIL_QSCALE = 0.125f * 1.4426950408889634f;
constexpr int BM = 256, BK = 64, HALF = 128, HTB = HALF * BK * 2, STAGE_BYTES = 8 * HTB, NXCD = 8, WGM = 8;
__host__ __device__ __forceinline__ int lds_byte(int r, int c) { const int st = (r >> 4) * 2 + (c >> 5), rr = r & 15, cc = c & 31, ob = rr * 64 + cc * 2; return st * 1024 + (ob ^ (((ob >> 9) & 1) << 5)); }
__host__ __device__ __forceinline__ void stage_rc(int b, int& R, int& C) { const int st = b / 1024, sb = b % 1024, swz = sb ^ (((sb >> 9) & 1) << 5); R = (st >> 1) * 16 + swz / 64; C = (st & 1) * 32 + (swz % 64) / 2; }
__host__ __device__ __forceinline__ int perm32(int rho) { const int n = rho >> 4, i = rho & 15; return 8 * (i >> 2) + 4 * n + (i & 3); }

struct Unit { int pm, pn; };
struct Gemm { const h16* A; const h16* Bt; int lda, ldb, M, N, K; };

struct StaticOrder {
    int nM, nN, nwg, G, c;
    __host__ __device__ void init(int M_, int N_, int G_, int c_) { nM = M_ / BM; nN = N_ / BM; nwg = nM * nN; G = G_; c = c_; }
    __host__ __device__ bool next(int i, Unit& u) const {
        const long L = (long)i * G + c; if (L >= nwg) return false;
        int wgid = (int)L; { const int q = nwg / NXCD, r = nwg % NXCD, xcd = wgid % NXCD, off = wgid / NXCD; wgid = (xcd < r ? xcd * (q + 1) : r * (q + 1) + (xcd - r) * q) + off; }
        const int nig = WGM * nN, gid = wgid / nig, fm = gid * WGM, gsz = (nM - fm) < WGM ? (nM - fm) : WGM;
        u.pm = fm + ((wgid % nig) % gsz); u.pn = (wgid % nig) / gsz; return true;
    }
};

struct FixedOrder { StaticOrder S; __host__ __device__ bool next(int i, Unit& u) const { const bool ok = S.next(i, u); u.pm = (int)(blockIdx.x & 7); u.pn = (int)((blockIdx.x >> 3) & 3); return ok; } };
template <class Epi, class Sched>
__device__ __forceinline__ void gemm_phase(LAS unsigned char* lds, const int wid, const Gemm g, const Sched& S, const Epi& E) {
    int lane = __builtin_amdgcn_mbcnt_hi(~0u, __builtin_amdgcn_mbcnt_lo(~0u, 0u)); asm volatile("" : "+v"(lane));
    const int tid = wid * 64 + lane, wr = wid >> 2, wc = wid & 3, fr = lane & 15, fq = lane >> 4;
    const int K = g.K, nt = K / BK;
    unsigned voffA[2], voffB[2];
#pragma unroll
    for (int i = 0; i < 2; ++i) { int R, C; stage_rc(tid * 16 + i * 8192, R, C); const int Rb = Epi::PERM ? ((R & ~31) + perm32(R & 31)) : R;
        voffA[i] = (unsigned)(R * g.lda + C) * 2u; voffB[i] = (unsigned)(Rb * g.ldb + C) * 2u; }
    const size_t kstep = (size_t)(BK * 2);
    const size_t hstepA = (size_t)HALF * g.lda * 2, hstepB = (size_t)HALF * g.ldb * 2;
    const size_t tstepA = 2 * hstepA, tstepB = 2 * hstepB;
    const unsigned ldsw = (unsigned)wid * 1024u;
    const int aoff = lds_byte(wr * 64 + fr, fq * 8), boff = lds_byte(wc * 32 + fr, fq * 8);
#define PG8_SA(b, h) (((b) * 2 + (h)) * HTB)
#define PG8_SB(b, h) ((4 + (b) * 2 + (h)) * HTB)
#define PG8_STAGE(bufoff, gbase, voff) do { _Pragma("unroll") for (int _i = 0; _i < 2; ++_i) \
        __builtin_amdgcn_global_load_lds((const unsigned*)((const char*)(gbase) + (voff)[_i]), (LAS unsigned*)(lds + (bufoff) + ldsw + _i * 8192), 16, 0, 0); } while (0)
#define PG8_LDA(dst, b, h) do { _Pragma("unroll") for (int m = 0; m < 4; ++m) _Pragma("unroll") for (int k = 0; k < 2; ++k) dst[m][k] = *(const LAS h16x8*)(lds + PG8_SA(b, h) + aoff + m * 2048 + k * 1024); } while (0)
#define PG8_LDB(dst, b, h) do { _Pragma("unroll") for (int n = 0; n < 2; ++n) _Pragma("unroll") for (int k = 0; k < 2; ++k) dst[n][k] = *(const LAS h16x8*)(lds + PG8_SB(b, h) + boff + n * 2048 + k * 1024); } while (0)
#define PG8_MMA(ai, bj, At, Bt) do { __builtin_amdgcn_s_setprio(1); _Pragma("unroll") for (int m = 0; m < 4; ++m) _Pragma("unroll") for (int n = 0; n < 2; ++n) _Pragma("unroll") for (int k = 0; k < 2; ++k) \
        acc[ai][bj][m][n] = __builtin_amdgcn_mfma_f32_16x16x32_f16(Bt[n][k], At[m][k], acc[ai][bj][m][n], 0, 0, 0); __builtin_amdgcn_s_setprio(0); } while (0)
#define PG8_WAIT_V(n) asm volatile("s_waitcnt vmcnt(" #n ")" ::: "memory")
#define PG8_WAIT_L(n) asm volatile("s_waitcnt lgkmcnt(" #n ")" ::: "memory")
#define PG8_BAR __builtin_amdgcn_s_barrier()
#define PG8_SCHED __builtin_amdgcn_sched_barrier(0)
    Unit cur, nxt; int ui = 0;
    if (!S.next(0, cur)) return;
    f32x4 acc[2][2][4][2];
#pragma unroll
    for (int a = 0; a < 2; ++a)
#pragma unroll
        for (int b = 0; b < 2; ++b)
#pragma unroll
            for (int m = 0; m < 4; ++m)
#pragma unroll
                for (int n = 0; n < 2; ++n) acc[a][b][m][n] = (f32x4){0.f, 0.f, 0.f, 0.f};
    h16x8 At[4][2], B0[2][2], B1[2][2];
    const char* cA = (const char*)g.A + (size_t)cur.pm * tstepA; const char* cB = (const char*)g.Bt + (size_t)cur.pn * tstepB;
    PG8_STAGE(PG8_SB(0, 0), cB, voffB); PG8_STAGE(PG8_SB(0, 1), cB + hstepB, voffB); PG8_STAGE(PG8_SA(0, 0), cA, voffA); PG8_STAGE(PG8_SA(0, 1), cA + hstepA, voffA);
    if (wr == 1) PG8_BAR;
    PG8_WAIT_V(2); PG8_BAR;
    PG8_STAGE(PG8_SB(1, 0), cB + kstep, voffB); PG8_STAGE(PG8_SA(1, 0), cA + kstep, voffA); PG8_STAGE(PG8_SB(1, 1), cB + hstepB + kstep, voffB);
    PG8_WAIT_V(6); PG8_BAR;
    for (;;) {
        const bool has_next = S.next(ui + 1, nxt);
        const char* nA = has_next ? (const char*)g.A + (size_t)nxt.pm * tstepA : cA; const char* nB = has_next ? (const char*)g.Bt + (size_t)nxt.pn * tstepB : cB;
#pragma unroll 1
        for (int t = 0; t < nt; t += 2) {
            const bool last = (t == nt - 2);
            const char* a1 = cA + (size_t)(t + 1) * kstep;
            const char* a2 = last ? nA : cA + (size_t)(t + 2) * kstep; const char* b2 = last ? nB : cB + (size_t)(t + 2) * kstep;
            const char* a3 = a2 + kstep; const char* b3 = b2 + kstep;
            PG8_LDB(B0, 0, 0); PG8_LDB(B1, 0, 1); PG8_SCHED; PG8_LDA(At, 0, 0); PG8_STAGE(PG8_SA(1, 1), a1 + hstepA, voffA);
            PG8_WAIT_V(8); PG8_WAIT_L(0); PG8_BAR; PG8_MMA(0, 0, At, B0); PG8_MMA(0, 1, At, B1); PG8_BAR; PG8_SCHED;
            PG8_LDA(At, 0, 1); PG8_STAGE(PG8_SB(0, 0), b2, voffB); PG8_STAGE(PG8_SB(0, 1), b2 + hstepB, voffB); PG8_STAGE(PG8_SA(0, 0), a2, voffA);
            PG8_WAIT_V(8); PG8_WAIT_L(0); PG8_BAR; PG8_MMA(1, 0, At, B0); PG8_MMA(1, 1, At, B1); PG8_BAR; PG8_SCHED;
            PG8_LDB(B0, 1, 0); PG8_LDB(B1, 1, 1); PG8_SCHED; PG8_LDA(At, 1, 0); PG8_STAGE(PG8_SA(0, 1), a2 + hstepA, voffA);
            PG8_WAIT_V(8); PG8_WAIT_L(0); PG8_BAR; PG8_MMA(0, 0, At, B0); PG8_MMA(0, 1, At, B1); PG8_BAR; PG8_SCHED;
            PG8_LDA(At, 1, 1); PG8_STAGE(PG8_SB(1, 0), b3, voffB); PG8_STAGE(PG8_SB(1, 1), b3 + hstepB, voffB); PG8_STAGE(PG8_SA(1, 0), a3, voffA);
            PG8_WAIT_V(8); PG8_WAIT_L(0); PG8_BAR; PG8_MMA(1, 0, At, B0); PG8_MMA(1, 1, At, B1); PG8_BAR; PG8_SCHED;
        }
        if (wr == 0) PG8_BAR;
        E(acc, cur, wr, wc, fr, fq);
        if (!has_next) break;
#pragma unroll
        for (int a = 0; a < 2; ++a)
#pragma unroll
            for (int b = 0; b < 2; ++b)
#pragma unroll
                for (int m = 0; m < 4; ++m)
#pragma unroll
                    for (int n = 0; n < 2; ++n) acc[a][b][m][n] = (f32x4){0.f, 0.f, 0.f, 0.f};
        cur = nxt; cA = nA; cB = nB; ++ui;
        if (wr == 1) PG8_BAR;
    }
    PG8_WAIT_V(0);
    PG8_BAR;
#undef PG8_SA
#undef PG8_SB
#undef PG8_STAGE
#undef PG8_LDA
#undef PG8_LDB
#undef PG8_MMA
#undef PG8_WAIT_V
#undef PG8_WAIT_L
#undef PG8_BAR
#undef PG8_SCHED
}

struct RowStats { const float* s1; const float* s2; };
__device__ __forceinline__ void row_mu_rs(const RowStats& st, int r, float& mu, float& rs) {
    const float a = st.s1[r], b = st.s2[r];
    mu = a * (1.0f / DM); const float var = fmaxf(b * (1.0f / DM) - mu * mu, 0.f); rs = rsqrtf(var + LN_EPS);
}

struct EpiIn {
    static constexpr bool PERM = true;
    h16* Z; const float* c1; const float* c2; RowStats st; int ident; float* ssq_q; float* ssq_kv; int rmask; const h16* rope;
    __device__ __forceinline__ void operator()(const f32x4 (&acc)[2][2][4][2], const Unit& u, int wr, int wc, int fr, int fq) const {
        const int row0 = u.pm * BM + wr * 64 + fr, col0 = u.pn * BM + wc * 32 + 8 * fq;
        f32x4 c1v[2][2], c2v[2][2];
#pragma unroll
        for (int bj = 0; bj < 2; ++bj)
#pragma unroll
            for (int n = 0; n < 2; ++n) { c1v[bj][n] = *(const f32x4*)(c1 + col0 + bj * HALF + 4 * n); c2v[bj][n] = *(const f32x4*)(c2 + col0 + bj * HALF + 4 * n); }
        const bool do_ssq = (u.pn == 2) || (u.pn == 3);
        float sq[2][4];
        float mus[2][4], rss[2][4];
#pragma unroll
        for (int ai = 0; ai < 2; ++ai)
#pragma unroll
            for (int m = 0; m < 4; ++m) { mus[ai][m] = 0.f; rss[ai][m] = 1.f; if (!ident) row_mu_rs(st, row0 + ai * HALF + m * 16, mus[ai][m], rss[ai][m]); }
        const bool rp = (u.pn == 4) || (u.pn == 5);
        const float qsc = (u.pn == 4) ? DIL_QSCALE : 1.0f;
#pragma unroll
        for (int ai = 0; ai < 2; ++ai) {
#pragma unroll
            for (int m = 0; m < 4; ++m) {
                const int r = row0 + ai * HALF + m * 16;
                const float mu = mus[ai][m], rs = rss[ai][m];
                float q = 0.f;
                if (rp) {
                    const h16x8 rcm = *(const h16x8*)(rope + (size_t)r * 64 + 8 * fq), rsm = *(const h16x8*)(rope + (size_t)r * 64 + 32 + 8 * fq);
                    f32x4 a0 = acc[ai][0][m][0], a1 = acc[ai][0][m][1], b0 = acc[ai][1][m][0], b1 = acc[ai][1][m][1];
                    if (!ident) { a0 = (a0 - c1v[0][0] * mu) * rs + c2v[0][0]; a1 = (a1 - c1v[0][1] * mu) * rs + c2v[0][1]; b0 = (b0 - c1v[1][0] * mu) * rs + c2v[1][0]; b1 = (b1 - c1v[1][1] * mu) * rs + c2v[1][1]; }
                    float o1[8], o2[8];
#pragma unroll
                    for (int j = 0; j < 8; ++j) { const float x1 = j < 4 ? a0[j & 3] : a1[j & 3], x2 = j < 4 ? b0[j & 3] : b1[j & 3], cc = (float)rcm[j] * qsc, ss = (float)rsm[j] * qsc;
                        o1[j] = x1 * cc - x2 * ss; o2[j] = x1 * ss + x2 * cc; }
                    u32x4 w1, w2; w1.x = pkh(o1[0], o1[1]); w1.y = pkh(o1[2], o1[3]); w1.z = pkh(o1[4], o1[5]); w1.w = pkh(o1[6], o1[7]);
                    w2.x = pkh(o2[0], o2[1]); w2.y = pkh(o2[2], o2[3]); w2.z = pkh(o2[4], o2[5]); w2.w = pkh(o2[6], o2[7]);
                    h16* zd = Z + (size_t)(r & rmask) * ZP + u.pn * BM + wc * 64 + 8 * fq;
                    *(u32x4*)zd = w1; *(u32x4*)(zd + 32) = w2;
                } else {
#pragma unroll
                for (int bj = 0; bj < 2; ++bj) {
                    f32x4 v0 = acc[ai][bj][m][0], v1 = acc[ai][bj][m][1];
                    if (!ident) { v0 = (v0 - c1v[bj][0] * mu) * rs + c2v[bj][0]; v1 = (v1 - c1v[bj][1] * mu) * rs + c2v[bj][1]; }
                    u32x4 w; w.x = pkh(v0[0], v0[1]); w.y = pkh(v0[2], v0[3]); w.z = pkh(v1[0], v1[1]); w.w = pkh(v1[2], v1[3]);
                    *(u32x4*)(Z + (size_t)(r & rmask) * ZP + col0 + bj * HALF) = w;
                    const bool valid = (u.pn == 2) ? (bj == 0 || wc < 2) : (bj == 0);
                    if (valid) q += (v0[0] * v0[0] + v0[1] * v0[1]) + (v0[2] * v0[2] + v0[3] * v0[3]) + (v1[0] * v1[0] + v1[1] * v1[1]) + (v1[2] * v1[2] + v1[3] * v1[3]);
                }
                }
                sq[ai][m] = q;
            }
        }
        if (do_ssq) {
            float* dst = (u.pn == 2) ? ssq_q : ssq_kv;
#pragma unroll
            for (int ai = 0; ai < 2; ++ai) {
                float t[4];
#pragma unroll
                for (int m = 0; m < 4; ++m) { float q = sq[ai][m]; q += __shfl_xor(q, 16); q += __shfl_xor(q, 32); t[m] = q; }
                const float mine = fq == 0 ? t[0] : fq == 1 ? t[1] : fq == 2 ? t[2] : t[3];
                atomic_addf(dst + u.pm * BM + ai * HALF + wr * 64 + fq * 16 + fr, mine);
            }
        }
    }
};

struct EpiRes {
    static constexpr bool PERM = true;
    h16* V; h16* Vo; int ident; RowStats st; const LAS float* g; const LAS float* b; float* o1; float* o2;
    __device__ __forceinline__ void operator()(const f32x4 (&acc)[2][2][4][2], const Unit& u, int wr, int wc, int fr, int fq) const {
        const int row0 = u.pm * BM + wr * 64 + fr, col0 = u.pn * BM + wc * 32 + 8 * fq;
        float s1[2][4], s2[2][4];
#pragma unroll
        for (int ai = 0; ai < 2; ++ai) {
            h16x8 hv[4][2]; float mus[4], rss[4];
#pragma unroll
            for (int m = 0; m < 4; ++m) {
                const int r = row0 + ai * HALF + m * 16;
#pragma unroll
                for (int bj = 0; bj < 2; ++bj) hv[m][bj] = *(const h16x8*)(V + (size_t)r * DM + col0 + bj * HALF);
                mus[m] = 0.f; rss[m] = 1.f; if (!ident) row_mu_rs(st, r, mus[m], rss[m]);
            }
#pragma unroll
            for (int m = 0; m < 4; ++m) {
                const int r = row0 + ai * HALF + m * 16;
                const float mu = mus[m], rs = rss[m];
                float a1 = 0.f, a2 = 0.f;
#pragma unroll
                for (int bj = 0; bj < 2; ++bj) {
                    const size_t off = (size_t)r * DM + col0 + bj * HALF;
                    const h16x8 hx = hv[m][bj];
                    f32x4 x0 = (f32x4){(float)hx[0], (float)hx[1], (float)hx[2], (float)hx[3]}, x1 = (f32x4){(float)hx[4], (float)hx[5], (float)hx[6], (float)hx[7]};
                    if (!ident) { const LAS float* gp = g + col0 + bj * HALF; const LAS float* bp = b + col0 + bj * HALF;
                        x0 = (x0 - mu) * rs * *(const LAS f32x4*)gp + *(const LAS f32x4*)bp; x1 = (x1 - mu) * rs * *(const LAS f32x4*)(gp + 4) + *(const LAS f32x4*)(bp + 4); }
                    const f32x4 v0 = x0 * ALPHA + acc[ai][bj][m][0], v1 = x1 * ALPHA + acc[ai][bj][m][1];
                    h16x8 ho = {(h16)v0[0], (h16)v0[1], (h16)v0[2], (h16)v0[3], (h16)v1[0], (h16)v1[1], (h16)v1[2], (h16)v1[3]};
                    *(h16x8*)(Vo + off) = ho;
#pragma unroll
                    for (int j = 0; j < 8; ++j) { const float f = (float)ho[j]; a1 += f; a2 += f * f; }
                }
                a1 += __shfl_xor(a1, 16); a1 += __shfl_xor(a1, 32); a2 += __shfl_xor(a2, 16); a2 += __shfl_xor(a2, 32);
                s1[ai][m] = a1; s2[ai][m] = a2;
            }
        }
#pragma unroll
        for (int ai = 0; ai < 2; ++ai) {
            const float m1 = fq == 0 ? s1[ai][0] : fq == 1 ? s1[ai][1] : fq == 2 ? s1[ai][2] : s1[ai][3];
            const float m2 = fq == 0 ? s2[ai][0] : fq == 1 ? s2[ai][1] : fq == 2 ? s2[ai][2] : s2[ai][3];
            const int r = u.pm * BM + ai * HALF + wr * 64 + fq * 16 + fr;
            atomic_addf(o1 + r, m1); atomic_addf(o2 + r, m2);
        }
    }
};

struct EpiGU {
    static constexpr bool PERM = true;
    h16* H; const float* c1; const float* c2; RowStats st;
    __device__ __forceinline__ void operator()(const f32x4 (&acc)[2][2][4][2], const Unit& u, int wr, int wc, int fr, int fq) const {
        const int row0 = u.pm * BM + wr * 64 + fr, cin = wc * 32 + 8 * fq, col0 = u.pn * BM + cin;
        f32x4 c1v[2][2], c2v[2][2];
#pragma unroll
        for (int bj = 0; bj < 2; ++bj)
#pragma unroll
            for (int n = 0; n < 2; ++n) { c1v[bj][n] = *(const f32x4*)(c1 + col0 + bj * HALF + 4 * n); c2v[bj][n] = *(const f32x4*)(c2 + col0 + bj * HALF + 4 * n); }
        float mus[2][4], rss[2][4];
#pragma unroll
        for (int ai = 0; ai < 2; ++ai)
#pragma unroll
            for (int m = 0; m < 4; ++m) row_mu_rs(st, row0 + ai * HALF + m * 16, mus[ai][m], rss[ai][m]);
#pragma unroll
        for (int ai = 0; ai < 2; ++ai)
#pragma unroll
            for (int m = 0; m < 4; ++m) {
                const int r = row0 + ai * HALF + m * 16;
                const float mu = mus[ai][m], rs = rss[ai][m];
                float hv[8];
#pragma unroll
                for (int n = 0; n < 2; ++n) {
                    const f32x4 gg = (acc[ai][0][m][n] - c1v[0][n] * mu) * rs + c2v[0][n];
                    const f32x4 uu = (acc[ai][1][m][n] - c1v[1][n] * mu) * rs + c2v[1][n];
#pragma unroll
                    for (int j = 0; j < 4; ++j) { const float e = __builtin_amdgcn_exp2f(gg[j] * -1.4426950408889634f); hv[4 * n + j] = gg[j] * uu[j] * __builtin_amdgcn_rcpf(1.0f + e); }
                }
                u32x4 w; w.x = pkh(hv[0], hv[1]); w.y = pkh(hv[2], hv[3]); w.z = pkh(hv[4], hv[5]); w.w = pkh(hv[6], hv[7]);
                *(u32x4*)(H + (size_t)r * FF + u.pn * HALF + cin) = w;
            }
    }
};


struct EpiNull {
    static constexpr bool PERM = true;
    __device__ __forceinline__ void operator()(const f32x4 (&acc)[2][2][4][2], const Unit& u, int wr, int wc, int fr, int fq) const {
#pragma unroll
        for (int ai = 0; ai < 2; ++ai)
#pragma unroll
            for (int bj = 0; bj < 2; ++bj)
#pragma unroll
                for (int m = 0; m < 4; ++m)
#pragma unroll
                    for (int n = 0; n < 2; ++n) asm volatile("" :: "v"(acc[ai][bj][m][n]));
    }
};
constexpr float QSCALE96 = 0.10206207261596577f * 1.4426950408889634f;
struct EpiQ {
    static constexpr bool PERM = false;
    h16* Q; const float* ssq; const float* rb;
    __device__ __forceinline__ void operator()(const f32x4 (&acc)[2][2][4][2], const Unit& u, int wr, int wc, int fr, int fq) const {
        const int row0 = u.pm * BM + wr * 64 + fr;
#pragma unroll
        for (int ai = 0; ai < 2; ++ai)
#pragma unroll
            for (int m = 0; m < 4; ++m) {
                const int r = row0 + ai * HALF + m * 16;
                const float rs = rsqrtf(ssq[r] * (1.0f / 192.0f) + RMS_EPS) * QSCALE96;
#pragma unroll
                for (int bj = 0; bj < 2; ++bj) {
                    const int g32 = 8 * u.pn + 4 * bj + wc;
                    if (g32 >= 12) continue;
                    f32x4 v0 = acc[ai][bj][m][0] * rs, v1 = acc[ai][bj][m][1] * rs;
                    if (g32 % 3 == 2) {
                        const f32x4 cc = *(const f32x4*)(rb + (size_t)r * 32 + 4 * fq), ss = *(const f32x4*)(rb + (size_t)r * 32 + 16 + 4 * fq);
                        const f32x4 a = v0 * cc - v1 * ss, b = v0 * ss + v1 * cc; v0 = a; v1 = b;
                    }
                    u32x2 w0, w1; w0.x = pkh(v0[0], v0[1]); w0.y = pkh(v0[2], v0[3]); w1.x = pkh(v1[0], v1[1]); w1.y = pkh(v1[2], v1[3]);
                    h16* dst = Q + (size_t)r * 384 + 32 * g32 + 4 * fq;
                    *(u32x2*)dst = w0; *(u32x2*)(dst + 16) = w1;
                }
                asm volatile("" ::: "memory");
            }
    }
};
struct EpiKV {
    static constexpr bool PERM = true;
    h16* Kf; h16* Vm; const float* ssq;
    __device__ __forceinline__ void operator()(const f32x4 (&acc)[2][2][4][2], const Unit& u, int wr, int wc, int fr, int fq) const {
        const int row0 = u.pm * BM + wr * 64 + fr;
#pragma unroll
        for (int ai = 0; ai < 2; ++ai)
#pragma unroll
            for (int m = 0; m < 4; ++m) {
                const int r = row0 + ai * HALF + m * 16;
                const float rs = rsqrtf(ssq[r] * (1.0f / 128.0f) + RMS_EPS);
#pragma unroll
                for (int bj = 0; bj < 2; ++bj) {
                    const int hd = 2 * u.pn + bj, within = 32 * wc + 8 * fq;
                    const f32x4 v0 = acc[ai][bj][m][0] * rs, v1 = acc[ai][bj][m][1] * rs;
                    u32x4 w; w.x = pkh(v0[0], v0[1]); w.y = pkh(v0[2], v0[3]); w.z = pkh(v1[0], v1[1]); w.w = pkh(v1[2], v1[3]);
                    if (wc < 2) *(u32x4*)(Kf + (size_t)r * 384 + hd * 96 + within) = w;
                    else *(u32x4*)(Vm + (size_t)r * 256 + hd * 64 + within - 64) = w;
                }
                asm volatile("" ::: "memory");
            }
    }
};
}

#define XB_TMO      128
#define XB_XCNT(j)  (256  + 64 * (j))
#define XB_XSUB(j)  (1280 + 64 * (j))
#define XB_XGEN(j)  (2304 + 64 * (j))
#define XB_TOP      3328
#define XB_TOPGEN   3392
#define XCD_BAR_WORDS 3456
#define XB_SPIN_CAP (1u << 18)
__device__ __forceinline__ unsigned xb_ld(unsigned* p)              { return __hip_atomic_load(p, __ATOMIC_RELAXED, __HIP_MEMORY_SCOPE_AGENT); }
__device__ __forceinline__ unsigned xb_add(unsigned* p, unsigned v) { return __hip_atomic_fetch_add(p, v, __ATOMIC_RELAXED, __HIP_MEMORY_SCOPE_AGENT); }
__device__ __forceinline__ unsigned xb_xcc_id() { return (unsigned)__builtin_amdgcn_s_getreg((3 << 11) | 20) & 0xFu; }
#define XB_SPIN(cond, bar) do { unsigned _sp = 0; while (cond) { __builtin_amdgcn_s_sleep(1); \
    if ((++_sp & 255u) == 0u) { if (xb_ld(&(bar)[XB_TMO])) break; if (_sp > XB_SPIN_CAP) { atomicAdd(&(bar)[XB_TMO], 1u); break; } } } } while (0)
struct XcdBarrier { unsigned* bar; unsigned x; volatile LAS unsigned* st; int wave; };
__device__ __forceinline__ bool xb_thread0(int wave) { return wave == 0 && __builtin_amdgcn_mbcnt_hi(~0u, __builtin_amdgcn_mbcnt_lo(~0u, 0u)) == 0; }
__device__ __forceinline__ XcdBarrier xcd_barrier_post(unsigned* bar, volatile LAS unsigned* st, int wave) {
    XcdBarrier b; b.bar = bar; b.x = xb_xcc_id(); b.st = st; b.wave = wave;
    if (xb_thread0(wave)) (void)xb_add(&bar[XB_XCNT(b.x)], 1u);
    return b;
}
__device__ __forceinline__ void xcd_barrier_complete(unsigned* bar, unsigned x, unsigned& nloc, unsigned& nx) {
    const unsigned G = gridDim.x * gridDim.y * gridDim.z;
    unsigned sum, cnt, mine, sp = 0u;
    for (;;) {
        sum = 0u; cnt = 0u; mine = 0u;
#pragma unroll
        for (unsigned j = 0; j < 16; ++j) { const unsigned c = xb_ld(&bar[XB_XCNT(j)]); sum += c; cnt += (c > 0u) ? 1u : 0u; mine = (j == x) ? c : mine; }
        if (sum == G) break;
        __builtin_amdgcn_s_sleep(1);
        if ((++sp & 255u) == 0u) { if (xb_ld(&bar[XB_TMO])) break; if (sp > XB_SPIN_CAP) { atomicAdd(&bar[XB_TMO], 1u); break; } }
    }
    nloc = mine > 0u ? mine : 1u; nx = cnt > 0u ? cnt : 1u;
}
__device__ __forceinline__ void xcd_barrier(const XcdBarrier& b) {
    asm volatile("s_waitcnt vmcnt(0)" ::: "memory");
    __syncthreads();
    if (xb_thread0(b.wave)) {
        unsigned* bar = b.bar;
        __builtin_amdgcn_s_waitcnt(0);
        unsigned nloc = b.st[0], nx = b.st[1];
        if (nloc == 0u) { xcd_barrier_complete(bar, b.x, nloc, nx); b.st[0] = nloc; b.st[1] = nx; }
        const unsigned old = xb_add(&bar[XB_XSUB(b.x)], 1u);
        const unsigned gen = old / nloc;
        if (old + 1u == (gen + 1u) * nloc) {
            __builtin_amdgcn_fence(__ATOMIC_RELEASE, "agent");
            asm volatile("s_waitcnt vmcnt(0)" ::: "memory");
            const unsigned og = xb_add(&bar[XB_TOP], 1u);
            const unsigned tg = og / nx;
            if (og + 1u == (tg + 1u) * nx) xb_add(&bar[XB_TOPGEN], 1u);
            else XB_SPIN(xb_ld(&bar[XB_TOPGEN]) == tg, bar);
            __builtin_amdgcn_fence(__ATOMIC_ACQUIRE, "agent");
            xb_add(&bar[XB_XGEN(b.x)], 1u);
            asm volatile("s_waitcnt vmcnt(0)" ::: "memory");
        } else {
            XB_SPIN(xb_ld(&bar[XB_XGEN(b.x)]) == gen, bar);
            __builtin_amdgcn_fence(__ATOMIC_ACQUIRE, "agent");
            asm volatile("s_waitcnt vmcnt(0)" ::: "memory");
        }
    }
    __syncthreads();
}

struct Args {
    const float* x; const int* pos; const float* w_in; const float* a_ln_g; const float* a_ln_b; const float* a_ws; const float* a_bs;
    const float* b_q_norm; const float* b_kv_norm; const float* b_w_uq; const float* b_w_ukv;
    const float* d_conv_w; const float* d_conv_b; const float* d_igate_b; const float* d_fgate_b;
    const float* w_out; const float* ln1_g; const float* ln1_b; const float* w_gate; const float* w_up; const float* w_down; const float* ln2_g; const float* ln2_b;
    float* out; unsigned char* ws; int ph_lo, ph_hi; int use_bar, pad;
};

template <int MAP>
__device__ __forceinline__ void transpose_item(const float* W, int Ksrc, int Nsrc, const float* g, const float* b, h16* Wt, int Kdst, int Ndst_valid,
                                               float* c1, float* c2, int kb, int nb, LAS float* scr, int lane) {
    const int k0 = 64 * kb, n0 = 32 * nb, nn = lane & 31, kh = lane >> 5;
    int ns, nd;
    if (MAP == 0) { nd = n0 + nn; ns = (nd < Ndst_valid && nd < Nsrc) ? nd : -1; }
    else if (MAP == 1) { nd = n0 + nn; ns = in_src(nd); }
    else { const int j = n0 + nn; ns = j; nd = 256 * (j >> 7) + (j & 127) + (MAP == 3 ? 128 : 0); }
    float s1 = 0.f, s2 = 0.f;
    const bool okn = ns >= 0; const int nsc = okn ? ns : 0;
    float wv[32], gv[32], bv[32];
#pragma unroll
    for (int i = 0; i < 32; ++i) { int k = k0 + 2 * i + kh; if (k >= Ksrc) k = Ksrc - 1; wv[i] = W[(size_t)k * Nsrc + nsc]; gv[i] = g ? g[k] : 1.0f; bv[i] = b ? b[k] : 0.0f; }
#pragma unroll
    for (int i = 0; i < 32; ++i) {
        const int kk = 2 * i + kh, k = k0 + kk;
        const float w = (okn && k < Ksrc) ? wv[i] : 0.f;
        const float hf = (float)(h16)(w * gv[i]);
        scr[kk * 33 + nn] = hf; s1 += hf; s2 += bv[i] * w;
    }
    if (c1) { s1 += __shfl_xor(s1, 32); s2 += __shfl_xor(s2, 32); if (lane < 32) { atomic_addf(c1 + nd, s1); atomic_addf(c2 + nd, s2); } }
    asm volatile("s_waitcnt lgkmcnt(0)" ::: "memory");
    const int c = lane & 7;
    int nd0; if (MAP <= 1) nd0 = n0; else nd0 = 256 * (n0 >> 7) + (n0 & 127) + (MAP == 3 ? 128 : 0);
#pragma unroll
    for (int j = 0; j < 4; ++j) { const int n = (lane >> 3) + 8 * j; const LAS float* s = scr + (8 * c) * 33 + n;
        u32x4 o; o.x = pkh(s[0 * 33], s[1 * 33]); o.y = pkh(s[2 * 33], s[3 * 33]); o.z = pkh(s[4 * 33], s[5 * 33]); o.w = pkh(s[6 * 33], s[7 * 33]);
        *(u32x4*)(Wt + (size_t)(nd0 + n) * Kdst + k0 + 8 * c) = o; }
    asm volatile("s_waitcnt lgkmcnt(0)" ::: "memory");
}

struct Frame { LAS unsigned char* lds; int tid, lane, wave, G; };
#define UNIT_END_BAR() do { asm volatile("s_waitcnt lgkmcnt(0)" ::: "memory"); __builtin_amdgcn_s_barrier(); asm volatile("" ::: "memory"); } while (0)
__device__ __forceinline__ Frame fresh_frame(const Frame& F0) {
    Frame F; int ln = __builtin_amdgcn_mbcnt_hi(~0u, __builtin_amdgcn_mbcnt_lo(~0u, 0u)); asm volatile("" : "+v"(ln));
    F.lds = F0.lds; F.G = F0.G; F.wave = F0.wave; F.lane = ln; F.tid = F0.wave * 64 + ln; return F;
}

__device__ __forceinline__ void p0_prologue(const Args& a, const Frame& F0, float* c12) {
    const Frame F = fresh_frame(F0);
    LAS float* scr = (LAS float*)(F.lds + F.wave * 16384);
    const int gw = blockIdx.x * 8 + F.wave, NGW = F.G * 8;
    constexpr int I_IN = 16 * (ZP / 32), I_OUT = 16 * 32, I_G = 16 * (FF / 32), I_DN = (FF / 64) * 32, I_UQ = 4 * 16, I_UKV = 4 * 16;
    constexpr int PER_LAYER = I_IN + I_OUT + 2 * I_G + I_DN + I_UQ + I_UKV;
    for (int it = gw; it < DEPTH * PER_LAYER; it += NGW) {
        const int l = it / PER_LAYER; int r = it % PER_LAYER;
        if (r < I_IN) { const int kb = r / (ZP / 32), nb = r % (ZP / 32);
            transpose_item<1>(a.w_in + (size_t)l * DM * IN_COLS, DM, IN_COLS, l ? a.ln2_g + (l - 1) * DM : nullptr, l ? a.ln2_b + (l - 1) * DM : nullptr,
                              (h16*)(a.ws + WS_WIN) + (size_t)l * ZP * DM, DM, ZP, c12 + C1IN + l * ZP, c12 + C2IN + l * ZP, kb, nb, scr, F.lane); continue; } r -= I_IN;
        if (r < I_OUT) { const int kb = r / 32, nb = r % 32;
            transpose_item<0>(a.w_out + (size_t)l * DM * DM, DM, DM, nullptr, nullptr, (h16*)(a.ws + WS_WOUT) + (size_t)l * DM * DM, DM, DM, nullptr, nullptr, kb, nb, scr, F.lane); continue; } r -= I_OUT;
        if (r < I_G) { const int kb = r / (FF / 32), nb = r % (FF / 32);
            transpose_item<2>(a.w_gate + (size_t)l * DM * FF, DM, FF, a.ln1_g + l * DM, a.ln1_b + l * DM, (h16*)(a.ws + WS_WGU) + (size_t)l * GU * DM, DM, GU, c12 + C1GU + l * GU, c12 + C2GU + l * GU, kb, nb, scr, F.lane); continue; } r -= I_G;
        if (r < I_G) { const int kb = r / (FF / 32), nb = r % (FF / 32);
            transpose_item<3>(a.w_up + (size_t)l * DM * FF, DM, FF, a.ln1_g + l * DM, a.ln1_b + l * DM, (h16*)(a.ws + WS_WGU) + (size_t)l * GU * DM, DM, GU, c12 + C1GU + l * GU, c12 + C2GU + l * GU, kb, nb, scr, F.lane); continue; } r -= I_G;
        if (r < I_DN) { const int kb = r / 32, nb = r % 32;
            transpose_item<0>(a.w_down + (size_t)l * FF * DM, FF, DM, nullptr, nullptr, (h16*)(a.ws + WS_WDOWN) + (size_t)l * DM * FF, FF, DM, nullptr, nullptr, kb, nb, scr, F.lane); continue; } r -= I_DN;
        if (r < I_UQ) { const int kb = r / 16, nb = r % 16;
            transpose_item<0>(a.b_w_uq + (size_t)l * 192 * 384, 192, 384, a.b_q_norm + l * 192, nullptr, (h16*)(a.ws + WS_WUQ) + (size_t)l * 512 * 256, 256, 384, nullptr, nullptr, kb, nb, scr, F.lane); continue; } r -= I_UQ;
        { const int kb = r / 16, nb = r % 16;
            transpose_item<0>(a.b_w_ukv + (size_t)l * 128 * 512, 128, 512, a.b_kv_norm + l * 128, nullptr, (h16*)(a.ws + WS_WUKV) + (size_t)l * 512 * 256, 256, 512, nullptr, nullptr, kb, nb, scr, F.lane); }
    }
    const size_t gt = (size_t)blockIdx.x * 512 + F.tid, NT = (size_t)F.G * 512;
    h16* V = (h16*)(a.ws + WS_V16);
    for (size_t i0 = gt; i0 < (size_t)M * DM / 8; i0 += 8 * NT) {
        f32x4 p[8], q[8];
#pragma unroll
        for (int k = 0; k < 8; ++k) { size_t i = i0 + k * NT; if (i >= (size_t)M * DM / 8) i = (size_t)M * DM / 8 - 1; p[k] = *(const f32x4*)(a.x + i * 8); q[k] = *(const f32x4*)(a.x + i * 8 + 4); }
#pragma unroll
        for (int k = 0; k < 8; ++k) { const size_t i = i0 + k * NT; if (i >= (size_t)M * DM / 8) continue;
            u32x4 w; w.x = pkh(p[k][0], p[k][1]); w.y = pkh(p[k][2], p[k][3]); w.z = pkh(q[k][0], q[k][1]); w.w = pkh(q[k][2], q[k][3]);
            *(u32x4*)(V + i * 8) = w; }
    }
    float* rb = (float*)(a.ws + WS_ROPEB); h16* rc = (h16*)(a.ws + WS_ROPEC);
    for (size_t i = gt; i < (size_t)M * 48; i += NT) {
        const int row = (int)(i / 48), j = (int)(i % 48);
        const float p = (float)a.pos[row];
        if (j < 16) { const float inv = powf(10000.0f, -(float)j / 16.0f); float s, c; sincosf(p * inv, &s, &c); rb[(size_t)row * 32 + j] = c; rb[(size_t)row * 32 + 16 + j] = s; }
        else { const int jj = j - 16; const float inv = powf(10000.0f, -(float)jj / 32.0f); float s, c; sincosf(p * inv, &s, &c); rc[(size_t)row * 64 + jj] = (h16)c; rc[(size_t)row * 64 + 32 + jj] = (h16)s; }
    }
    float* par = (float*)(a.ws + WS_PAR);
    for (size_t i = gt; i < (size_t)PF_END; i += NT) {
        const int k = (int)i; float v;
        if (k < PF_LN1B) v = a.ln1_g[k - PF_LN1G]; else if (k < PF_LN2G) v = a.ln1_b[k - PF_LN1B]; else if (k < PF_LN2B) v = a.ln2_g[k - PF_LN2G]; else if (k < PF_ALNG) v = a.ln2_b[k - PF_LN2B];
        else if (k < PF_ALNB) v = a.a_ln_g[k - PF_ALNG]; else if (k < PF_ABS) v = a.a_ln_b[k - PF_ALNB]; else if (k < PF_CONVW) v = a.a_bs[k - PF_ABS]; else if (k < PF_CONVB) v = a.d_conv_w[k - PF_CONVW];
        else if (k < PF_IGB) v = a.d_conv_b[k - PF_CONVB]; else if (k < PF_FGB) v = (k - PF_IGB < 16) ? a.d_igate_b[k - PF_IGB] : 0.f; else v = a.d_fgate_b[k - PF_FGB];
        par[k] = v;
    }
    h16* aws = (h16*)(a.ws + WS_AWS);
    for (size_t i = gt; i < (size_t)DEPTH * 4 * 128 * 128; i += NT) aws[i] = (h16)a.a_ws[i];
}

struct Core { float* out; unsigned char* ws; };
__device__ __forceinline__ void final_ln(const Core& a, const Frame& F0) {
    const Frame F = fresh_frame(F0);
    const int gw = blockIdx.x * 8 + F.wave, NGW = F.G * 8;
    const h16* V = (const h16*)(a.ws + WS_V16);
    const float* par = (const float*)(a.ws + WS_PAR); const float* g = par + PF_LN2G + (DEPTH - 1) * DM; const float* b = par + PF_LN2B + (DEPTH - 1) * DM;
    f32x4 gg[4], bb[4];
#pragma unroll
    for (int j = 0; j < 2; ++j)
#pragma unroll
        for (int k4 = 0; k4 < 2; ++k4) { const int c = j * 512 + F.lane * 8 + k4 * 4; gg[j * 2 + k4] = *(const f32x4*)(g + c); bb[j * 2 + k4] = *(const f32x4*)(b + c); }
    for (int r0 = gw; r0 < M; r0 += 4 * NGW) {
        h16x8 hv[4][2];
#pragma unroll
        for (int k = 0; k < 4; ++k) { int r = r0 + k * NGW; if (r >= M) r = M - 1;
#pragma unroll
            for (int j = 0; j < 2; ++j) hv[k][j] = *(const h16x8*)(V + (size_t)r * DM + j * 512 + F.lane * 8); }
#pragma unroll
        for (int k = 0; k < 4; ++k) { const int r = r0 + k * NGW; if (r >= M) continue;
            float v[16];
#pragma unroll
            for (int j = 0; j < 2; ++j)
#pragma unroll
                for (int e = 0; e < 8; ++e) v[j * 8 + e] = (float)hv[k][j][e];
            float s = 0.f;
#pragma unroll
            for (int e = 0; e < 16; ++e) s += v[e];
            const float mean = wave_sum(s) * (1.0f / DM); float q = 0.f;
#pragma unroll
            for (int e = 0; e < 16; ++e) { v[e] -= mean; q += v[e] * v[e]; }
            const float rs = rsqrtf(wave_sum(q) * (1.0f / DM) + LN_EPS);
#pragma unroll
            for (int j = 0; j < 2; ++j)
#pragma unroll
                for (int k4 = 0; k4 < 2; ++k4) { const int c = j * 512 + F.lane * 8 + k4 * 4; const f32x4 G4 = gg[j * 2 + k4], B4 = bb[j * 2 + k4];
                    f32x4 o; o[0] = v[j * 8 + k4 * 4 + 0] * rs * G4[0] + B4[0]; o[1] = v[j * 8 + k4 * 4 + 1] * rs * G4[1] + B4[1]; o[2] = v[j * 8 + k4 * 4 + 2] * rs * G4[2] + B4[2]; o[3] = v[j * 8 + k4 * 4 + 3] * rs * G4[3] + B4[3];
                    *(f32x4*)(a.out + (size_t)r * DM + c) = o; }
        }
    }
}

#ifndef EN_C
#define EN_C 1
#endif
#ifndef EN_B
#define EN_B 1
#endif
#ifndef EN_D
#define EN_D 1
#endif
#ifndef EN_B1
#define EN_B1 1
#endif
#ifndef EN_B2
#define EN_B2 1
#endif
#ifndef DUP_MASK
#define DUP_MASK 0
#endif
#ifndef EN_A
#define EN_A 1
#endif
#ifndef ZERO_FROM
#define ZERO_FROM 1024
#endif
#ifndef LOOP_START
#define LOOP_START 0
#endif
#ifndef LOOP_DEPTH
#define LOOP_DEPTH DEPTH
#endif
#ifndef EN_P0
#define EN_P0 1
#endif
#ifndef EN_P1
#define EN_P1 1
#endif
#ifndef EN_P3
#define EN_P3 1
#endif
#ifndef EN_P4
#define EN_P4 1
#endif
#ifndef EN_P5
#define EN_P5 1
#endif
#ifndef EN_PF
#define EN_PF 1
#endif

typedef short v4i16_t __attribute__((ext_vector_type(4)));
__device__ __forceinline__ f32x16 mfma32(h16x8 a, h16x8 b, f32x16 c) { return __builtin_amdgcn_mfma_f32_32x32x16_f16(a, b, c, 0, 0, 0); }
__device__ __forceinline__ int crow(int i, int hh) { return (i & 3) + 8 * (i >> 2) + 4 * hh; }
template <bool NAT>
__device__ __forceinline__ h16x8 tr_frag(const LAS h16* T, int pitch, int k0, int c0, int lane) {
    const int i = lane & 15, g4 = lane >> 4, hh = g4 >> 1;
    const int ra = k0 + (NAT ? 8 * hh : 4 * hh) + (i >> 2), rb = ra + (NAT ? 4 : 8);
    const int cc = c0 + 16 * (g4 & 1) + 4 * (i & 3);
    const v4i16_t x = __builtin_amdgcn_ds_read_tr16_b64_v4i16((LAS v4i16_t*)(T + ra * pitch + cc));
    const v4i16_t y = __builtin_amdgcn_ds_read_tr16_b64_v4i16((LAS v4i16_t*)(T + rb * pitch + cc));
    typedef short s16x8 __attribute__((ext_vector_type(8)));
    const s16x8 r = {x[0], x[1], x[2], x[3], y[0], y[1], y[2], y[3]};
    return __builtin_bit_cast(h16x8, r);
}
__device__ __forceinline__ float gelu_erf(float v) {
    const float av = fabsf(v), t = __builtin_amdgcn_rcpf(av * 0.2316418882f + 1.0f);
    float q = t * 0.5307027145f + (-0.7265760135f); q = q * t + 0.7107068705f; q = q * t + (-0.142248368f); q = q * t + 0.127414796f; q = q * t;
    const float e = __builtin_amdgcn_exp2f((v * v) * (-0.72134752044f));
    const float m = v * (q * e);
    return v < 0.f ? m : v - m;
}


__device__ __forceinline__ void store_row32(h16* rowp, const u32x2 (&v)[4], int hh) {
#pragma unroll
    for (int p = 0; p < 2; ++p) {
        const auto r0 = __builtin_amdgcn_permlane32_swap(v[2 * p].x, v[2 * p + 1].x, false, false);
        const auto r1 = __builtin_amdgcn_permlane32_swap(v[2 * p].y, v[2 * p + 1].y, false, false);
        const u32x4 w = {r0[0], r1[0], r0[1], r1[1]};
        *(u32x4*)(rowp + 16 * p + 8 * hh) = w;
    }
}
constexpr int GM_PITCH = 288;
template <int l>
__device__ __forceinline__ void gmlp_unit(const Core& C, const Frame& F0, int unit) {
    const Frame F = fresh_frame(F0);
    const h16* Z = (const h16*)(C.ws + WS_Z); h16* Y = (h16*)((unsigned char*)C.out + OUT_Y);
    const float* par = (const float*)(C.ws + WS_PAR);
    const h16* W = (const h16*)(C.ws + WS_AWS) + (size_t)l * 4 * 128 * 128;
    LAS h16* Vt = (LAS h16*)F.lds;
    const int row0 = (unit >> 4) * SEQ + (unit & 15) * 128;
    const int lane = F.lane, w = F.wave;
    {
        const f32x4 gg = *(const f32x4*)(par + PF_ALNG + l * GW + 4 * lane), bb = *(const f32x4*)(par + PF_ALNB + l * GW + 4 * lane);
        h16x4 hvv[16];
#pragma unroll
        for (int i = 0; i < 16; ++i) hvv[i] = *(const h16x4*)(Z + (size_t)(row0 + w * 16 + i) * ZP + ZC_A + 256 + 4 * lane);
#pragma unroll
        for (int i = 0; i < 16; ++i) {
            const int t = w * 16 + i;
            const h16x4 hv = hvv[i];
            float x[4]; float s = 0.f;
#pragma unroll
            for (int j = 0; j < 4; ++j) { x[j] = gelu_erf((float)hv[j]); s += x[j]; }
            const float mean = wave_sum(s) * (1.0f / 256.0f); float q = 0.f;
#pragma unroll
            for (int j = 0; j < 4; ++j) { x[j] -= mean; q += x[j] * x[j]; }
            const float rs = rsqrtf(wave_sum(q) * (1.0f / 256.0f) + LN_EPS);
            u32x2 o; o.x = pkh(x[0] * rs * gg[0] + bb[0], x[1] * rs * gg[1] + bb[1]); o.y = pkh(x[2] * rs * gg[2] + bb[2], x[3] * rs * gg[3] + bb[3]);
            *(LAS u32x2*)(Vt + t * GM_PITCH + 4 * lane) = o;
        }
    }
    __syncthreads();
    {
        const int h = w >> 1, db = w & 1, tl = lane & 31, hh = lane >> 5;
        const float* bs = par + PF_ABS + (l * 4 + h) * 128;
#pragma unroll 1
        for (int tb = 0; tb < 4; ++tb) {
            const int t = 32 * tb + tl;
            f32x16 acc;
#pragma unroll
            for (int i = 0; i < 16; ++i) acc[i] = 0.f;
            const h16* wrow = W + ((size_t)h * 128 + t) * 128 + 8 * hh;
            h16x4 uv[4];
            { const size_t zoff = (size_t)(row0 + t) * ZP + ZC_A + h * 64 + 32 * db + 4 * hh;
#pragma unroll
              for (int g = 0; g < 4; ++g) uv[g] = *(const h16x4*)(Z + zoff + 8 * g); }
            for (int ks = 0; ks < 2 * (tb + 1); ++ks) {
                const h16x8 a = tr_frag<true>(Vt, GM_PITCH, 16 * ks, h * 64 + 32 * db, lane);
                h16x8 bw = *(const h16x8*)(wrow + 16 * ks);
                const int s0 = 16 * ks + 8 * hh;
#pragma unroll
                for (int j = 0; j < 8; ++j) if (s0 + j > t) bw[j] = (h16)0.f;
                acc = mfma32(a, bw, acc);
            }
            const float bias = bs[t];
            u32x2 ov[4];
#pragma unroll
            for (int g = 0; g < 4; ++g) {
                const h16x4 uu = uv[g];
                ov[g].x = pkh(gelu_erf((float)uu[0]) * (acc[4 * g + 0] + bias), gelu_erf((float)uu[1]) * (acc[4 * g + 1] + bias));
                ov[g].y = pkh(gelu_erf((float)uu[2]) * (acc[4 * g + 2] + bias), gelu_erf((float)uu[3]) * (acc[4 * g + 3] + bias));
            }
            store_row32(Y + (size_t)(row0 + t) * DM + h * 64 + 32 * db, ov, hh);
        }
    }
    UNIT_END_BAR();
}


__device__ __forceinline__ bool bh_unit(int it, int n_per, int G, int& bh, int& r) {
    if (G != 256) { const int L = it * G + (int)blockIdx.x; if (L >= 128 * n_per) return false; bh = L / n_per; r = L % n_per; return true; }
    const int xcd = blockIdx.x & 7, s = blockIdx.x >> 3, j = it * 32 + s;
    if (j >= 16 * n_per) return false;
    bh = (j / n_per) * 8 + xcd; r = j % n_per; return true;
}
template <int DQ, int NT>
__device__ __forceinline__ void attn_tile(const LAS h16* Kt, int kpitch, const LAS h16* Vt, int vpitch, const h16x8 (&qf)[DQ / 16], float& m, float& ls, f32x16 (&o)[2],
                                          bool masked, int lo, int hi, int lane) {
    const int kr = lane & 31, hh = lane >> 5;
    f32x16 sc[NT];
#pragma unroll
    for (int t = 0; t < NT; ++t) {
#pragma unroll
        for (int i = 0; i < 16; ++i) sc[t][i] = 0.f;
#pragma unroll
        for (int ds = 0; ds < DQ / 16; ++ds) { const h16x8 a = *(const LAS h16x8*)(Kt + (32 * t + kr) * kpitch + 16 * ds + 8 * hh); sc[t] = mfma32(a, qf[ds], sc[t]); }
    }
    if (masked) {
#pragma unroll
        for (int t = 0; t < NT; ++t)
#pragma unroll
            for (int i = 0; i < 16; ++i) { const int kk = 32 * t + crow(i, hh); if (kk < lo || kk > hi) sc[t][i] = -INFINITY; }
    }
    float mx = sc[0][0];
#pragma unroll
    for (int t = 0; t < NT; ++t)
#pragma unroll
        for (int i = 0; i < 16; ++i) mx = fmaxf(mx, sc[t][i]);
    mx = fmaxf(mx, __shfl_xor(mx, 32));
    if (__any(mx > m)) {
        const float mn = fmaxf(m, mx);
        const float alpha = __builtin_amdgcn_exp2f(m - mn);
        ls *= alpha; m = mn;
#pragma unroll
        for (int i = 0; i < 16; ++i) { o[0][i] *= alpha; o[1][i] *= alpha; }
    }
    float ps = 0.f;
#pragma unroll
    for (int t = 0; t < NT; ++t)
#pragma unroll
        for (int i = 0; i < 16; ++i) { sc[t][i] = __builtin_amdgcn_exp2f(sc[t][i] - m); ps += sc[t][i]; }
    ls += ps;
#pragma unroll
    for (int t = 0; t < NT; ++t) {
        h16x8 pf[2];
#pragma unroll
        for (int s2 = 0; s2 < 2; ++s2)
#pragma unroll
            for (int j = 0; j < 8; ++j) pf[s2][j] = (h16)sc[t][8 * s2 + j];
#pragma unroll
        for (int db = 0; db < 2; ++db)
#pragma unroll
            for (int s2 = 0; s2 < 2; ++s2) { const h16x8 a = tr_frag<false>(Vt + 32 * t * vpitch, vpitch, 16 * s2, 32 * db, lane); o[db] = mfma32(a, pf[s2], o[db]); }
    }
}


template <int DQ>
__device__ __forceinline__ void attn_tile_dual(const LAS h16* Kt, int kpitch, const LAS h16* Vt, int vpitch, const h16x8 (&qA)[DQ / 16], const h16x8 (&qB)[DQ / 16],
                                               float& mA, float& lsA, f32x16 (&oA)[2], float& mB, float& lsB, f32x16 (&oB)[2], bool maskA, int hiA, bool maskB, int hiB, int lane) {
    const int kr = lane & 31, hh = lane >> 5;
    f32x16 sA, sB;
#pragma unroll
    for (int i = 0; i < 16; ++i) { sA[i] = 0.f; sB[i] = 0.f; }
#pragma unroll
    for (int ds = 0; ds < DQ / 16; ++ds) { const h16x8 a = *(const LAS h16x8*)(Kt + kr * kpitch + 16 * ds + 8 * hh); sA = mfma32(a, qA[ds], sA); sB = mfma32(a, qB[ds], sB); }
    if (maskA) {
#pragma unroll
        for (int i = 0; i < 16; ++i) if (crow(i, hh) > hiA) sA[i] = -INFINITY;
    }
    if (maskB) {
#pragma unroll
        for (int i = 0; i < 16; ++i) if (crow(i, hh) > hiB) sB[i] = -INFINITY;
    }
    float xa = sA[0], xb = sB[0];
#pragma unroll
    for (int i = 1; i < 16; ++i) { xa = fmaxf(xa, sA[i]); xb = fmaxf(xb, sB[i]); }
    xa = fmaxf(xa, __shfl_xor(xa, 32)); xb = fmaxf(xb, __shfl_xor(xb, 32));
    if (__any(xa > mA)) { const float mn = fmaxf(mA, xa), al = __builtin_amdgcn_exp2f(mA - mn); lsA *= al; mA = mn;
#pragma unroll
        for (int i = 0; i < 16; ++i) { oA[0][i] *= al; oA[1][i] *= al; } }
    if (__any(xb > mB)) { const float mn = fmaxf(mB, xb), al = __builtin_amdgcn_exp2f(mB - mn); lsB *= al; mB = mn;
#pragma unroll
        for (int i = 0; i < 16; ++i) { oB[0][i] *= al; oB[1][i] *= al; } }
    float pa = 0.f, pb = 0.f;
#pragma unroll
    for (int i = 0; i < 16; ++i) { sA[i] = __builtin_amdgcn_exp2f(sA[i] - mA); pa += sA[i]; sB[i] = __builtin_amdgcn_exp2f(sB[i] - mB); pb += sB[i]; }
    lsA += pa; lsB += pb;
    h16x8 fA[2], fB[2];
#pragma unroll
    for (int s2 = 0; s2 < 2; ++s2)
#pragma unroll
        for (int j = 0; j < 8; ++j) { fA[s2][j] = (h16)sA[8 * s2 + j]; fB[s2][j] = (h16)sB[8 * s2 + j]; }
#pragma unroll
    for (int db = 0; db < 2; ++db)
#pragma unroll
        for (int s2 = 0; s2 < 2; ++s2) { const h16x8 a = tr_frag<false>(Vt, vpitch, 16 * s2, 32 * db, lane); oA[db] = mfma32(a, fA[s2], oA[db]); oB[db] = mfma32(a, fB[s2], oB[db]); }
}
constexpr int DK_PITCH = 72, DV_PITCH = 96;
constexpr int DIL_V_OFF = 384 * DK_PITCH * 2;
constexpr float QK_SCALE64 = 0.125f * 1.4426950408889634f;
struct DilGeo { int br, b, h, d, tok0, res0, U0, nrows, segbase; };
struct DilPre { h16x8 vreg[6], kreg[6], qa[4]; };
__device__ __forceinline__ DilGeo dil_geo(int bh, int rr) {
    DilGeo g; const int x = rr & 7; g.br = rr >> 3; g.b = bh >> 2; g.h = bh & 3; g.d = g.br == 0 ? 1 : g.br == 1 ? 4 : 16; g.tok0 = g.b * SEQ;
    if (g.br == 0) { g.res0 = 0; g.U0 = 256 * x; g.nrows = 384; } else if (g.br == 1) { g.res0 = x >> 1; g.U0 = 256 * (x & 1); g.nrows = 384; } else { g.res0 = 2 * x; g.U0 = 128; g.nrows = 256; }
    g.segbase = g.U0 - 128;
    return g;
}
__device__ __forceinline__ void dil_qgeo(const DilGeo& g, int w, int& res, int& jblk, int& rowoff) {
    if (g.br == 2) { res = g.res0 + (w >> 2); jblk = w & 3; rowoff = 128 * (w >> 2); } else { res = g.res0; jblk = (g.U0 >> 5) + w; rowoff = -g.segbase; }
}
__device__ __forceinline__ void dil_issue(const Core& C, const Frame& F, const DilGeo& g, DilPre& P) {
    const h16* Z = (const h16*)(C.ws + WS_Z);
    const int tid = F.tid, lane = F.lane, br = g.br, d = g.d, h = g.h;
#pragma unroll
    for (int i = 0; i < 6; ++i) {
        int it = tid + 512 * i; if (it >= g.nrows * 8) it = g.nrows * 8 - 1;
        const int ri = it >> 3, c8 = it & 7;
        int up, res; if (br == 2) { up = ri & 127; res = g.res0 + (ri >> 7); } else { up = g.segbase + ri; res = g.res0; }
        if (up < 0) up = 0;
        const h16* src = Z + (size_t)(g.tok0 + up * d + res) * ZP + ZC_C + h * 64 + 8 * c8;
        P.vreg[i] = *(const h16x8*)(src + 512); P.kreg[i] = *(const h16x8*)(src + 256);
    }
    int res, jblk, rowoff; dil_qgeo(g, F.wave, res, jblk, rowoff);
    const int qi = lane & 31, hh = lane >> 5;
    const int qtok = g.tok0 + (32 * jblk + qi) * d + res;
    const h16* qsrc = Z + (size_t)qtok * ZP + ZC_C + h * 64 + 8 * hh;
#pragma unroll
    for (int ds = 0; ds < 4; ++ds) P.qa[ds] = *(const h16x8*)(qsrc + 16 * ds);
}
__device__ __forceinline__ void dil_stage(const Frame& F, const DilGeo& g, const DilPre& P, h16x8 (&qf)[4]) {
    LAS h16* Kt = (LAS h16*)F.lds; LAS h16* Vt = (LAS h16*)(F.lds + DIL_V_OFF);
    const int tid = F.tid, br = g.br;
#pragma unroll
    for (int i = 0; i < 6; ++i) {
        const int it = tid + 512 * i; const int ri = it >> 3, c8 = it & 7;
        int up; if (br == 2) up = ri & 127; else up = g.segbase + ri;
        if (it < g.nrows * 8 && up >= 0) { *(LAS h16x8*)(Vt + ri * DV_PITCH + 8 * c8) = P.vreg[i]; *(LAS h16x8*)(Kt + ri * DK_PITCH + 8 * c8) = P.kreg[i]; }
    }
#pragma unroll
    for (int ds = 0; ds < 4; ++ds) qf[ds] = P.qa[ds];
}
__device__ __forceinline__ void dil_compute(const Core& C, const Frame& F, const DilGeo& g, const h16x8 (&qf)[4]) {
    h16* DP = (h16*)((unsigned char*)C.out + OUT_DP); float* DL = (float*)((unsigned char*)C.out + OUT_DL);
    const LAS h16* Kt = (const LAS h16*)F.lds; const LAS h16* Vt = (const LAS h16*)(F.lds + DIL_V_OFF);
    const int lane = F.lane, br = g.br, h = g.h;
    int res, jblk, rowoff; dil_qgeo(g, F.wave, res, jblk, rowoff);
    const int qi = lane & 31, hh = lane >> 5;
    const int qtok = g.tok0 + (32 * jblk + qi) * g.d + res;
    float m = -INFINITY, ls = 0.f; f32x16 o[2];
#pragma unroll
    for (int i = 0; i < 16; ++i) { o[0][i] = 0.f; o[1][i] = 0.f; }
    {
        const int ub0 = 32 * (jblk - 4);
        if (ub0 >= 0) { const int rowb = ub0 + rowoff; attn_tile<64, 1>(Kt + rowb * DK_PITCH, DK_PITCH, Vt + rowb * DV_PITCH, DV_PITCH, qf, m, ls, o, true, qi, 64, lane); }
        if (ub0 + 32 >= 0) { const int rowb = ub0 + 32 + rowoff; attn_tile<64, 2>(Kt + rowb * DK_PITCH, DK_PITCH, Vt + rowb * DV_PITCH, DV_PITCH, qf, m, ls, o, false, -1, 64, lane); }
        else if (ub0 + 64 >= 0) { const int rowb = ub0 + 64 + rowoff; attn_tile<64, 1>(Kt + rowb * DK_PITCH, DK_PITCH, Vt + rowb * DV_PITCH, DV_PITCH, qf, m, ls, o, false, -1, 64, lane); }
        if (ub0 + 96 >= 0) { const int rowb = ub0 + 96 + rowoff; attn_tile<64, 2>(Kt + rowb * DK_PITCH, DK_PITCH, Vt + rowb * DV_PITCH, DV_PITCH, qf, m, ls, o, true, -1, 32 + qi, lane); }
        else { const int rowb = ub0 + 128 + rowoff; attn_tile<64, 1>(Kt + rowb * DK_PITCH, DK_PITCH, Vt + rowb * DV_PITCH, DV_PITCH, qf, m, ls, o, true, -1, qi, lane); }
    }
    const float lt = ls + __shfl_xor(ls, 32);
    const float inv = 1.0f / lt;
    unsigned char* dst8 = (unsigned char*)DP + ((size_t)qtok * 3 + br) * 256 + h * 64 + 16 * hh;
#pragma unroll
    for (int db = 0; db < 2; ++db) { u32x4 w;
#pragma unroll
        for (int gq = 0; gq < 4; ++gq) { int p = __builtin_amdgcn_cvt_pk_fp8_f32(o[db][4 * gq] * inv, o[db][4 * gq + 1] * inv, 0, false); p = __builtin_amdgcn_cvt_pk_fp8_f32(o[db][4 * gq + 2] * inv, o[db][4 * gq + 3] * inv, p, true); w[gq] = (unsigned)p; }
        *(u32x4*)(dst8 + 32 * db) = w; }
    if (hh == 0) DL[((size_t)qtok * 3 + br) * 4 + h] = m + __builtin_amdgcn_logf(lt);
}
template <int l>
__device__ __forceinline__ void dilated_phase(const Core& C, const Frame& F0) {
    const Frame F = fresh_frame(F0);
    int bh, rr;
    if (!bh_unit(0, 24, F.G, bh, rr)) return;
    DilGeo g = dil_geo(bh, rr); DilPre P;
    dil_issue(C, F, g, P);
    int it = 0;
#pragma unroll 1
    for (;;) {
        h16x8 qf[4];
        dil_stage(F, g, P, qf);
        __syncthreads();
        int bh2, rr2; const bool hn = bh_unit(it + 1, 24, F.G, bh2, rr2);
        DilGeo g2 = g;
        if (hn) { g2 = dil_geo(bh2, rr2); dil_issue(C, F, g2, P); }
        dil_compute(C, F, g, qf);
        asm volatile("s_waitcnt lgkmcnt(0)" ::: "memory"); __builtin_amdgcn_s_barrier(); asm volatile("" ::: "memory");
        if (!hn) break;
        g = g2; ++it;
    }
}
__device__ __forceinline__ void dil_combine(const Core& C, const Frame& F0) {
    const Frame F = fresh_frame(F0);
    const h16* DP = (const h16*)((unsigned char*)C.out + OUT_DP); const float* DL = (const float*)((unsigned char*)C.out + OUT_DL); h16* Y = (h16*)((unsigned char*)C.out + OUT_Y);
    const size_t gt = (size_t)blockIdx.x * 512 + F.tid, NT = (size_t)F.G * 512;
    const unsigned char* DP8 = (const unsigned char*)DP;
    for (size_t it0 = gt; it0 < (size_t)M * 8; it0 += 4 * NT) {
        float l0[4], l1[4], l2[4]; u32x4 av[4][3][2];
#pragma unroll
        for (int k = 0; k < 4; ++k) { size_t it = it0 + k * NT; if (it >= (size_t)M * 8) it = (size_t)M * 8 - 1; const size_t tok = it >> 3; const int hd = (int)(it & 7), h = hd >> 1, db = hd & 1;
            const size_t off = (size_t)h * 64 + 32 * db;
            l0[k] = DL[(tok * 3 + 0) * 4 + h]; l1[k] = DL[(tok * 3 + 1) * 4 + h]; l2[k] = DL[(tok * 3 + 2) * 4 + h];
#pragma unroll
            for (int br = 0; br < 3; ++br) { av[k][br][0] = *(const u32x4*)(DP8 + (tok * 3 + br) * 256 + off); av[k][br][1] = *(const u32x4*)(DP8 + (tok * 3 + br) * 256 + off + 16); } }
#pragma unroll
        for (int k = 0; k < 4; ++k) { const size_t it = it0 + k * NT; if (it >= (size_t)M * 8) continue; const size_t tok = it >> 3; const int hd = (int)(it & 7);
            const float mx = fmaxf(l0[k], fmaxf(l1[k], l2[k]));
            float w0 = __builtin_amdgcn_exp2f(l0[k] - mx), w1 = __builtin_amdgcn_exp2f(l1[k] - mx), w2 = __builtin_amdgcn_exp2f(l2[k] - mx);
            const float inv = 1.0f / (w0 + w1 + w2); w0 *= inv; w1 *= inv; w2 *= inv;
#pragma unroll
            for (int g = 0; g < 4; ++g) {
                float r[8];
#pragma unroll
                for (int half = 0; half < 2; ++half) {
                    const unsigned x0 = av[k][0][half][g], x1 = av[k][1][half][g], x2 = av[k][2][half][g];
                    const f32x2 p0 = __builtin_amdgcn_cvt_pk_f32_fp8((int)x0, false), q0 = __builtin_amdgcn_cvt_pk_f32_fp8((int)x0, true);
                    const f32x2 p1 = __builtin_amdgcn_cvt_pk_f32_fp8((int)x1, false), q1 = __builtin_amdgcn_cvt_pk_f32_fp8((int)x1, true);
                    const f32x2 p2 = __builtin_amdgcn_cvt_pk_f32_fp8((int)x2, false), q2 = __builtin_amdgcn_cvt_pk_f32_fp8((int)x2, true);
                    r[4 * half + 0] = p0[0] * w0 + p1[0] * w1 + p2[0] * w2; r[4 * half + 1] = p0[1] * w0 + p1[1] * w1 + p2[1] * w2;
                    r[4 * half + 2] = q0[0] * w0 + q1[0] * w1 + q2[0] * w2; r[4 * half + 3] = q0[1] * w0 + q1[1] * w1 + q2[1] * w2;
                }
                h16x8 rr;
#pragma unroll
                for (int j = 0; j < 8; ++j) rr[j] = (h16)r[j];
                *(h16x8*)(Y + tok * DM + 512 + 32 * hd + 8 * g) = rr; }
        }
    }
}
__device__ __forceinline__ void mla_krope(const Core& C, const Frame& F0) {
    const Frame F = fresh_frame(F0);
    const h16* Z = (const h16*)(C.ws + WS_Z); const float* rb = (const float*)(C.ws + WS_ROPEB); h16* Kf = (h16*)(C.ws + WS_KF);
    const size_t gt = (size_t)blockIdx.x * 512 + F.tid, NT = (size_t)F.G * 512;
    for (size_t it = gt; it < (size_t)M * 2; it += NT) {
        const size_t tok = it >> 1; const int c = (int)(it & 1);
        const h16x8 x1 = *(const h16x8*)(Z + tok * ZP + ZC_KR + 8 * c), x2 = *(const h16x8*)(Z + tok * ZP + ZC_KR + 16 + 8 * c);
        const float* cs = rb + tok * 32 + 8 * c;
        h16x8 o1, o2;
#pragma unroll
        for (int j = 0; j < 8; ++j) { const float cc = cs[j], ss = cs[16 + j], a = (float)x1[j], b = (float)x2[j]; o1[j] = (h16)(a * cc - b * ss); o2[j] = (h16)(a * ss + b * cc); }
#pragma unroll
        for (int hd = 0; hd < 4; ++hd) { *(h16x8*)(Kf + tok * 384 + hd * 96 + 64 + 8 * c) = o1; *(h16x8*)(Kf + tok * 384 + hd * 96 + 80 + 8 * c) = o2; }
    }
}
constexpr int MK_PITCH = 104, MV_PITCH = 96;
constexpr int MLA_KB = 64 * MK_PITCH * 2, MLA_VB = 64 * MV_PITCH * 2;
template <int MODE>
__device__ __forceinline__ void mla_qblock(const Core& C, const Frame& F0, int b, int h, int qblk, h16* Yout) {
    const Frame F = fresh_frame(F0);
    const h16* Qm = (const h16*)(C.ws + WS_Q); const h16* Kf = (const h16*)(C.ws + WS_KF); const h16* Vm = (const h16*)(C.ws + WS_VM); h16* Y = Yout;
    const int lane = F.lane, w = F.wave, tid = F.tid, qi = lane & 31, hh = lane >> 5;
    const int tok0 = b * SEQ, q0w = 256 * qblk + 32 * w;
    h16x8 qf[6];
    { const h16* qsrc = Qm + (size_t)(tok0 + q0w + qi) * 384 + h * 96 + 8 * hh;
#pragma unroll
      for (int ds = 0; ds < 6; ++ds) qf[ds] = *(const h16x8*)(qsrc + 16 * ds); }
    float m = -INFINITY, ls = 0.f; f32x16 o[2];
#pragma unroll
    for (int i = 0; i < 16; ++i) { o[0][i] = 0.f; o[1][i] = 0.f; }
    const int nkt = 4 * (qblk + 1);
    const int kr0 = tid / 12, kc0 = tid % 12, kr1 = (tid + 512) / 12, kc1 = (tid + 512) % 12, vr = tid >> 3, vc = tid & 7;
    const bool has2 = tid < 256;
    const h16* kp0 = Kf + (size_t)(tok0 + kr0) * 384 + h * 96 + 8 * kc0; const h16* kp1 = Kf + (size_t)(tok0 + (has2 ? kr1 : kr0)) * 384 + h * 96 + 8 * (has2 ? kc1 : kc0);
    const h16* vp = Vm + (size_t)(tok0 + vr) * 256 + h * 64 + 8 * vc;
    const int ko0 = kr0 * MK_PITCH + 8 * kc0, ko1 = kr1 * MK_PITCH + 8 * kc1, vo = vr * MV_PITCH + 8 * vc;
#define MLA_LOAD(KA, KB, VA, t) do { const size_t o_ = (MODE & 1) ? 0 : (size_t)64 * (t); KA = *(const h16x8*)(kp0 + o_ * 384); KB = *(const h16x8*)(kp1 + o_ * 384); VA = *(const h16x8*)(vp + o_ * 256); } while (0)
#define MLA_STORE(KA, KB, VA, buf) do { LAS h16* Kn = (LAS h16*)(F.lds + (buf) * MLA_KB); LAS h16* Vn = (LAS h16*)(F.lds + 3 * MLA_KB + (buf) * MLA_VB); \
        *(LAS h16x8*)(Kn + ko0) = KA; if (has2) *(LAS h16x8*)(Kn + ko1) = KB; *(LAS h16x8*)(Vn + vo) = VA; } while (0)
#define MLA_BAR() do { asm volatile("s_waitcnt lgkmcnt(0)" ::: "memory"); __builtin_amdgcn_s_barrier(); asm volatile("" ::: "memory"); } while (0)
#define MLA_COMPUTE(kt_, buf) do { const LAS h16* Kt = (const LAS h16*)(F.lds + (buf) * MLA_KB); const LAS h16* Vt = (const LAS h16*)(F.lds + 3 * MLA_KB + (buf) * MLA_VB); \
        const int kbase = 64 * (kt_); \
        if (kbase + 32 <= q0w + 31) { attn_tile<96, 2>(Kt, MK_PITCH, Vt, MV_PITCH, qf, m, ls, o, kbase + 63 > q0w, -1, q0w + qi - kbase, lane); } \
        else if (kbase <= q0w + 31) { attn_tile<96, 1>(Kt, MK_PITCH, Vt, MV_PITCH, qf, m, ls, o, true, -1, q0w + qi - kbase, lane); } } while (0)
    h16x8 kaA, kbA, vaA, kaB, kbB, vaB;
    MLA_LOAD(kaA, kbA, vaA, 0);
    MLA_LOAD(kaB, kbB, vaB, 1);
    MLA_STORE(kaA, kbA, vaA, 0);
    MLA_BAR();
    int buf = 0;
#pragma unroll 1
    for (int kt = 0; kt < nkt; kt += 2) {
        const int b1 = buf == 2 ? 0 : buf + 1, b2 = b1 == 2 ? 0 : b1 + 1;
        if (kt + 2 < nkt) MLA_LOAD(kaA, kbA, vaA, kt + 2);
        MLA_COMPUTE(kt, buf);
        MLA_STORE(kaB, kbB, vaB, b1);
        MLA_BAR();
        if (kt + 3 < nkt) MLA_LOAD(kaB, kbB, vaB, kt + 3);
        MLA_COMPUTE(kt + 1, b1);
        if (kt + 2 < nkt) MLA_STORE(kaA, kbA, vaA, b2);
        MLA_BAR();
        buf = b2;
    }
#undef MLA_LOAD
#undef MLA_STORE
#undef MLA_BAR
#undef MLA_COMPUTE
    const float lt = ls + __shfl_xor(ls, 32);
    const float inv = 1.0f / lt;
    h16* dst = Y + (size_t)(tok0 + q0w + qi) * DM + 256 + h * 64;
#pragma unroll
    for (int db = 0; db < 2; ++db) { u32x2 ov[4];
#pragma unroll
        for (int g = 0; g < 4; ++g) { ov[g].x = pkh(o[db][4 * g] * inv, o[db][4 * g + 1] * inv); ov[g].y = pkh(o[db][4 * g + 2] * inv, o[db][4 * g + 3] * inv); }
        store_row32(dst + 32 * db, ov, hh); }
}
template <int MODE>
__device__ __forceinline__ void mla_qblock2(const Core& C, const Frame& F0, int b, int h, int qblk, h16* Yout) {
    const Frame F = fresh_frame(F0);
    const h16* Qm = (const h16*)(C.ws + WS_Q); const h16* Kf = (const h16*)(C.ws + WS_KF); const h16* Vm = (const h16*)(C.ws + WS_VM); h16* Y = Yout;
    const int lane = F.lane, w = F.wave, tid = F.tid, qi = lane & 31, hh = lane >> 5;
    const int tok0 = b * SEQ, q0w = 512 * qblk + 64 * w;
    h16x8 qf[6], qg[6];
    { const h16* qsrc = Qm + (size_t)(tok0 + q0w + qi) * 384 + h * 96 + 8 * hh;
#pragma unroll
      for (int ds = 0; ds < 6; ++ds) { qf[ds] = *(const h16x8*)(qsrc + 16 * ds); qg[ds] = *(const h16x8*)(qsrc + (size_t)32 * 384 + 16 * ds); } }
    float m = -INFINITY, ls = 0.f, m2 = -INFINITY, ls2 = 0.f; f32x16 o[2], o2[2];
#pragma unroll
    for (int i = 0; i < 16; ++i) { o[0][i] = 0.f; o[1][i] = 0.f; o2[0][i] = 0.f; o2[1][i] = 0.f; }
    const int nkt = 8 * (qblk + 1);
    const int kr0 = tid / 12, kc0 = tid % 12, kr1 = (tid + 512) / 12, kc1 = (tid + 512) % 12, vr = tid >> 3, vc = tid & 7;
    const bool has2 = tid < 256;
    const h16* Kr = (const h16*)(C.ws + WS_KR);
    const int kr1c = has2 ? kr1 : kr0, kc1c = has2 ? kc1 : kc0;
    const h16* kp0 = kc0 < 8 ? Kf + (size_t)(tok0 + kr0) * 256 + h * 64 + 8 * kc0 : Kr + (size_t)(tok0 + kr0) * 32 + 8 * (kc0 - 8);
    const h16* kp1 = kc1c < 8 ? Kf + (size_t)(tok0 + kr1c) * 256 + h * 64 + 8 * kc1c : Kr + (size_t)(tok0 + kr1c) * 32 + 8 * (kc1c - 8);
    const size_t ks0 = kc0 < 8 ? 256 : 32, ks1 = kc1c < 8 ? 256 : 32;
    const h16* vp = Vm + (size_t)(tok0 + vr) * 256 + h * 64 + 8 * vc;
    const int ko0 = kr0 * MK_PITCH + 8 * kc0, ko1 = kr1 * MK_PITCH + 8 * kc1, vo = vr * MV_PITCH + 8 * vc;
#define MLA_LOAD(KA, KB, VA, t) do { const size_t o_ = (MODE & 1) ? 0 : (size_t)64 * (t); KA = *(const h16x8*)(kp0 + o_ * ks0); KB = *(const h16x8*)(kp1 + o_ * ks1); VA = *(const h16x8*)(vp + o_ * 256); } while (0)
#define MLA_STORE(KA, KB, VA, buf) do { LAS h16* Kn = (LAS h16*)(F.lds + (buf) * MLA_KB); LAS h16* Vn = (LAS h16*)(F.lds + 3 * MLA_KB + (buf) * MLA_VB); \
        *(LAS h16x8*)(Kn + ko0) = KA; if (has2) *(LAS h16x8*)(Kn + ko1) = KB; *(LAS h16x8*)(Vn + vo) = VA; } while (0)
#define MLA_BAR() do { asm volatile("s_waitcnt lgkmcnt(0)" ::: "memory"); __builtin_amdgcn_s_barrier(); asm volatile("" ::: "memory"); } while (0)
#define MLA_COMPUTE(kt_, buf) do { const LAS h16* Kt = (const LAS h16*)(F.lds + (buf) * MLA_KB); const LAS h16* Vt = (const LAS h16*)(F.lds + 3 * MLA_KB + (buf) * MLA_VB); \
        _Pragma("unroll") for (int sub_ = 0; sub_ < 2; ++sub_) { const int kbase = 64 * (kt_) + 32 * sub_; \
            const LAS h16* Ks = Kt + 32 * sub_ * MK_PITCH; const LAS h16* Vs = Vt + 32 * sub_ * MV_PITCH; \
              \
            if (kbase <= q0w + 63) attn_tile_dual<96>(Ks, MK_PITCH, Vs, MV_PITCH, qf, qg, m, ls, o, m2, ls2, o2, kbase + 31 > q0w, q0w + qi - kbase, kbase + 31 > q0w + 32, q0w + 32 + qi - kbase, lane); } } while (0)
    h16x8 kaA, kbA, vaA, kaB, kbB, vaB;
    MLA_LOAD(kaA, kbA, vaA, 0);
    MLA_LOAD(kaB, kbB, vaB, 1);
    MLA_STORE(kaA, kbA, vaA, 0);
    MLA_BAR();
    int buf = 0;
#pragma unroll 1
    for (int kt = 0; kt < nkt; kt += 2) {
        const int b1 = buf == 2 ? 0 : buf + 1, b2 = b1 == 2 ? 0 : b1 + 1;
        if (kt + 2 < nkt) MLA_LOAD(kaA, kbA, vaA, kt + 2);
        MLA_COMPUTE(kt, buf);
        MLA_STORE(kaB, kbB, vaB, b1);
        MLA_BAR();
        if (kt + 3 < nkt) MLA_LOAD(kaB, kbB, vaB, kt + 3);
        MLA_COMPUTE(kt + 1, b1);
        if (kt + 2 < nkt) MLA_STORE(kaA, kbA, vaA, b2);
        MLA_BAR();
        buf = b2;
    }
#undef MLA_LOAD
#undef MLA_STORE
#undef MLA_BAR
#undef MLA_COMPUTE
    {
    const float lt = ls + __shfl_xor(ls, 32);
    const float inv = 1.0f / lt;
    h16* dst = Y + (size_t)(tok0 + q0w + qi) * DM + 256 + h * 64;
#pragma unroll
    for (int db = 0; db < 2; ++db) { u32x2 ov[4];
#pragma unroll
        for (int g = 0; g < 4; ++g) { ov[g].x = pkh(o[db][4 * g] * inv, o[db][4 * g + 1] * inv); ov[g].y = pkh(o[db][4 * g + 2] * inv, o[db][4 * g + 3] * inv); }
        store_row32(dst + 32 * db, ov, hh); }
    }
    {
    const float lt = ls2 + __shfl_xor(ls2, 32);
    const float inv = 1.0f / lt;
    h16* dst = Y + (size_t)(tok0 + q0w + 32 + qi) * DM + 256 + h * 64;
#pragma unroll
    for (int db = 0; db < 2; ++db) { u32x2 ov[4];
#pragma unroll
        for (int g = 0; g < 4; ++g) { ov[g].x = pkh(o2[db][4 * g] * inv, o2[db][4 * g + 1] * inv); ov[g].y = pkh(o2[db][4 * g + 2] * inv, o2[db][4 * g + 3] * inv); }
        store_row32(dst + 32 * db, ov, hh); }
    }
}

template <int MODE>
__device__ __forceinline__ void mla_unit2(const Core& C, const Frame& F, int unit, h16* Yout) {
    const int bh = unit >> 1, p = unit & 1;
    mla_qblock2<MODE>(C, F, bh >> 2, bh & 3, 3 - p, Yout);
    mla_qblock2<MODE>(C, F, bh >> 2, bh & 3, p, Yout);
}
template <int MODE>
__device__ __forceinline__ void mla_unit(const Core& C, const Frame& F, int unit, h16* Yout) {
    const int b = unit >> 4, h = (unit >> 2) & 3, p = unit & 3;
    mla_qblock<MODE>(C, F, b, h, 7 - p, Yout);
    mla_qblock<MODE>(C, F, b, h, p, Yout);
}


constexpr int ML_QP = 72, ML_VP = 96;
constexpr int ML_Q = 0, ML_K = ML_Q + 128 * ML_QP * 2, ML_KW = ML_K + 128 * ML_QP * 2, ML_V = ML_KW + 128 * ML_VP * 2, ML_C = ML_V + 128 * ML_VP * 2, ML_F = ML_C + 64 * ML_VP * 2;
constexpr float LOG2E = 1.4426950408889634f;
constexpr int MLG_STRIDE = 400;
__device__ __forceinline__ void ml_conv_load(const h16* Z, const float* cw, const float* cb, int b, int c, int h, const bool both, LAS h16* Qt, LAS h16* Kt, int tid) {
    const int isk = both ? (tid >> 8) : 1, rg = (tid & 255) >> 3, c8 = tid & 7, col = isk * 256 + h * 64 + 8 * c8;
    if (!both && tid >= 256) return;
    h16x8 xv[7];
#pragma unroll
    for (int j = 0; j < 7; ++j) { int pos = 128 * c + 4 * rg - 3 + j; if (pos < 0) pos = 0;
        xv[j] = *(const h16x8*)(Z + (size_t)(b * SEQ + pos) * ZP + ZC_D + col); }
    f32x4 w0[4], w1[4];
#pragma unroll
    for (int j = 0; j < 4; ++j) { w0[j] = *(const f32x4*)(cw + j * 512 + col); w1[j] = *(const f32x4*)(cw + j * 512 + col + 4); }
    const f32x4 b0 = *(const f32x4*)(cb + col), b1 = *(const f32x4*)(cb + col + 4);
    const float sc = isk ? 0.125f : 1.0f;
    LAS h16* dst = isk ? Kt : Qt;
#pragma unroll
    for (int i = 0; i < 4; ++i) {
        float acc[8];
#pragma unroll
        for (int e = 0; e < 4; ++e) { acc[e] = b0[e]; acc[4 + e] = b1[e]; }
#pragma unroll
        for (int j = 0; j < 4; ++j) { const float on = (128 * c + 4 * rg + i - 3 + j >= 0) ? 1.0f : 0.0f;
#pragma unroll
            for (int e = 0; e < 4; ++e) { acc[e] += on * w0[j][e] * (float)xv[i + j][e]; acc[4 + e] += on * w1[j][e] * (float)xv[i + j][4 + e]; } }
        h16x8 ov;
#pragma unroll
        for (int e = 0; e < 8; ++e) { const float y = acc[e]; ov[e] = (h16)(y * sc * __builtin_amdgcn_rcpf(1.0f + __builtin_amdgcn_exp2f(-y * LOG2E))); }
        *(LAS h16x8*)(dst + (4 * rg + i) * ML_QP + 8 * c8) = ov;
    }
}
__device__ __forceinline__ void ml_gate_load(const h16* Z, int tokc, int h, int lane, h16 (&gz)[4]) {
    const size_t z0 = (size_t)(tokc + 2 * lane) * ZP + ZC_GATE + h;
    gz[0] = Z[z0]; gz[1] = Z[z0 + ZP]; gz[2] = Z[z0 + 4]; gz[3] = Z[z0 + ZP + 4];
}
__device__ __forceinline__ void ml_gates(const h16 (&gz)[4], float igb, float fgb, LAS float* gk, LAS float* bc, LAS float* pm, int lane, float& bend, float& gmax) {
    const float i0 = (float)gz[0] + igb, i1 = (float)gz[1] + igb, f0 = (float)gz[2] + fgb, f1 = (float)gz[3] + fgb;
    const float fl0 = fminf(f0, 0.f) - log1pf(expf(-fabsf(f0))), fl1 = fminf(f1, 0.f) - log1pf(expf(-fabsf(f1)));
    float sc = fl0 + fl1;
#pragma unroll
    for (int o = 1; o < 64; o <<= 1) { const float t = __shfl_up(sc, o); if (lane >= o) sc += t; }
    const float bc1 = sc, bc0 = sc - fl1;
    const float g0 = i0 - bc0, g1 = i1 - bc1;
    float p = fmaxf(g0, g1);
#pragma unroll
    for (int o = 1; o < 64; o <<= 1) { const float t = __shfl_up(p, o); if (lane >= o) p = fmaxf(p, t); }
    float pprev = __shfl_up(p, 1); if (lane == 0) pprev = -INFINITY;
    gk[2 * lane] = g0; gk[2 * lane + 1] = g1; bc[2 * lane] = bc0; bc[2 * lane + 1] = bc1; pm[2 * lane] = fmaxf(pprev, g0); pm[2 * lane + 1] = p;
    bend = __shfl(bc1, 63); gmax = __shfl(p, 63);
}
template <int l>
__device__ __forceinline__ void mlstm_part1(const Core& C, const Frame& F0, int unit) {
    const Frame F = fresh_frame(F0);
    const h16* Z = (const h16*)(C.ws + WS_Z); const float* par = (const float*)(C.ws + WS_PAR);
    h16* DC = (h16*)(C.ws + WS_MLC); float* DN = (float*)(C.ws + WS_MLN);
    const int bh = unit >> 4, c = unit & 15, b = bh >> 2, h = bh & 3, lane = F.lane, w = F.wave, tid = F.tid, qi = lane & 31, hh = lane >> 5;
    const int u15 = bh * 15 + c;
    float* GA = (float*)(C.ws + WS_MLG) + (size_t)unit * MLG_STRIDE;
    LAS h16* Kt = (LAS h16*)(F.lds + ML_K); LAS h16* KWt = (LAS h16*)(F.lds + ML_KW); LAS h16* Vt = (LAS h16*)(F.lds + ML_V);
    LAS float* gk = (LAS float*)(F.lds + ML_F); LAS float* pm = gk + 128; LAS float* bc = gk + 256; LAS float* scal = gk + 448;
    const int tokc = b * SEQ + 128 * c;
    h16 gz[4];
    if (w == 7) ml_gate_load(Z, tokc, h, lane, gz);
    if (c < 15) {
    const int r0 = tid >> 3, c8 = tid & 7;
    const h16x8 va = *(const h16x8*)(Z + (size_t)(tokc + r0) * ZP + ZC_D + 512 + h * 64 + 8 * c8), vb = *(const h16x8*)(Z + (size_t)(tokc + r0 + 64) * ZP + ZC_D + 512 + h * 64 + 8 * c8);
    ml_conv_load(Z, par + PF_CONVW + l * 4 * 512, par + PF_CONVB + l * 512, b, c, h, false, Kt, Kt, tid);
    *(LAS h16x8*)(Vt + r0 * ML_VP + 8 * c8) = va; *(LAS h16x8*)(Vt + (r0 + 64) * ML_VP + 8 * c8) = vb;
    }
    if (w == 7) { float bend, gmax; ml_gates(gz, par[PF_IGB + l * 4 + h], par[PF_FGB + l * 4 + h], gk, bc, pm, lane, bend, gmax);
        if (lane == 0) { scal[0] = bend; scal[1] = gmax; GA[384] = bend; GA[385] = gmax; } }
    __syncthreads();
    if (tid < 384) GA[tid] = gk[tid];
    if (c == 15) { UNIT_END_BAR(); return; }
    { const float gmax = scal[1];
      for (int it = tid; it < 1024; it += 512) { const int r = it >> 3, c8 = it & 7; const float wk = __builtin_amdgcn_exp2f((gk[r] - gmax) * LOG2E);
        const h16x8 kv = *(const LAS h16x8*)(Kt + r * ML_QP + 8 * c8); h16x8 o;
#pragma unroll
        for (int e = 0; e < 8; ++e) o[e] = (h16)((float)kv[e] * wk);
        *(LAS h16x8*)(KWt + r * ML_VP + 8 * c8) = o; } }
    __syncthreads();
    if (w < 4) {
        const int dkb = w >> 1, dvb = w & 1;
        f32x16 acc;
#pragma unroll
        for (int i = 0; i < 16; ++i) acc[i] = 0.f;
#pragma unroll
        for (int ks = 0; ks < 8; ++ks) { const h16x8 a = tr_frag<true>(KWt, ML_VP, 16 * ks, 32 * dkb, lane), bq = tr_frag<true>(Vt, ML_VP, 16 * ks, 32 * dvb, lane); acc = mfma32(a, bq, acc); }
        u32x2 ov[4];
#pragma unroll
        for (int g = 0; g < 4; ++g) { ov[g].x = pkh(acc[4 * g], acc[4 * g + 1]); ov[g].y = pkh(acc[4 * g + 2], acc[4 * g + 3]); }
        store_row32(DC + (size_t)u15 * 4096 + (32 * dvb + qi) * 64 + 32 * dkb, ov, hh);
    } else if (w == 4) {
        float sacc = 0.f;
#pragma unroll 8
        for (int r = 0; r < 128; ++r) sacc += (float)KWt[r * ML_VP + lane];
        DN[(size_t)u15 * 128 + lane] = sacc;
    }
    UNIT_END_BAR();
}
template <int l>
__device__ __forceinline__ void mlstm_part2(const Core& C, const Frame& F0, int unit) {
    const Frame F = fresh_frame(F0);
    const h16* Z = (const h16*)(C.ws + WS_Z); h16* Y = (h16*)((unsigned char*)C.out + OUT_Y); const float* par = (const float*)(C.ws + WS_PAR);
    const h16* DC = (const h16*)(C.ws + WS_MLC); const float* DN = (const float*)(C.ws + WS_MLN);
    const int bh = unit >> 4, c = unit & 15, b = bh >> 2, h = bh & 3, lane = F.lane, w = F.wave, tid = F.tid, qi = lane & 31, hh = lane >> 5;
    LAS h16* Qt = (LAS h16*)(F.lds + ML_Q); LAS h16* Kt = (LAS h16*)(F.lds + ML_K); LAS h16* Vt = (LAS h16*)(F.lds + ML_V); LAS h16* Cs = (LAS h16*)(F.lds + ML_C);
    LAS float* gk = (LAS float*)(F.lds + ML_F); LAS float* pm = gk + 128; LAS float* bc = gk + 256; LAS float* nvec = gk + 384; LAS float* scal = gk + 448;
    const int tokc = b * SEQ + 128 * c;
    const float* cw = par + PF_CONVW + l * 4 * 512; const float* cb = par + PF_CONVB + l * 512;
    h16x8 dvv[15]; float dnn[15]; h16x4 ogv[4];
    { const int dk = tid >> 3, d8 = tid & 7;
#pragma unroll
      for (int j0 = 0; j0 < 15; j0 += 5) {
          if (j0 < c) {
#pragma unroll
              for (int j = j0; j < j0 + 5; ++j) { const int jj = j < c ? j : c - 1;
                  dvv[j] = *(const h16x8*)(DC + (size_t)(bh * 15 + jj) * 4096 + dk * 64 + 8 * d8); dnn[j] = DN[(size_t)(bh * 15 + jj) * 128 + (tid & 63)]; }
          } else {
#pragma unroll
              for (int j = j0; j < j0 + 5; ++j) { dvv[j] = (h16x8){(h16)0.f, (h16)0.f, (h16)0.f, (h16)0.f, (h16)0.f, (h16)0.f, (h16)0.f, (h16)0.f}; dnn[j] = 0.f; }
          }
      }
      const size_t zo = (size_t)(tokc + 32 * (w >> 1) + qi) * ZP + ZC_D + 768 + h * 64 + 32 * (w & 1) + 4 * hh;
#pragma unroll
      for (int g = 0; g < 4; ++g) ogv[g] = *(const h16x4*)(Z + zo + 8 * g); }
    const int r0v = tid >> 3, c8v = tid & 7;
    const h16x8 va = *(const h16x8*)(Z + (size_t)(tokc + r0v) * ZP + ZC_D + 512 + h * 64 + 8 * c8v), vb = *(const h16x8*)(Z + (size_t)(tokc + r0v + 64) * ZP + ZC_D + 512 + h * 64 + 8 * c8v);
    const float* GAu = (const float*)(C.ws + WS_MLG) + (size_t)unit * MLG_STRIDE;
    const float gav = GAu[tid < 384 ? tid : 383];
    const float* GAb = (const float*)(C.ws + WS_MLG) + (size_t)(bh * 16) * MLG_STRIDE;
    const int jl = lane < 15 ? lane : 14;
    const float be_l = GAb[(size_t)jl * MLG_STRIDE + 384], gm_l = GAb[(size_t)jl * MLG_STRIDE + 385];
    ml_conv_load(Z, cw, cb, b, c, h, true, Qt, Kt, tid);
    *(LAS h16x8*)(Vt + r0v * ML_VP + 8 * c8v) = va; *(LAS h16x8*)(Vt + (r0v + 64) * ML_VP + 8 * c8v) = vb;
    if (tid < 384) gk[tid] = gav;
    if (w == 0) {
        const bool act = lane < c;
        float Bs = act ? be_l : 0.f;
#pragma unroll
        for (int o = 1; o < 16; o <<= 1) { const float t = __shfl_down(Bs, o); if (lane + o < 64) Bs += t; }
        const float cand = act ? gm_l + Bs : -INFINITY;
        float mc = cand;
#pragma unroll
        for (int o = 1; o < 16; o <<= 1) mc = fmaxf(mc, __shfl_xor(mc, o));
        mc = fmaxf(__shfl(mc, 0), __shfl(Bs, 0));
        if (lane < 16) scal[16 + lane] = act ? __builtin_amdgcn_exp2f((cand - mc) * LOG2E) : 0.f;
        if (lane == 0) scal[0] = mc;
    }
    __syncthreads();
    {
        const int dk = tid >> 3, d8 = tid & 7;
        float a8[8];
#pragma unroll
        for (int e = 0; e < 8; ++e) a8[e] = 0.f;
        float nn = 0.f;
#pragma unroll
        for (int j = 0; j < 15; ++j) { const float cf = scal[16 + j];
#pragma unroll
            for (int e = 0; e < 8; ++e) a8[e] += cf * (float)dvv[j][e];
            nn += cf * dnn[j]; }
        h16x8 o;
#pragma unroll
        for (int e = 0; e < 8; ++e) o[e] = (h16)a8[e];
        *(LAS h16x8*)(Cs + dk * ML_QP + 8 * d8) = o;
        if (tid < 64) nvec[tid] = nn;
    }
    __syncthreads();
    {
        const int tb = w >> 1, dvb = w & 1, t = 32 * tb + qi;
        const float mr = scal[0], Mtt = fmaxf(mr, pm[t]), bct = bc[t];
        h16x8 qf[4];
#pragma unroll
        for (int ds = 0; ds < 4; ++ds) qf[ds] = *(const LAS h16x8*)(Qt + t * ML_QP + 16 * ds + 8 * hh);
        f32x16 num, inter; float den = 0.f;
#pragma unroll
        for (int i = 0; i < 16; ++i) { num[i] = 0.f; inter[i] = 0.f; }
#pragma unroll 1
        for (int sb = 0; sb <= tb; ++sb) {
            f32x16 sc;
#pragma unroll
            for (int i = 0; i < 16; ++i) sc[i] = 0.f;
#pragma unroll
            for (int ds = 0; ds < 4; ++ds) { const h16x8 a = *(const LAS h16x8*)(Kt + (32 * sb + qi) * ML_QP + 16 * ds + 8 * hh); sc = mfma32(a, qf[ds], sc); }
            float ps = 0.f;
#pragma unroll
            for (int i = 0; i < 16; ++i) { const int kk = crow(i, hh); const float wgt = __builtin_amdgcn_exp2f((gk[32 * sb + kk] - Mtt) * LOG2E);
                float p = sc[i] * wgt; if (sb == tb && kk > qi) p = 0.f; sc[i] = p; ps += p; }
            den += ps;
            h16x8 pf[2];
#pragma unroll
            for (int s2 = 0; s2 < 2; ++s2)
#pragma unroll
                for (int j = 0; j < 8; ++j) pf[s2][j] = (h16)sc[8 * s2 + j];
#pragma unroll
            for (int s2 = 0; s2 < 2; ++s2) { const h16x8 a = tr_frag<false>(Vt + 32 * sb * ML_VP, ML_VP, 16 * s2, 32 * dvb, lane); num = mfma32(a, pf[s2], num); }
        }
        float dq = 0.f;
#pragma unroll
        for (int ks = 0; ks < 4; ++ks) { const h16x8 a = *(const LAS h16x8*)(Cs + (32 * dvb + qi) * ML_QP + 16 * ks + 8 * hh); inter = mfma32(a, qf[ks], inter);
#pragma unroll
            for (int j = 0; j < 8; ++j) dq += (float)qf[ks][j] * nvec[16 * ks + 8 * hh + j]; }
        den += __shfl_xor(den, 32); dq += __shfl_xor(dq, 32);
        const float scl = __builtin_amdgcn_exp2f((mr - Mtt) * LOG2E);
        const float dtot = den + scl * dq;
        const float dnm = fmaxf(fabsf(dtot), __builtin_amdgcn_exp2f(-(bct + Mtt) * LOG2E));
        const float inv = 1.0f / dnm;
        u32x2 ov[4];
#pragma unroll
        for (int g = 0; g < 4; ++g) { const h16x4 og = ogv[g]; float r4[4];
#pragma unroll
            for (int j = 0; j < 4; ++j) { const float hv = (num[4 * g + j] + scl * inter[4 * g + j]) * inv; r4[j] = hv * __builtin_amdgcn_rcpf(1.0f + __builtin_amdgcn_exp2f(-(float)og[j] * LOG2E)); }
            ov[g].x = pkh(r4[0], r4[1]); ov[g].y = pkh(r4[2], r4[3]); }
        store_row32(Y + (size_t)(tokc + t) * DM + 768 + h * 64 + 32 * dvb, ov, hh);
    }
    UNIT_END_BAR();
}


constexpr int UP_PITCH = 200;
constexpr int UP_BUF = 32 * UP_PITCH * 2;
template <int l>
__device__ __forceinline__ void mla_upproj_unit(const Core& C, const Frame& F0, int panel) {
    const Frame F = fresh_frame(F0);
    const h16* Z = (const h16*)(C.ws + WS_Z); const float* rb = (const float*)(C.ws + WS_ROPEB); const float* ssq = (const float*)(C.ws + WS_SSQ);
    const h16* Wq = (const h16*)(C.ws + WS_WUQ) + (size_t)l * 512 * 256; const h16* Wkv = (const h16*)(C.ws + WS_WUKV) + (size_t)l * 512 * 256;
    h16* Qm = (h16*)(C.ws + WS_Q); h16* Kf = (h16*)(C.ws + WS_KF); h16* Kr = (h16*)(C.ws + WS_KR); h16* Vm = (h16*)(C.ws + WS_VM);
    const int lane = F.lane, w = F.wave, tid = F.tid, qi = lane & 31, hh = lane >> 5;
    const size_t row = (size_t)panel * 256 + 32 * w + qi;
    h16x8 wr[6];
#define UP_LOAD(S_) do { if ((S_) < 3) { _Pragma("unroll") for (int e = 0; e < 6; ++e) { const int ch = tid + 512 * e, rr = ch / 24, cc = ch % 24; wr[e] = *(const h16x8*)(Wq + (size_t)(128 * (S_) + rr) * 256 + 8 * cc); } } \
        else { _Pragma("unroll") for (int e = 0; e < 4; ++e) { const int ch = tid + 512 * e, rr = ch >> 4, cc = ch & 15; wr[e] = *(const h16x8*)(Wkv + (size_t)(128 * ((S_) - 3) + rr) * 256 + 8 * cc); } } } while (0)
#define UP_STORE(S_, buf) do { LAS h16* Wt = (LAS h16*)(F.lds + (buf) * (4 * UP_BUF)); if ((S_) < 3) { _Pragma("unroll") for (int e = 0; e < 6; ++e) { const int ch = tid + 512 * e, rr = ch / 24, cc = ch % 24; *(LAS h16x8*)(Wt + rr * UP_PITCH + 8 * cc) = wr[e]; } } \
        else { _Pragma("unroll") for (int e = 0; e < 4; ++e) { const int ch = tid + 512 * e, rr = ch >> 4, cc = ch & 15; *(LAS h16x8*)(Wt + rr * UP_PITCH + 8 * cc) = wr[e]; } } } while (0)
#define UP_BAR() do { asm volatile("s_waitcnt lgkmcnt(0)" ::: "memory"); __builtin_amdgcn_s_barrier(); asm volatile("" ::: "memory"); } while (0)
    UP_LOAD(0);
    h16x8 aq[12], akv[8];
    { const h16* zr = Z + row * ZP + 8 * hh;
#pragma unroll
      for (int ks = 0; ks < 12; ++ks) aq[ks] = *(const h16x8*)(zr + ZC_CQ + 16 * ks);
#pragma unroll
      for (int ks = 0; ks < 8; ++ks) akv[ks] = *(const h16x8*)(zr + ZC_CKV + 16 * ks); }
    const float rsq = rsqrtf(ssq[(size_t)(2 * l) * M + row] * (1.0f / 192.0f) + RMS_EPS) * pg8::QSCALE96;
    const float rskv = rsqrtf(ssq[(size_t)(2 * l + 1) * M + row] * (1.0f / 128.0f) + RMS_EPS);
    const f32x4 cl = *(const f32x4*)(rb + row * 32 + 4 * hh), ch = *(const f32x4*)(rb + row * 32 + 8 + 4 * hh);
    const f32x4 sl = *(const f32x4*)(rb + row * 32 + 16 + 4 * hh), sh = *(const f32x4*)(rb + row * 32 + 24 + 4 * hh);
    { const h16x8 x1 = *(const h16x8*)(Z + row * ZP + ZC_KR + 8 * hh), x2 = *(const h16x8*)(Z + row * ZP + ZC_KR + 16 + 8 * hh);
      const f32x4 c0 = *(const f32x4*)(rb + row * 32 + 8 * hh), c1 = *(const f32x4*)(rb + row * 32 + 8 * hh + 4), s0 = *(const f32x4*)(rb + row * 32 + 16 + 8 * hh), s1 = *(const f32x4*)(rb + row * 32 + 16 + 8 * hh + 4);
      h16x8 o1, o2;
#pragma unroll
      for (int j = 0; j < 8; ++j) { const float cc = j < 4 ? c0[j & 3] : c1[j & 3], ss = j < 4 ? s0[j & 3] : s1[j & 3], a = (float)x1[j], b = (float)x2[j]; o1[j] = (h16)(a * cc - b * ss); o2[j] = (h16)(a * ss + b * cc); }
#pragma unroll
      for (int hd = 0; hd < 1; ++hd) { *(h16x8*)(Kr + row * 32 + 8 * hh) = o1; *(h16x8*)(Kr + row * 32 + 16 + 8 * hh) = o2; } }
    UP_STORE(0, 0); UP_BAR();
#pragma unroll 1
    for (int S = 0; S < 7; ++S) {
        const int buf = S & 1;
        if (S + 1 < 7) UP_LOAD(S + 1);
#pragma unroll
        for (int sub = 0; sub < 4; ++sub) {
            const int s = (S < 3) ? 4 * S + sub : 12 + 4 * (S - 3) + sub;
            const LAS h16* Wt = (const LAS h16*)(F.lds + buf * (4 * UP_BUF)) + (32 * sub + qi) * UP_PITCH + 8 * hh;
            f32x16 acc;
#pragma unroll
            for (int i = 0; i < 16; ++i) acc[i] = 0.f;
            if (S < 3) {
#pragma unroll
                for (int ks = 0; ks < 12; ++ks) acc = mfma32(*(const LAS h16x8*)(Wt + 16 * ks), aq[ks], acc);
#pragma unroll
                for (int i = 0; i < 16; ++i) acc[i] *= rsq;
                if (s % 3 == 2) {
#pragma unroll
                    for (int i = 0; i < 8; ++i) { const float cc = i < 4 ? cl[i & 3] : ch[i & 3], ss = i < 4 ? sl[i & 3] : sh[i & 3], x1 = acc[i], x2 = acc[i + 8]; acc[i] = x1 * cc - x2 * ss; acc[i + 8] = x1 * ss + x2 * cc; }
                }
            } else {
#pragma unroll
                for (int ks = 0; ks < 8; ++ks) acc = mfma32(*(const LAS h16x8*)(Wt + 16 * ks), akv[ks], acc);
#pragma unroll
                for (int i = 0; i < 16; ++i) acc[i] *= rskv;
            }
            u32x2 ov[4];
#pragma unroll
            for (int g = 0; g < 4; ++g) { ov[g].x = pkh(acc[4 * g], acc[4 * g + 1]); ov[g].y = pkh(acc[4 * g + 2], acc[4 * g + 3]); }
            h16* dst;
            if (S < 3) dst = Qm + row * 384 + 32 * s;
            else { const int nb = s - 12, hd = nb >> 2, part = nb & 3; dst = part < 2 ? Kf + row * 256 + hd * 64 + 32 * part : Vm + row * 256 + hd * 64 + 32 * (part - 2); }
            store_row32(dst, ov, hh);
        }
        if (S + 1 < 7) UP_STORE(S + 1, buf ^ 1);
        UP_BAR();
    }
#undef UP_LOAD
#undef UP_STORE
#undef UP_BAR
}

#ifndef STAGGER_TICKS
#define STAGGER_TICKS 0
#endif
__device__ __forceinline__ void stagger_start() {
    if (STAGGER_TICKS > 0) { const unsigned long long t0 = __builtin_amdgcn_s_memrealtime(); const unsigned long long d = (unsigned long long)blockIdx.x * STAGGER_TICKS / gridDim.x;
        while (__builtin_amdgcn_s_memrealtime() - t0 < d) __builtin_amdgcn_s_sleep(8); }
}

template <int l>
__device__ __forceinline__ void layer_body(const Core& C, const Frame& F, const XcdBarrier& bar, const int lo, const int hi, const int use_bar) {
#define IN(k) (lo <= (k) && (k) < hi)
#define SEAM(k) do { if (use_bar && IN(k) && IN((k) + 1)) { xcd_barrier(bar); if (DUP_MASK & 4194304) xcd_barrier(bar); } } while (0)
    h16* V16 = (h16*)(C.ws + WS_V16); h16* Z = (h16*)(C.ws + WS_Z); h16* Hb = (h16*)(C.ws + WS_Z); h16* Y = (h16*)((unsigned char*)C.out + OUT_Y);
    float* c12 = (float*)(C.ws + WS_C12); float* stats = (float*)(C.ws + WS_STATS); float* ssq = (float*)(C.ws + WS_SSQ); const float* par = (const float*)(C.ws + WS_PAR);
    {
        const int pb = 1 + 6 * l;
        float* st_ln1 = stats + (size_t)(2 * l) * 2 * M; float* st_ln2 = stats + (size_t)(2 * l + 1) * 2 * M;
        const float* st_prev = l ? stats + (size_t)(2 * l - 1) * 2 * M : nullptr;
        if (IN(pb) && EN_P1) {
            pg8::Gemm g{V16, (const h16*)(C.ws + WS_WIN) + (size_t)l * ZP * DM, DM, DM, M, ZP, DM};
            pg8::StaticOrder S; S.init(M, ZP, F.G, (int)blockIdx.x);
            stagger_start();
            pg8::EpiIn E{Z, c12 + C1IN + l * ZP, c12 + C2IN + l * ZP, pg8::RowStats{st_prev, st_prev ? st_prev + M : nullptr}, l == 0 ? 1 : 0, ssq + (size_t)(2 * l) * M, ssq + (size_t)(2 * l + 1) * M, -1, (const h16*)(C.ws + WS_ROPEC)};
            pg8::gemm_phase(F.lds, F.wave, g, S, E);
            if (DUP_MASK & 1) { float* dums = (float*)(C.ws + WS_DUMS); pg8::EpiIn E2{(DUP_MASK & 65536) ? (h16*)(C.ws + WS_DUMV) : Z, c12 + C1IN + l * ZP, c12 + C2IN + l * ZP, pg8::RowStats{st_prev, st_prev ? st_prev + M : nullptr}, (DUP_MASK & 262144) ? 1 : (l == 0 ? 1 : 0), dums, dums + M, (DUP_MASK & 65536) ? 255 : -1, (const h16*)(C.ws + WS_ROPEC)};
                __syncthreads(); pg8::gemm_phase(F.lds, F.wave, g, S, E2); }
            if (DUP_MASK & 16384) { pg8::EpiNull EN; __syncthreads(); pg8::gemm_phase(F.lds, F.wave, g, S, EN); }
            if (DUP_MASK & 8388608) { pg8::EpiNull EN; pg8::FixedOrder SF{S}; __syncthreads(); pg8::gemm_phase(F.lds, F.wave, g, SF, EN); }
        }
        SEAM(pb);
        if (IN(pb + 1)) for (int rep = 0; rep < ((DUP_MASK & 2) ? 2 : 1); ++rep) {
            if (ZERO_FROM < DM) { const Frame Fz = fresh_frame(F); const size_t gt = (size_t)blockIdx.x * 512 + Fz.tid, NT = (size_t)F.G * 512; constexpr int ZW = (DM - ZERO_FROM) / 8 > 0 ? (DM - ZERO_FROM) / 8 : 1;
            for (size_t i = gt; i < (size_t)M * (DM - ZERO_FROM) / 8; i += NT) { const size_t r = i / ZW, c = i % ZW; *(u32x4*)(Y + r * DM + ZERO_FROM + c * 8) = (u32x4){0u, 0u, 0u, 0u}; } }
            if (EN_D) for (int r2 = 0; r2 < ((DUP_MASK & 64) ? 2 : 1); ++r2) { int bh, r; for (int it = 0; bh_unit(it, 16, F.G, bh, r); ++it) mlstm_part1<l>(C, F, bh * 16 + r); }
            if (EN_A) for (int r2 = 0; r2 < ((DUP_MASK & 128) ? 2 : 1); ++r2) for (int u = blockIdx.x; u < NB * 16; u += F.G) gmlp_unit<l>(C, F, u);
            if (EN_C) dilated_phase<l>(C, F);
            if (EN_B && EN_B1) for (int r2 = 0; r2 < ((DUP_MASK & 512) ? 2 : 1); ++r2) {
                for (int u = blockIdx.x; u < M / 256; u += F.G) mla_upproj_unit<l>(C, F, u);
                __syncthreads();
            }
        }
        SEAM(pb + 1);
        if (IN(pb + 2)) for (int rep = 0; rep < ((DUP_MASK & 4) ? 2 : 1); ++rep) { if (EN_C) for (int r2 = 0; r2 < ((DUP_MASK & 1024) ? 2 : 1); ++r2) dil_combine(C, F); if (EN_B && EN_B2) { { int bh, r; for (int it = 0; bh_unit(it, 2, F.G, bh, r); ++it) mla_unit2<0>(C, F, bh * 2 + r, Y); }
                if (DUP_MASK & 2048) for (int u = blockIdx.x; u < 512; u += F.G) mla_unit<0>(C, F, u, (h16*)(C.ws + WS_DUMV));
                if (DUP_MASK & 131072) for (int u = blockIdx.x; u < 512; u += F.G) mla_unit<1>(C, F, u, (h16*)(C.ws + WS_DUMV)); }
            if (EN_D) for (int r2 = 0; r2 < ((DUP_MASK & 4096) ? 2 : 1); ++r2) { int bh, r; for (int it = 0; bh_unit(it, 16, F.G, bh, r); ++it) mlstm_part2<l>(C, F, bh * 16 + r); } }
        SEAM(pb + 2);
        if (IN(pb + 3) && EN_P3) {
            { const Frame Fs = fresh_frame(F); LAS float* gl = (LAS float*)(F.lds + RING_BYTES); for (int i = Fs.tid; i < DM; i += 512) { gl[i] = (par + PF_LN2G + (l ? l - 1 : 0) * DM)[i]; gl[DM + i] = (par + PF_LN2B + (l ? l - 1 : 0) * DM)[i]; } __syncthreads(); }
            pg8::Gemm g{Y, (const h16*)(C.ws + WS_WOUT) + (size_t)l * DM * DM, DM, DM, M, DM, DM};
            pg8::StaticOrder S; S.init(M, DM, F.G, (int)blockIdx.x);
            if (DUP_MASK & 8) { float* dums = (float*)(C.ws + WS_DUMS); pg8::EpiRes E2{V16, (h16*)(C.ws + WS_DUMV), l == 0 ? 1 : 0, pg8::RowStats{st_prev, st_prev ? st_prev + M : nullptr}, (const LAS float*)(F.lds + RING_BYTES), (const LAS float*)(F.lds + RING_BYTES) + DM, dums, dums + M};
                pg8::gemm_phase(F.lds, F.wave, g, S, E2); __syncthreads(); }
            stagger_start();
            if (DUP_MASK & 32768) { pg8::EpiNull EN; pg8::gemm_phase(F.lds, F.wave, g, S, EN); __syncthreads(); }
            pg8::EpiRes E{V16, V16, l == 0 ? 1 : 0, pg8::RowStats{st_prev, st_prev ? st_prev + M : nullptr}, (const LAS float*)(F.lds + RING_BYTES), (const LAS float*)(F.lds + RING_BYTES) + DM, st_ln1, st_ln1 + M};
            pg8::gemm_phase(F.lds, F.wave, g, S, E);
        }
        SEAM(pb + 3);
        if (IN(pb + 4) && EN_P4) {
            pg8::Gemm g{V16, (const h16*)(C.ws + WS_WGU) + (size_t)l * GU * DM, DM, DM, M, GU, DM};
            pg8::StaticOrder S; S.init(M, GU, F.G, (int)blockIdx.x);
            stagger_start();
            pg8::EpiGU E{Hb, c12 + C1GU + l * GU, c12 + C2GU + l * GU, pg8::RowStats{st_ln1, st_ln1 + M}};
            pg8::gemm_phase(F.lds, F.wave, g, S, E);
            if (DUP_MASK & 16) { __syncthreads(); pg8::gemm_phase(F.lds, F.wave, g, S, E); }
        }
        SEAM(pb + 4);
        if (IN(pb + 5) && EN_P5) {
            { const Frame Fs = fresh_frame(F); LAS float* gl = (LAS float*)(F.lds + RING_BYTES); for (int i = Fs.tid; i < DM; i += 512) { gl[i] = (par + PF_LN1G + l * DM)[i]; gl[DM + i] = (par + PF_LN1B + l * DM)[i]; } __syncthreads(); }
            pg8::Gemm g{Hb, (const h16*)(C.ws + WS_WDOWN) + (size_t)l * DM * FF, FF, FF, M, DM, FF};
            pg8::StaticOrder S; S.init(M, DM, F.G, (int)blockIdx.x);
            stagger_start();
            if (DUP_MASK & 32) { float* dums = (float*)(C.ws + WS_DUMS); pg8::EpiRes E2{V16, (h16*)(C.ws + WS_DUMV), 0, pg8::RowStats{st_ln1, st_ln1 + M}, (const LAS float*)(F.lds + RING_BYTES), (const LAS float*)(F.lds + RING_BYTES) + DM, dums, dums + M};
                pg8::gemm_phase(F.lds, F.wave, g, S, E2); __syncthreads(); }
            pg8::EpiRes E{V16, V16, 0, pg8::RowStats{st_ln1, st_ln1 + M}, (const LAS float*)(F.lds + RING_BYTES), (const LAS float*)(F.lds + RING_BYTES) + DM, st_ln2, st_ln2 + M};
            pg8::gemm_phase(F.lds, F.wave, g, S, E);
        }
        SEAM(pb + 5);
        }
#undef IN
#undef SEAM
}
constexpr int N_PHASES = 2 + 6 * DEPTH;
__global__ void __launch_bounds__(512, 2) fwd_kernel(Args a) {
    extern __shared__ __attribute__((aligned(16))) unsigned char lds_raw[];
    Frame F; F.lds = (LAS unsigned char*)lds_raw; F.tid = threadIdx.x; F.lane = F.tid & 63; F.wave = __builtin_amdgcn_readfirstlane(F.tid >> 6); F.G = gridDim.x;
    volatile LAS unsigned* MISC = (volatile LAS unsigned*)(F.lds + MISC_OFF);
    if (F.tid < 64) MISC[F.tid] = 0u;
    __syncthreads();
    unsigned* ctl = (unsigned*)(a.ws + WS_ZERO);
    XcdBarrier bar; bar.bar = ctl + CW_BAR; bar.x = 0; bar.st = nullptr; bar.wave = F.wave;
    if (a.use_bar) bar = xcd_barrier_post(ctl + CW_BAR, MISC + 8, F.wave);
    const int lo = a.ph_lo, hi = a.ph_hi;
#define IN(k) (lo <= (k) && (k) < hi)
#define SEAM(k) do { if (a.use_bar && IN(k) && IN((k) + 1)) xcd_barrier(bar); } while (0)
    const Core C{a.out, a.ws};

    if (IN(0) && EN_P0) { if (DUP_MASK & 8192) { p0_prologue(a, F, (float*)(a.ws + WS_DUMS)); __syncthreads(); } p0_prologue(a, F, (float*)(a.ws + WS_C12)); }
    SEAM(0);
    if (LOOP_START <= 0 && 0 < LOOP_DEPTH) layer_body<0>(C, F, bar, lo, hi, a.use_bar);
    if (LOOP_START <= 1 && 1 < LOOP_DEPTH) layer_body<1>(C, F, bar, lo, hi, a.use_bar);
    if (LOOP_START <= 2 && 2 < LOOP_DEPTH) layer_body<2>(C, F, bar, lo, hi, a.use_bar);
    if (LOOP_START <= 3 && 3 < LOOP_DEPTH) layer_body<3>(C, F, bar, lo, hi, a.use_bar);
    if (IN(N_PHASES - 1) && EN_PF) final_ln(C, F);
#undef IN
#undef SEAM
}

#ifndef MK_PER_PHASE
#define MK_PER_PHASE 0
#endif
extern "C" void kernel_launch(void* const* d_in, const int* in_sizes, int n_in, void* d_out, int out_size, void* d_ws, size_t ws_size, hipStream_t stream) {
    static int grid = 0;
    if (grid == 0) {
        if (n_in != 23 || out_size != M * DM || ws_size < WS_END) { fprintf(stderr, "kernel_launch: unexpected shapes n_in %d out %d ws %zu\n", n_in, out_size, ws_size); grid = -1; return; }
        int dev = 0, cus = 0;
        if (hipGetDevice(&dev) != hipSuccess || hipDeviceGetAttribute(&cus, hipDeviceAttributeMultiprocessorCount, dev) != hipSuccess) { grid = -1; return; }
        if (hipFuncSetAttribute((const void*)fwd_kernel, hipFuncAttributeMaxDynamicSharedMemorySize, LDS_BYTES) != hipSuccess) { fprintf(stderr, "kernel_launch: hipFuncSetAttribute failed\n"); grid = -1; return; }
        int per_cu = 0;
        if (hipOccupancyMaxActiveBlocksPerMultiprocessor(&per_cu, (const void*)fwd_kernel, 512, LDS_BYTES) != hipSuccess || per_cu < 1) fprintf(stderr, "kernel_launch: occupancy query says %d\n", per_cu);
        (void)hipGetLastError();
        grid = cus;
    }
    if (grid < 0) return;
    (void)hipMemsetAsync((char*)d_ws + WS_ZERO, 0, ZERO_BYTES, stream);
    Args a{};
    a.x = (const float*)d_in[0]; a.pos = (const int*)d_in[1]; a.w_in = (const float*)d_in[2]; a.a_ln_g = (const float*)d_in[3]; a.a_ln_b = (const float*)d_in[4];
    a.a_ws = (const float*)d_in[5]; a.a_bs = (const float*)d_in[6]; a.b_q_norm = (const float*)d_in[7]; a.b_kv_norm = (const float*)d_in[8];
    a.b_w_uq = (const float*)d_in[9]; a.b_w_ukv = (const float*)d_in[10]; a.d_conv_w = (const float*)d_in[11]; a.d_conv_b = (const float*)d_in[12];
    a.d_igate_b = (const float*)d_in[13]; a.d_fgate_b = (const float*)d_in[14]; a.w_out = (const float*)d_in[15]; a.ln1_g = (const float*)d_in[16]; a.ln1_b = (const float*)d_in[17];
    a.w_gate = (const float*)d_in[18]; a.w_up = (const float*)d_in[19]; a.w_down = (const float*)d_in[20]; a.ln2_g = (const float*)d_in[21]; a.ln2_b = (const float*)d_in[22];
    a.out = (float*)d_out; a.ws = (unsigned char*)d_ws; a.pad = 0;
#if MK_PER_PHASE
    a.use_bar = 0;
    for (int p = 0; p < N_PHASES; ++p) { a.ph_lo = p; a.ph_hi = p + 1; hipLaunchKernelGGL(fwd_kernel, dim3(grid), dim3(512), LDS_BYTES, stream, a); }
#else
    a.use_bar = 1; a.ph_lo = 0; a.ph_hi = N_PHASES;
    hipLaunchKernelGGL(fwd_kernel, dim3(grid), dim3(512), LDS_BYTES, stream, a);
#endif
}
```
